# Optimizing an MI355X kernel written in HIP

```python
import math
import jax, jax.numpy as jnp
from jax import lax
import numpy as np

D_MODEL = 1024
BATCH = 16
SEQ = 2048
DEPTH = 2

SSM_WIDTH = 512
SSM_GROUP = 16
SSM_GROUPS = SSM_WIDTH // SSM_GROUP
SSM_STATE = 64
DT_MIN = 0.001
DT_MAX = 0.1
N_HEADS = 8
N_KV_HEADS = 2
HEAD_DIM = 64
Q_PER_KV = N_HEADS // N_KV_HEADS
ATTN_WIDTH = N_HEADS * HEAD_DIM
KV_WIDTH = N_KV_HEADS * HEAD_DIM
WINDOW = 128
BLOCK = 128
SPLITS = (SSM_WIDTH,
          SSM_WIDTH + ATTN_WIDTH,
          SSM_WIDTH + ATTN_WIDTH + KV_WIDTH,
          SSM_WIDTH + ATTN_WIDTH + 2 * KV_WIDTH,
          SSM_WIDTH + ATTN_WIDTH + 2 * KV_WIDTH + D_MODEL)
IN_COLS = SSM_WIDTH + ATTN_WIDTH + 2 * KV_WIDTH + 2 * D_MODEL
N_GROUPS = 4
EXPERTS_PER_GROUP = 4
N_EXPERTS = N_GROUPS * EXPERTS_PER_GROUP
TOP_K = 2
D_EXPERT = 256
EPS = 1e-6
NEG = -1e30

kernel_name = "hybrid_s5_swa_sink_hmoe"


def rmsnorm(x, g):
    xf = x.astype(jnp.float32)
    y = xf * lax.rsqrt(jnp.mean(xf * xf, axis=-1, keepdims=True) + EPS) * g.astype(jnp.float32)
    return y.astype(x.dtype)


def head_rmsnorm(t, g):
    tf = t.astype(jnp.float32)
    return tf * lax.rsqrt(jnp.mean(tf * tf, axis=-1, keepdims=True) + EPS) * g.astype(jnp.float32)


def alibi_slopes():
    return jnp.exp2(-8.0 * jnp.arange(1, N_HEADS + 1, dtype=jnp.float32) / N_HEADS)


def s5_mixer(u, lam_re, lam_im, log_dt, b_re, b_im, c_re, c_im, d_skip):
    f32 = jnp.float32
    bsz, L, _ = u.shape
    uf = u.astype(f32).reshape(bsz, L, SSM_GROUPS, SSM_GROUP)
    lam = lax.complex(lam_re.astype(f32), lam_im.astype(f32))
    dt = jnp.exp(log_dt.astype(f32))[:, None]
    lam_bar = jnp.exp(lam * dt)
    b = lax.complex(b_re.astype(f32), b_im.astype(f32))
    b_bar = ((lam_bar - 1.0) / lam)[..., None] * b
    bu = jnp.einsum('gph,blgh->blgp', b_bar, uf)
    a = jnp.broadcast_to(lam_bar, bu.shape)

    def combine(e1, e2):
        a1, s1 = e1
        a2, s2 = e2
        return a1 * a2, a2 * s1 + s2

    _, states = lax.associative_scan(combine, (a, bu), axis=1)
    c = lax.complex(c_re.astype(f32), c_im.astype(f32))
    y = jnp.einsum('ghp,blgp->blgh', c, states).real
    y = y + d_skip.astype(f32).reshape(SSM_GROUPS, SSM_GROUP) * uf
    return y.reshape(bsz, L, SSM_WIDTH).astype(u.dtype)


def with_prev_block(t):
    pad = ((0, 0), (1, 0)) + ((0, 0),) * (t.ndim - 2)
    prev = jnp.pad(t[:, :-1], pad)
    return jnp.concatenate([prev, t], axis=2)


def sliding_window_attention(q, k, v, q_gain, k_gain, sinks):
    f32 = jnp.float32
    bsz, L, _ = q.shape
    nb = L // BLOCK
    qh = head_rmsnorm(q.reshape(bsz, L, N_HEADS, HEAD_DIM), q_gain)
    kh = head_rmsnorm(k.reshape(bsz, L, N_KV_HEADS, HEAD_DIM), k_gain)
    vh = v.astype(f32).reshape(bsz, L, N_KV_HEADS, HEAD_DIM)
    qb = qh.reshape(bsz, nb, BLOCK, N_KV_HEADS, Q_PER_KV, HEAD_DIM)
    kw = with_prev_block(kh.reshape(bsz, nb, BLOCK, N_KV_HEADS, HEAD_DIM))
    vw = with_prev_block(vh.reshape(bsz, nb, BLOCK, N_KV_HEADS, HEAD_DIM))
    scores = jnp.einsum('bnqkgd,bnskd->bnkgqs', qb, kw) * (HEAD_DIM ** -0.5)
    qpos = jnp.arange(BLOCK)[:, None] + BLOCK
    kpos = jnp.arange(2 * BLOCK)[None, :]
    dist = qpos - kpos
    blk = jnp.arange(nb)[:, None, None]
    valid = (dist >= 0) & (dist < WINDOW)
    valid = valid[None] & ((blk > 0) | (kpos[None] >= BLOCK))
    slopes = alibi_slopes().reshape(N_KV_HEADS, Q_PER_KV)
    scores = scores - slopes[:, :, None, None] * dist.astype(f32)
    scores = jnp.where(valid[None, :, None, None], scores, NEG)
    sink = sinks.astype(f32).reshape(N_KV_HEADS, Q_PER_KV)[None, None, :, :, None, None]
    m = jnp.maximum(jnp.max(scores, axis=-1, keepdims=True), sink)
    p = jnp.exp(scores - m)
    denom = jnp.sum(p, axis=-1, keepdims=True) + jnp.exp(sink - m)
    out = jnp.einsum('bnkgqs,bnskd->bnqkgd', p / denom, vw)
    return out.reshape(bsz, L, ATTN_WIDTH).astype(q.dtype)


def hierarchical_moe(h, w_coarse, w_fine, w_up, w_down):
    f32 = jnp.float32
    bsz, L, D = h.shape
    t = h.reshape(-1, D)
    n_tok = t.shape[0]
    coarse = jax.nn.softmax((t @ w_coarse).astype(f32), axis=-1)
    g_prob, g_idx = lax.top_k(coarse, 1)
    g_idx = g_idx[:, 0]
    fine = (t @ w_fine).astype(f32).reshape(n_tok, N_GROUPS, EXPERTS_PER_GROUP)
    fine = fine[jnp.arange(n_tok), g_idx]
    top_vals, top_idx = lax.top_k(fine, TOP_K)
    top_w = jax.nn.softmax(top_vals, axis=-1) * g_prob
    expert_id = g_idx[:, None] * EXPERTS_PER_GROUP + top_idx
    gates = jnp.sum(jax.nn.one_hot(expert_id, N_EXPERTS, dtype=f32) * top_w[..., None], axis=1)
    gu = jnp.einsum('nd,edf->nef', t, w_up)
    g_part, u_part = jnp.split(gu, 2, axis=-1)
    act = jax.nn.silu(g_part) * u_part * gates[..., None].astype(t.dtype)
    out = jnp.einsum('nef,efd->nd', act, w_down)
    return out.reshape(bsz, L, D)


def setup_inputs(seed: int = 0) -> dict:
    key = jax.random.key(seed)
    ks = jax.random.split(key, 24)
    f32 = jnp.float32

    def normal(k, shape):
        return jax.random.normal(k, shape, f32)

    def dense(k, shape, fan_in):
        return normal(k, shape) * fan_in ** -0.5

    n_idx = jnp.arange(SSM_STATE, dtype=f32)
    gp = (DEPTH, SSM_GROUPS, SSM_STATE)
    return {
        "x": normal(ks[0], (BATCH, SEQ, D_MODEL)),
        "norm_mix": 1.0 + 0.02 * normal(ks[1], (DEPTH, D_MODEL)),
        "w_in": dense(ks[2], (DEPTH, D_MODEL, IN_COLS), D_MODEL),
        "ssm_lam_re": -0.5 + 0.01 * normal(ks[3], gp),
        "ssm_lam_im": math.pi * n_idx + 0.01 * normal(ks[4], gp),
        "ssm_log_dt": jax.random.uniform(ks[5], (DEPTH, SSM_GROUPS), f32, math.log(DT_MIN), math.log(DT_MAX)),
        "ssm_b_re": dense(ks[6], (DEPTH, SSM_GROUPS, SSM_STATE, SSM_GROUP), 2 * SSM_GROUP),
        "ssm_b_im": dense(ks[7], (DEPTH, SSM_GROUPS, SSM_STATE, SSM_GROUP), 2 * SSM_GROUP),
        "ssm_c_re": dense(ks[8], (DEPTH, SSM_GROUPS, SSM_GROUP, SSM_STATE), SSM_STATE),
        "ssm_c_im": dense(ks[9], (DEPTH, SSM_GROUPS, SSM_GROUP, SSM_STATE), SSM_STATE),
        "ssm_d": normal(ks[10], (DEPTH, SSM_WIDTH)),
        "w_ssm_glu_val": dense(ks[11], (DEPTH, SSM_WIDTH, D_MODEL), SSM_WIDTH),
        "w_ssm_glu_gate": dense(ks[12], (DEPTH, SSM_WIDTH, D_MODEL), SSM_WIDTH),
        "q_norm": 1.0 + 0.02 * normal(ks[13], (DEPTH, HEAD_DIM)),
        "k_norm": 1.0 + 0.02 * normal(ks[14], (DEPTH, HEAD_DIM)),
        "attn_sinks": normal(ks[15], (DEPTH, N_HEADS)),
        "w_attn_up": dense(ks[16], (DEPTH, ATTN_WIDTH, D_MODEL), ATTN_WIDTH),
        "w_out": dense(ks[17], (DEPTH, D_MODEL, D_MODEL), D_MODEL),
        "norm_ffn": 1.0 + 0.02 * normal(ks[18], (DEPTH, D_MODEL)),
        "w_coarse": dense(ks[19], (DEPTH, D_MODEL, N_GROUPS), D_MODEL),
        "w_fine": dense(ks[20], (DEPTH, D_MODEL, N_EXPERTS), D_MODEL),
        "w_expert_up": dense(ks[21], (DEPTH, N_EXPERTS, D_MODEL, 2 * D_EXPERT), D_MODEL),
        "w_expert_down": dense(ks[22], (DEPTH, N_EXPERTS, D_EXPERT, D_MODEL), D_EXPERT),
    }


def reference(x, norm_mix, w_in, ssm_lam_re, ssm_lam_im, ssm_log_dt, ssm_b_re, ssm_b_im,
              ssm_c_re, ssm_c_im, ssm_d, w_ssm_glu_val, w_ssm_glu_gate, q_norm, k_norm,
              attn_sinks, w_attn_up, w_out, norm_ffn, w_coarse, w_fine, w_expert_up,
              w_expert_down):
    for i in range(DEPTH):
        h = rmsnorm(x, norm_mix[i])
        proj = h @ w_in[i]
        u, q, k, v, gate_s, gate_a = jnp.split(proj, SPLITS, axis=-1)
        y_s = s5_mixer(u, ssm_lam_re[i], ssm_lam_im[i], ssm_log_dt[i], ssm_b_re[i], ssm_b_im[i],
                       ssm_c_re[i], ssm_c_im[i], ssm_d[i])
        z = jax.nn.gelu(y_s)
        branch_s = (z @ w_ssm_glu_val[i]) * jax.nn.sigmoid(z @ w_ssm_glu_gate[i])
        y_a = sliding_window_attention(q, k, v, q_norm[i], k_norm[i], attn_sinks[i])
        branch_a = y_a @ w_attn_up[i]
        merged = jax.nn.sigmoid(gate_s) * branch_s + jax.nn.sigmoid(gate_a) * branch_a
        x = x + merged @ w_out[i]
        h2 = rmsnorm(x, norm_ffn[i])
        x = x + hierarchical_moe(h2, w_coarse[i], w_fine[i], w_expert_up[i], w_expert_down[i])
    return x
```

```cpp
#include <hip/hip_runtime.h>
#include <hip/hip_cooperative_groups.h>
#include <stdint.h>
#include <stdio.h>

#define DI __device__ __forceinline__
typedef unsigned short u16;
typedef short bf16x8 __attribute__((ext_vector_type(8)));
typedef short s16x4 __attribute__((ext_vector_type(4)));
typedef float f32x4 __attribute__((ext_vector_type(4)));
typedef float f32x2 __attribute__((ext_vector_type(2)));
typedef float f32x16 __attribute__((ext_vector_type(16)));
typedef unsigned u32x4 __attribute__((ext_vector_type(4)));
typedef unsigned u32x2 __attribute__((ext_vector_type(2)));
typedef __bf16 bf2_t __attribute__((ext_vector_type(2)));

constexpr int NTOK = 32768, DM = 1024, SEQ = 2048, NBATCH = 16, INC = 3328;
constexpr int TCH = 32, NCH = SEQ / TCH, S5M = NBATCH * NCH, S5K1 = TCH * 16, S5K2 = S5K1 + 128;
constexpr int TM = 128;
constexpr int MAXTILES = (NTOK + 24 * (TM - 1)) / TM + 1;
constexpr int NTHR = 512;
constexpr int LDS_BYTES = 98304;

constexpr size_t MiB = 1u << 20;
constexpr size_t OFF_R1 = 0;
constexpr size_t OFF_R2 = 64 * MiB;
constexpr size_t OFF_R3 = 128 * MiB;
constexpr size_t OFF_A2 = 192 * MiB;
constexpr size_t OFF_Q = 232 * MiB;
constexpr size_t OFF_KV = 264 * MiB;
constexpr size_t OFF_SLOC = 280 * MiB;
constexpr size_t OFF_Z = 296 * MiB;
constexpr size_t OFF_YA = 328 * MiB;
constexpr size_t OFF_WIN = 360 * MiB;
constexpr size_t OFF_WGLU = OFF_WIN + 7 * MiB;
constexpr size_t OFF_WATT = OFF_WGLU + 2 * MiB;
constexpr size_t OFF_WOUT = OFF_WATT + 1 * MiB;
constexpr size_t OFF_WUP = OFF_WOUT + 2 * MiB;
constexpr size_t OFF_WDN = OFF_WUP + 16 * MiB;
constexpr size_t OFF_W1T = OFF_WDN + 24 * MiB;
constexpr size_t OFF_W2T = OFF_W1T + 8 * MiB;
constexpr size_t OFF_SMALL = OFF_W2T + 20 * MiB;
constexpr size_t OFF_WR = OFF_SMALL;
constexpr size_t OFF_LT = OFF_WR + 128 * 1024;
constexpr size_t OFF_RSTD1 = OFF_LT + 64 * 1024;
constexpr size_t OFF_RSTD2 = OFF_RSTD1 + 128 * 1024;
constexpr size_t OFF_BUCKET = OFF_RSTD2 + 128 * 1024;
constexpr size_t OFF_RW = OFF_BUCKET + 128 * 1024;
constexpr size_t OFF_PERM = OFF_RW + 256 * 1024;
constexpr size_t OFF_CNT = OFF_PERM + 256 * 1024;
constexpr size_t OFF_TILEB = OFF_CNT + 32 * 1024;
constexpr size_t OFF_META = OFF_TILEB + 4 * 1024;
constexpr size_t WS_END = OFF_META + 1024;

struct Params {
    const float* in[23];
    float* out;
    char* ws;
    int layer;
    int pad_;
};

DI unsigned pk2(float a, float b) { f32x2 v = {a, b}; bf2_t r = __builtin_convertvector(v, bf2_t); return __builtin_bit_cast(unsigned, r); }
DI float bf_lo(unsigned u) { return __uint_as_float(u << 16); }
DI float bf_hi(unsigned u) { return __uint_as_float(u & 0xffff0000u); }
DI float sigmoidf_(float x) { return 1.0f / (1.0f + __expf(-x)); }
DI float gelu_tanh(float x) { const float u = 0.7978845608028654f * (x + 0.044715f * x * x * x); const float e = __expf(2.0f * u); const float t = 1.0f - 2.0f / (e + 1.0f); return 0.5f * x * (1.0f + t); }
DI f32x16 mfma32(bf16x8 a, bf16x8 b, f32x16 c) { return __builtin_amdgcn_mfma_f32_32x32x16_bf16(a, b, c, 0, 0, 0); }
DI f32x4 mfma16(bf16x8 a, bf16x8 b, f32x4 c) { return __builtin_amdgcn_mfma_f32_16x16x32_bf16(a, b, c, 0, 0, 0); }

DI void tconv_tile(const float* __restrict__ src, int ld_src, u16* __restrict__ dst, int ld_dst, int dcol0, int rmul, int radd, const float* __restrict__ scale, int k0, int n0, float* sm) {
    const int tid = threadIdx.x;
#pragma unroll
    for (int i = 0; i < 8; ++i) {
        const int k = (tid >> 6) + 8 * i, n = tid & 63;
        float v = src[(size_t)(k0 + k) * ld_src + n0 + n];
        if (scale) v *= scale[k0 + k];
        sm[n * 65 + k] = v;
    }
    __syncthreads();
    {
        const int n = tid >> 3, c = tid & 7;
        const float* s = sm + n * 65 + c * 8;
        u32x4 o; o.x = pk2(s[0], s[1]); o.y = pk2(s[2], s[3]); o.z = pk2(s[4], s[5]); o.w = pk2(s[6], s[7]);
        *(u32x4*)(dst + (size_t)((n0 + n) * rmul + radd) * ld_dst + dcol0 + k0 + c * 8) = o;
    }
    __syncthreads();
}

constexpr int T_WIN = (1024 / 64) * (INC / 64);
constexpr int T_GLU = 2 * (512 / 64) * (1024 / 64);
constexpr int T_ATT = (512 / 64) * (1024 / 64);
constexpr int T_OUT = (1024 / 64) * (1024 / 64);
constexpr int T_UP = 16 * 2 * (1024 / 64) * (256 / 64);
constexpr int T_DN = 24 * 2 * (256 / 64) * (1024 / 64);
constexpr int T_ALL = T_WIN + T_GLU + T_ATT + T_OUT + T_UP + T_DN;
constexpr int PREP_ITEMS = T_ALL + 32   + 1  ;

DI void pair_experts(int pidx, int& a, int& b) {
    a = pidx < 3 ? 0 : (pidx < 5 ? 1 : 2);
    b = pidx < 3 ? pidx + 1 : (pidx < 5 ? pidx - 1 : 3);
}

DI void prep_tconv(const Params& p, int t, float* sm) {
    const int L = p.layer;
    char* ws = p.ws;
    if (t < T_WIN) { const int kb = t / (INC / 64), nb = t % (INC / 64);
        tconv_tile(p.in[2] + (size_t)L * 1024 * INC, INC, (u16*)(ws + OFF_WIN), 1024, 0, 1, 0, p.in[1] + L * 1024, kb * 64, nb * 64, sm); return; }
    t -= T_WIN;
    if (t < T_GLU) { const int half = t / 128, r = t % 128, kb = r / 16, nb = r % 16;
        tconv_tile(p.in[half ? 12 : 11] + (size_t)L * 512 * 1024, 1024, (u16*)(ws + OFF_WGLU), 512, 0, 2, half, nullptr, kb * 64, nb * 64, sm); return; }
    t -= T_GLU;
    if (t < T_ATT) { const int kb = t / 16, nb = t % 16;
        tconv_tile(p.in[16] + (size_t)L * 512 * 1024, 1024, (u16*)(ws + OFF_WATT), 512, 0, 1, 0, nullptr, kb * 64, nb * 64, sm); return; }
    t -= T_ATT;
    if (t < T_OUT) { const int kb = t / 16, nb = t % 16;
        tconv_tile(p.in[17] + (size_t)L * 1024 * 1024, 1024, (u16*)(ws + OFF_WOUT), 1024, 0, 1, 0, nullptr, kb * 64, nb * 64, sm); return; }
    t -= T_OUT;
    if (t < T_UP) { const int e = t / 128, r = t % 128, half = r / 64, r2 = r % 64, kb = r2 / 4, nb = r2 % 4;
        tconv_tile(p.in[21] + ((size_t)(L * 16 + e) * 1024) * 512 + half * 256, 512, (u16*)(ws + OFF_WUP) + (size_t)e * 512 * 1024, 1024, 0, 2, half, p.in[18] + L * 1024, kb * 64, nb * 64, sm); return; }
    t -= T_UP;
    { const int pr = t / 128, r = t % 128, slot = r / 64, r2 = r % 64, kb = r2 / 16, nb = r2 % 16;
      const int grp = pr / 6; int a, b; pair_experts(pr % 6, a, b); const int e = grp * 4 + (slot ? b : a);
      tconv_tile(p.in[22] + ((size_t)(L * 16 + e) * 256) * 1024, 1024, (u16*)(ws + OFF_WDN) + (size_t)pr * 1024 * 512, 512, slot * 256, 1, 0, nullptr, kb * 64, nb * 64, sm); }
}

DI void prep_s5_group(const Params& p, int g, float* sm) {
    const int L = p.layer, tid = threadIdx.x;
    float* LBre = sm;
    float* LBim = LBre + 33 * 64;
    float* BBre = LBim + 33 * 64;
    float* BBim = BBre + 1024;
    float* Cre = BBim + 1024;
    float* Cim = Cre + 1024;
    float* Kt = Cim + 1024;
    const float* lam_re = p.in[3] + (size_t)(L * 32 + g) * 64;
    const float* lam_im = p.in[4] + (size_t)(L * 32 + g) * 64;
    const float dt = expf(p.in[5][L * 32 + g]);
    const float* b_re = p.in[6] + (size_t)(L * 32 + g) * 1024;
    const float* b_im = p.in[7] + (size_t)(L * 32 + g) * 1024;
    const float* c_re = p.in[8] + (size_t)(L * 32 + g) * 1024;
    const float* c_im = p.in[9] + (size_t)(L * 32 + g) * 1024;
    const float* dsk = p.in[10] + L * 512 + g * 16;
    for (int i = tid; i < 33 * 64; i += NTHR) {
        const int lag = i >> 6, pp = i & 63;
        const float mag = expf(lam_re[pp] * dt * (float)lag);
        double a = (double)lam_im[pp] * (double)dt * (double)lag;
        a -= 6.283185307179586476925 * rint(a * 0.15915494309189533577);
        const float af = (float)a;
        LBre[i] = mag * cosf(af); LBim[i] = mag * sinf(af);
    }
    for (int i = tid; i < 1024; i += NTHR) { Cre[i] = c_re[i]; Cim[i] = c_im[i]; }
    for (int i = tid; i < 1024; i += NTHR) {
        const int pp = i >> 4;
        const float lr = lam_re[pp], li = lam_im[pp];
        const float a = lr * dt; const float bb = li * dt;
        double br = (double)bb; br -= 6.283185307179586476925 * rint(br * 0.15915494309189533577);
        const float bf = (float)br;
        const float sh = sinf(0.5f * bf);
        const float xr = expm1f(a) * cosf(bf) - 2.0f * sh * sh;
        const float xi = expf(a) * sinf(bf);
        const float den = 1.0f / (lr * lr + li * li);
        const float fr = (xr * lr + xi * li) * den, fi = (xi * lr - xr * li) * den;
        const float vr = b_re[i], vi = b_im[i];
        BBre[i] = fr * vr - fi * vi; BBim[i] = fr * vi + fi * vr;
    }
    __syncthreads();
    if (tid < 64) { float* LT = (float*)(p.ws + OFF_LT) + (size_t)(g * 64 + tid) * 2; LT[0] = LBre[32 * 64 + tid]; LT[1] = LBim[32 * 64 + tid]; }
    for (int i = tid; i < 32 * 256; i += NTHR) {
        const int lag = i >> 8, ho = (i >> 4) & 15, hi = i & 15;
        float acc = 0.f;
        for (int pp = 0; pp < 64; ++pp) {
            const float cr = Cre[ho * 64 + pp], ci = Cim[ho * 64 + pp];
            const float lr = LBre[lag * 64 + pp], li = LBim[lag * 64 + pp];
            const float tr = cr * lr - ci * li, ti = cr * li + ci * lr;
            acc += tr * BBre[pp * 16 + hi] - ti * BBim[pp * 16 + hi];
        }
        Kt[i] = acc;
    }
    __syncthreads();
    u16* W1 = (u16*)(p.ws + OFF_W1T) + (size_t)g * 128 * 512;
    for (int i = tid; i < 128 * 256; i += NTHR) {
        const int n = i >> 8, k = (i & 255) * 2, pp = n >> 1, ri = n & 1, j = k >> 4, hi = k & 15;
        const float lr = LBre[(31 - j) * 64 + pp], li = LBim[(31 - j) * 64 + pp];
        float v[2];
#pragma unroll
        for (int e = 0; e < 2; ++e) { const float br = BBre[pp * 16 + hi + e], bi = BBim[pp * 16 + hi + e]; v[e] = ri ? (lr * bi + li * br) : (lr * br - li * bi); }
        *(unsigned*)(W1 + (size_t)n * 512 + k) = pk2(v[0], v[1]);
    }
    u16* W2 = (u16*)(p.ws + OFF_W2T) + (size_t)g * 512 * 640;
    for (int idx = tid; idx < 512 * 320; idx += NTHR) {
        const int n = idx / 320, k = (idx % 320) * 2, ii = n >> 4, ho = n & 15;
        float v[2];
        if (k < 512) {
            const int j = k >> 4, hi = k & 15;
#pragma unroll
            for (int e = 0; e < 2; ++e) {
                float x = 0.f;
                if (j <= ii) x = Kt[(ii - j) * 256 + ho * 16 + hi + e];
                if (j == ii && hi + e == ho) x += dsk[ho];
                v[e] = x;
            }
        } else {
            const int pp = (k - 512) >> 1;
            const float cr = Cre[ho * 64 + pp], ci = Cim[ho * 64 + pp];
            const float lr = LBre[(ii + 1) * 64 + pp], li = LBim[(ii + 1) * 64 + pp];
            v[0] = cr * lr - ci * li; v[1] = -(cr * li + ci * lr);
        }
        *(unsigned*)(W2 + (size_t)n * 640 + k) = pk2(v[0], v[1]);
    }
    __syncthreads();
}

DI void prep_router_w(const Params& p) {
    const int L = p.layer;
    float* WR = (float*)(p.ws + OFF_WR);
    const float* nf = p.in[18] + L * 1024;
    const float* wc = p.in[19] + (size_t)L * 1024 * 4;
    const float* wf = p.in[20] + (size_t)L * 1024 * 16;
    for (int i = threadIdx.x; i < 20 * 1024; i += NTHR) {
        const int n = i >> 10, k = i & 1023;
        WR[i] = nf[k] * (n < 4 ? wc[k * 4 + n] : wf[k * 16 + (n - 4)]);
    }
}

DI void phase_prep(const Params& p, char* lds) {
    float* sm = (float*)lds;
    for (int it = blockIdx.x; it < PREP_ITEMS; it += gridDim.x) {
        if (it < 32) prep_s5_group(p, it, sm);
        else if (it == 32) prep_router_w(p);
        else prep_tconv(p, it - 33, sm);
    }
}

DI void phase_xb(const Params& p) {
    const float* X = p.layer == 0 ? p.in[0] : p.out;
    u16* XB = (u16*)(p.ws + OFF_R1);
    float* rstd = (float*)(p.ws + OFF_RSTD1);
    const int lane = threadIdx.x & 63, w = threadIdx.x >> 6;
    for (int row = blockIdx.x * 8 + w; row < NTOK; row += gridDim.x * 8) {
        const f32x4* xr = (const f32x4*)(X + (size_t)row * DM) + lane;
        f32x4 v[4]; float s = 0.f;
#pragma unroll
        for (int j = 0; j < 4; ++j) { v[j] = xr[64 * j]; s += v[j].x * v[j].x + v[j].y * v[j].y + v[j].z * v[j].z + v[j].w * v[j].w; }
#pragma unroll
        for (int o = 1; o < 64; o <<= 1) s += __shfl_xor(s, o);
        u32x2* o8 = (u32x2*)(XB + (size_t)row * DM) + lane;
#pragma unroll
        for (int j = 0; j < 4; ++j) { u32x2 q; q.x = pk2(v[j].x, v[j].y); q.y = pk2(v[j].z, v[j].w); o8[64 * j] = q; }
        if (lane == 0) rstd[row] = rsqrtf(s * (1.0f / DM) + 1e-6f);
    }
}

constexpr int LDT = 72;
template <class J>
DI void gemm_phase(const J& jb, char* lds) {
    const int tid = threadIdx.x, lane = tid & 63, w = tid >> 6, fr = lane & 15, fq = lane >> 4;
    const int wm = w >> 1, wn = w & 1;
    u16* As = (u16*)lds;
    u16* Bs = As + 2 * 128 * LDT;
    const int nu = jb.num_units();
    const int nk = jb.ktiles();
    const size_t akstep = jb.a_kstep();
    for (int u = blockIdx.x; u < nu; u += gridDim.x) {
        const typename J::Unit un = jb.unit(u);
        const char* pa[2]; const char* pb[2]; int so[2];
#pragma unroll
        for (int i = 0; i < 2; ++i) { const int pc = tid + 512 * i, r = pc >> 3, c = pc & 7; pa[i] = jb.a_ptr(un, r, c); pb[i] = jb.b_ptr(un, r, c); so[i] = r * LDT + c * 8; }
        f32x4 acc[2][4];
#pragma unroll
        for (int mi = 0; mi < 2; ++mi)
#pragma unroll
            for (int ni = 0; ni < 4; ++ni) acc[mi][ni] = (f32x4){0.f, 0.f, 0.f, 0.f};
        u32x4 ra[2], rb[2];
#pragma unroll
        for (int i = 0; i < 2; ++i) { ra[i] = *(const u32x4*)pa[i]; rb[i] = *(const u32x4*)pb[i]; }
#pragma unroll
        for (int i = 0; i < 2; ++i) { *(u32x4*)(As + so[i]) = ra[i]; *(u32x4*)(Bs + so[i]) = rb[i]; }
        __syncthreads();
        for (int kt = 0; kt < nk; ++kt) {
            const int cur = kt & 1;
            if (kt + 1 < nk) {
#pragma unroll
                for (int i = 0; i < 2; ++i) { ra[i] = *(const u32x4*)(pa[i] + (size_t)(kt + 1) * akstep); rb[i] = *(const u32x4*)(pb[i] + (size_t)(kt + 1) * 128); }
            }
            const u16* Ab = As + cur * 128 * LDT; const u16* Bb = Bs + cur * 128 * LDT;
#pragma unroll
            for (int ks = 0; ks < 2; ++ks) {
                bf16x8 af[2], bfr[4];
#pragma unroll
                for (int mi = 0; mi < 2; ++mi) af[mi] = *(const bf16x8*)(Ab + (wm * 32 + mi * 16 + fr) * LDT + ks * 32 + fq * 8);
#pragma unroll
                for (int ni = 0; ni < 4; ++ni) bfr[ni] = *(const bf16x8*)(Bb + (wn * 64 + ni * 16 + fr) * LDT + ks * 32 + fq * 8);
#pragma unroll
                for (int mi = 0; mi < 2; ++mi)
#pragma unroll
                    for (int ni = 0; ni < 4; ++ni) acc[mi][ni] = mfma16(bfr[ni], af[mi], acc[mi][ni]);
            }
            if (kt + 1 < nk) {
                u16* An = As + (cur ^ 1) * 128 * LDT; u16* Bn = Bs + (cur ^ 1) * 128 * LDT;
#pragma unroll
                for (int i = 0; i < 2; ++i) { *(u32x4*)(An + so[i]) = ra[i]; *(u32x4*)(Bn + so[i]) = rb[i]; }
            }
            __syncthreads();
        }
#pragma unroll
        for (int mi = 0; mi < 2; ++mi)
#pragma unroll
            for (int ni = 0; ni < 4; ++ni) jb.epi(un, wm * 32 + mi * 16 + fr, wn * 64 + ni * 16 + 4 * fq, acc[mi][ni]);
    }
}

struct UnitMN { int m0, n0; };

struct JobInProj {
    typedef UnitMN Unit;
    const char* A; const char* B; const float* rstd; u16* A2; u16* Q; u16* KV; u16* SGS; u16* SGA;
    DI int num_units() const { return (NTOK / 128) * (INC / 128); }
    DI Unit unit(int u) const { Unit x; x.m0 = (u / (INC / 128)) * 128; x.n0 = (u % (INC / 128)) * 128; return x; }
    DI const char* a_ptr(const Unit& un, int r, int c) const { return A + ((size_t)(un.m0 + r) * 1024 + c * 8) * 2; }
    DI const char* b_ptr(const Unit& un, int r, int c) const { return B + ((size_t)(un.n0 + r) * 1024 + c * 8) * 2; }
    DI size_t a_kstep() const { return 128; }
    DI int ktiles() const { return 16; }
    DI void epi(const Unit& un, int r, int c, f32x4 v) const {
        const int row = un.m0 + r, col = un.n0 + c;
        const float s = rstd[row];
        v = v * s;
        if (col < 512) {
            const int g = col >> 4, ho = col & 15, b = row >> 11, t = row & 2047, ch = t >> 5, i = t & 31;
            u32x2 o; o.x = pk2(v.x, v.y); o.y = pk2(v.z, v.w);
            *(u32x2*)(A2 + ((size_t)(g * S5M + b * NCH + ch) * S5K2 + i * 16 + ho)) = o;
        } else if (col < 1024) {
            u32x2 o; o.x = pk2(v.x, v.y); o.y = pk2(v.z, v.w);
            *(u32x2*)(Q + (size_t)row * 512 + (col - 512)) = o;
        } else if (col < 1280) {
            u32x2 o; o.x = pk2(v.x, v.y); o.y = pk2(v.z, v.w);
            *(u32x2*)(KV + (size_t)row * 256 + (col - 1024)) = o;
        } else if (col < 2304) {
            u32x2 o; o.x = pk2(sigmoidf_(v.x), sigmoidf_(v.y)); o.y = pk2(sigmoidf_(v.z), sigmoidf_(v.w));
            *(u32x2*)(SGS + (size_t)row * 1024 + (col - 1280)) = o;
        } else {
            u32x2 o; o.x = pk2(sigmoidf_(v.x), sigmoidf_(v.y)); o.y = pk2(sigmoidf_(v.z), sigmoidf_(v.w));
            *(u32x2*)(SGA + (size_t)row * 1024 + (col - 2304)) = o;
        }
    }
};

struct UnitG { int g, m0, n0; };
struct JobS5G1 {
    typedef UnitG Unit;
    const char* A2; const char* W1; float* Sloc;
    DI int num_units() const { return 32 * (S5M / 128); }
    DI Unit unit(int u) const { Unit x; x.g = u / (S5M / 128); x.m0 = (u % (S5M / 128)) * 128; x.n0 = 0; return x; }
    DI const char* a_ptr(const Unit& un, int r, int c) const { return A2 + ((size_t)(un.g * S5M + un.m0 + r) * S5K2 + c * 8) * 2; }
    DI const char* b_ptr(const Unit& un, int r, int c) const { return W1 + ((size_t)(un.g * 128 + r) * 512 + c * 8) * 2; }
    DI size_t a_kstep() const { return 128; }
    DI int ktiles() const { return S5K1 / 64; }
    DI void epi(const Unit& un, int r, int c, f32x4 v) const { *(f32x4*)(Sloc + (size_t)(un.g * S5M + un.m0 + r) * 128 + c) = v; }
};

struct JobS5G2 {
    typedef UnitG Unit;
    const char* A2; const char* W2; u16* Zp;
    DI int num_units() const { return 32 * (S5M / 128) * 4; }
    DI Unit unit(int u) const { Unit x; x.g = u / ((S5M / 128) * 4); const int r = u % ((S5M / 128) * 4); x.m0 = (r >> 2) * 128; x.n0 = (r & 3) * 128; return x; }
    DI const char* a_ptr(const Unit& un, int r, int c) const { return A2 + ((size_t)(un.g * S5M + un.m0 + r) * S5K2 + c * 8) * 2; }
    DI const char* b_ptr(const Unit& un, int r, int c) const { return W2 + ((size_t)(un.g * 512 + un.n0 + r) * S5K2 + c * 8) * 2; }
    DI size_t a_kstep() const { return 128; }
    DI int ktiles() const { return S5K2 / 64; }
    DI void epi(const Unit& un, int r, int c, f32x4 v) const {
        const int rr = un.m0 + r, n = un.n0 + c, b = rr >> 6, ch = rr & 63, i = n >> 4, ho = n & 15;
        const int tok = b * SEQ + ch * TCH + i;
        u32x2 o; o.x = pk2(gelu_tanh(v.x), gelu_tanh(v.y)); o.y = pk2(gelu_tanh(v.z), gelu_tanh(v.w));
        *(u32x2*)(Zp + ((size_t)un.g * NTOK + tok) * 16 + ho) = o;
    }
};

struct JobGLU {
    typedef UnitMN Unit;
    const char* Zp; const char* B; const u16* SGS; u16* MS;
    DI int num_units() const { return (NTOK / 128) * 16; }
    DI Unit unit(int u) const { Unit x; x.m0 = (u >> 4) * 128; x.n0 = (u & 15) * 128; return x; }
    DI const char* a_ptr(const Unit& un, int r, int c) const { return Zp + ((size_t)(c >> 1) * NTOK + un.m0 + r) * 32 + (c & 1) * 16; }
    DI const char* b_ptr(const Unit& un, int r, int c) const { return B + ((size_t)(un.n0 + r) * 512 + c * 8) * 2; }
    DI size_t a_kstep() const { return (size_t)4 * NTOK * 32; }
    DI int ktiles() const { return 8; }
    DI void epi(const Unit& un, int r, int c, f32x4 v) const {
        const int row = un.m0 + r, j = (un.n0 + c) >> 1;
        const unsigned sg = *(const unsigned*)(SGS + (size_t)row * 1024 + j);
        const float o0 = v.x * sigmoidf_(v.y) * bf_lo(sg), o1 = v.z * sigmoidf_(v.w) * bf_hi(sg);
        *(unsigned*)(MS + (size_t)row * 1024 + j) = pk2(o0, o1);
    }
};

struct JobAttnUp {
    typedef UnitMN Unit;
    const char* A; const char* B; const u16* SGA; u16* MS;
    DI int num_units() const { return (NTOK / 128) * 8; }
    DI Unit unit(int u) const { Unit x; x.m0 = (u >> 3) * 128; x.n0 = (u & 7) * 128; return x; }
    DI const char* a_ptr(const Unit& un, int r, int c) const { return A + ((size_t)(un.m0 + r) * 512 + c * 8) * 2; }
    DI const char* b_ptr(const Unit& un, int r, int c) const { return B + ((size_t)(un.n0 + r) * 512 + c * 8) * 2; }
    DI size_t a_kstep() const { return 128; }
    DI int ktiles() const { return 8; }
    DI void epi(const Unit& un, int r, int c, f32x4 v) const {
        const size_t off = (size_t)(un.m0 + r) * 1024 + un.n0 + c;
        const u32x2 ms = *(const u32x2*)(MS + off), ga = *(const u32x2*)(SGA + off);
        u32x2 o; o.x = pk2(bf_lo(ms.x) + bf_lo(ga.x) * v.x, bf_hi(ms.x) + bf_hi(ga.x) * v.y);
        o.y = pk2(bf_lo(ms.y) + bf_lo(ga.y) * v.z, bf_hi(ms.y) + bf_hi(ga.y) * v.w);
        *(u32x2*)(MS + off) = o;
    }
};

struct JobOut {
    typedef UnitMN Unit;
    const char* A; const char* B; const float* Xin; float* Xout; u16* XB2;
    DI int num_units() const { return (NTOK / 128) * 8; }
    DI Unit unit(int u) const { Unit x; x.m0 = (u >> 3) * 128; x.n0 = (u & 7) * 128; return x; }
    DI const char* a_ptr(const Unit& un, int r, int c) const { return A + ((size_t)(un.m0 + r) * 1024 + c * 8) * 2; }
    DI const char* b_ptr(const Unit& un, int r, int c) const { return B + ((size_t)(un.n0 + r) * 1024 + c * 8) * 2; }
    DI size_t a_kstep() const { return 128; }
    DI int ktiles() const { return 16; }
    DI void epi(const Unit& un, int r, int c, f32x4 v) const {
        const size_t off = (size_t)(un.m0 + r) * 1024 + un.n0 + c;
        const f32x4 x = *(const f32x4*)(Xin + off) + v;
        *(f32x4*)(Xout + off) = x;
        u32x2 o; o.x = pk2(x.x, x.y); o.y = pk2(x.z, x.w);
        *(u32x2*)(XB2 + off) = o;
    }
};

struct UnitMoe { int m0, n0, e0, e1, pr; };
DI void bucket_decode(int bk, int& e0, int& e1) { const int grp = bk / 6; int a, b; pair_experts(bk % 6, a, b); e0 = grp * 4 + a; e1 = grp * 4 + b; }
struct JobMoeUp {
    typedef UnitMoe Unit;
    const char* XB2; const char* WUP; const int* perm; const int* tileb; const int* meta; const float* rstd2; const float* rw; u16* ACT;
    DI int num_units() const { return meta[0] * 8; }
    DI Unit unit(int u) const { Unit x; const int rt = u >> 3; x.m0 = rt * TM; x.n0 = (u & 7) * 128; x.pr = tileb[rt]; bucket_decode(x.pr, x.e0, x.e1); return x; }
    DI const char* a_ptr(const Unit& un, int r, int c) const { int tok = perm[un.m0 + r]; tok = tok < 0 ? 0 : tok; return XB2 + ((size_t)tok * 1024 + c * 8) * 2; }
    DI const char* b_ptr(const Unit& un, int r, int c) const { const int e = un.n0 < 512 ? un.e0 : un.e1; return WUP + ((size_t)(e * 512 + (un.n0 & 511) + r) * 1024 + c * 8) * 2; }
    DI size_t a_kstep() const { return 128; }
    DI int ktiles() const { return 16; }
    DI void epi(const Unit& un, int r, int c, f32x4 v) const {
        const int row = un.m0 + r, tok = perm[row];
        if (tok < 0) return;
        const int slot = un.n0 >> 9, j = ((un.n0 & 511) + c) >> 1;
        const float s = rstd2[tok], wgt = rw[tok * 2 + slot];
        const float g0 = v.x * s, u0 = v.y * s, g1 = v.z * s, u1 = v.w * s;
        const float a0 = g0 * sigmoidf_(g0) * u0 * wgt, a1 = g1 * sigmoidf_(g1) * u1 * wgt;
        *(unsigned*)(ACT + (size_t)row * 512 + slot * 256 + j) = pk2(a0, a1);
    }
};

struct JobMoeDown {
    typedef UnitMoe Unit;
    const char* ACT; const char* WDN; const int* perm; const int* tileb; const int* meta; float* X;
    DI int num_units() const { return meta[0] * 8; }
    DI Unit unit(int u) const { Unit x; const int rt = u >> 3; x.m0 = rt * TM; x.n0 = (u & 7) * 128; x.pr = tileb[rt]; x.e0 = 0; x.e1 = 0; return x; }
    DI const char* a_ptr(const Unit& un, int r, int c) const { return ACT + ((size_t)(un.m0 + r) * 512 + c * 8) * 2; }
    DI const char* b_ptr(const Unit& un, int r, int c) const { return WDN + ((size_t)(un.pr * 1024 + un.n0 + r) * 512 + c * 8) * 2; }
    DI size_t a_kstep() const { return 128; }
    DI int ktiles() const { return 8; }
    DI void epi(const Unit& un, int r, int c, f32x4 v) const {
        const int tok = perm[un.m0 + r];
        if (tok < 0) return;
        float* xp = X + (size_t)tok * 1024 + un.n0 + c;
        *(f32x4*)xp = *(const f32x4*)xp + v;
    }
};

DI void phase_scan(const Params& p) {
    const float* Sloc = (const float*)(p.ws + OFF_SLOC);
    const float* LT = (const float*)(p.ws + OFF_LT);
    u16* A2 = (u16*)(p.ws + OFF_A2);
    for (int idx = blockIdx.x * NTHR + threadIdx.x; idx < 32 * NBATCH * 64; idx += gridDim.x * NTHR) {
        const int pp = idx & 63, b = (idx >> 6) & 15, g = idx >> 10;
        const float ar = LT[(g * 64 + pp) * 2], ai = LT[(g * 64 + pp) * 2 + 1];
        float sr = 0.f, si = 0.f;
        const size_t r0 = (size_t)g * S5M + b * NCH;
#pragma unroll 8
        for (int c = 0; c < NCH; ++c) {
            *(unsigned*)(A2 + (r0 + c) * S5K2 + S5K1 + 2 * pp) = pk2(sr, si);
            const f32x2 l = *(const f32x2*)(Sloc + (r0 + c) * 128 + 2 * pp);
            const float nr = ar * sr - ai * si + l.x, ni = ar * si + ai * sr + l.y;
            sr = nr; si = ni;
        }
    }
}

DI void phase_attn(const Params& p, char* lds) {
    u16* Ks = (u16*)lds;
    u16* Vt = Ks + 256 * 72;
    const u16* Qg = (const u16*)(p.ws + OFF_Q);
    const u16* KVg = (const u16*)(p.ws + OFF_KV);
    u16* YA = (u16*)(p.ws + OFF_YA);
    const int L = p.layer;
    const float* qn = p.in[13] + L * 64; const float* kn = p.in[14] + L * 64; const float* sinks = p.in[15] + L * 8;
    const int tid = threadIdx.x, lane = tid & 63, w = tid >> 6, r = lane & 31, hh = lane >> 5;
    for (int u = blockIdx.x; u < NBATCH * 16 * 2; u += gridDim.x) {
        const int kvh = u & 1, nb = (u >> 1) & 15, b = u >> 5;
        const int tok0 = b * SEQ + nb * 128;
#pragma unroll
        for (int i = 0; i < 4; ++i) {
            const int pc = tid + 512 * i, key = pc >> 3, dc = pc & 7;
            const bool valid = (nb > 0) || (key >= 128);
            u32x4 kr = {0u, 0u, 0u, 0u}, vr = {0u, 0u, 0u, 0u};
            if (valid) { const u16* src = KVg + (size_t)(tok0 - 128 + key) * 256 + kvh * 64 + dc * 8; kr = *(const u32x4*)src; vr = *(const u32x4*)(src + 128); }
            float kf[8];
            kf[0] = bf_lo(kr.x); kf[1] = bf_hi(kr.x); kf[2] = bf_lo(kr.y); kf[3] = bf_hi(kr.y); kf[4] = bf_lo(kr.z); kf[5] = bf_hi(kr.z); kf[6] = bf_lo(kr.w); kf[7] = bf_hi(kr.w);
            float ss = 0.f;
#pragma unroll
            for (int e = 0; e < 8; ++e) ss += kf[e] * kf[e];
            ss += __shfl_xor(ss, 1); ss += __shfl_xor(ss, 2); ss += __shfl_xor(ss, 4);
            const float rs = rsqrtf(ss * (1.0f / 64.0f) + 1e-6f);
            const f32x4 g0 = *(const f32x4*)(kn + dc * 8), g1 = *(const f32x4*)(kn + dc * 8 + 4);
            u32x4 ko;
            ko.x = pk2(kf[0] * rs * g0.x, kf[1] * rs * g0.y); ko.y = pk2(kf[2] * rs * g0.z, kf[3] * rs * g0.w);
            ko.z = pk2(kf[4] * rs * g1.x, kf[5] * rs * g1.y); ko.w = pk2(kf[6] * rs * g1.z, kf[7] * rs * g1.w);
            *(u32x4*)(Ks + key * 72 + dc * 8) = ko;
            u16* vd = Vt + (dc * 8) * 260 + key;
            vd[0 * 260] = (u16)(vr.x & 0xffff); vd[1 * 260] = (u16)(vr.x >> 16); vd[2 * 260] = (u16)(vr.y & 0xffff); vd[3 * 260] = (u16)(vr.y >> 16);
            vd[4 * 260] = (u16)(vr.z & 0xffff); vd[5 * 260] = (u16)(vr.z >> 16); vd[6 * 260] = (u16)(vr.w & 0xffff); vd[7 * 260] = (u16)(vr.w >> 16);
        }
        __syncthreads();
        const int gq = w >> 1, h = kvh * 4 + gq, qhalf = w & 1;
        const float slope = exp2f(-(float)(h + 1)), sink = sinks[h];
#pragma unroll 1
        for (int qt = 0; qt < 2; ++qt) {
            const int i0 = qhalf * 64 + qt * 32;
            const int qtok = tok0 + i0 + r;
            bf16x8 qf[4];
            {
                u32x4 qr[4]; float ss = 0.f;
#pragma unroll
                for (int s = 0; s < 4; ++s) {
                    qr[s] = *(const u32x4*)(Qg + (size_t)qtok * 512 + h * 64 + 16 * s + 8 * hh);
                    const float a0 = bf_lo(qr[s].x), a1 = bf_hi(qr[s].x), a2 = bf_lo(qr[s].y), a3 = bf_hi(qr[s].y), a4 = bf_lo(qr[s].z), a5 = bf_hi(qr[s].z), a6 = bf_lo(qr[s].w), a7 = bf_hi(qr[s].w);
                    ss += a0 * a0 + a1 * a1 + a2 * a2 + a3 * a3 + a4 * a4 + a5 * a5 + a6 * a6 + a7 * a7;
                }
                ss += __shfl_xor(ss, 32);
                const float rs = rsqrtf(ss * (1.0f / 64.0f) + 1e-6f) * 0.125f;
#pragma unroll
                for (int s = 0; s < 4; ++s) {
                    const f32x4 g0 = *(const f32x4*)(qn + 16 * s + 8 * hh), g1 = *(const f32x4*)(qn + 16 * s + 8 * hh + 4);
                    u32x4 o;
                    o.x = pk2(bf_lo(qr[s].x) * rs * g0.x, bf_hi(qr[s].x) * rs * g0.y); o.y = pk2(bf_lo(qr[s].y) * rs * g0.z, bf_hi(qr[s].y) * rs * g0.w);
                    o.z = pk2(bf_lo(qr[s].z) * rs * g1.x, bf_hi(qr[s].z) * rs * g1.y); o.w = pk2(bf_lo(qr[s].w) * rs * g1.z, bf_hi(qr[s].w) * rs * g1.w);
                    qf[s] = __builtin_bit_cast(bf16x8, o);
                }
            }
            const int kt0 = i0 >> 5;
            const int qi = i0 + r;
            const int dbase = qi + 128 - kt0 * 32 - 4 * hh;
            const int maxd = nb > 0 ? 127 : (qi < 127 ? qi : 127);
            f32x16 o[2];
#pragma unroll
            for (int db = 0; db < 2; ++db)
#pragma unroll
                for (int e = 0; e < 16; ++e) o[db][e] = 0.f;
            float m = sink, l = 0.f;
#pragma unroll
            for (int kt = 0; kt < 5; ++kt) {
                f32x16 sc;
#pragma unroll
                for (int e = 0; e < 16; ++e) sc[e] = 0.f;
#pragma unroll
                for (int s = 0; s < 4; ++s) {
                    const bf16x8 kfr = *(const bf16x8*)(Ks + ((kt0 + kt) * 32 + r) * 72 + 16 * s + 8 * hh);
                    sc = mfma32(kfr, qf[s], sc);
                }
                float tm = -1e30f;
#pragma unroll
                for (int e = 0; e < 16; ++e) {
                    const int dist = dbase - (32 * kt + (e & 3) + 8 * (e >> 2));
                    const bool ok = (unsigned)dist <= (unsigned)maxd;
                    const float v = ok ? sc[e] - slope * (float)dist : -1e30f;
                    sc[e] = v; tm = fmaxf(tm, v);
                }
                tm = fmaxf(tm, __shfl_xor(tm, 32));
                const float mn = fmaxf(m, tm);
                const float alpha = __expf(m - mn);
                m = mn;
                float ls = 0.f;
#pragma unroll
                for (int e = 0; e < 16; ++e) { const float pv = __expf(sc[e] - mn); sc[e] = pv; ls += pv; }
                l = l * alpha + ls;
#pragma unroll
                for (int db = 0; db < 2; ++db)
#pragma unroll
                    for (int e = 0; e < 16; ++e) o[db][e] *= alpha;
#pragma unroll
                for (int s2 = 0; s2 < 2; ++s2) {
                    u32x4 pp;
                    pp.x = pk2(sc[8 * s2 + 0], sc[8 * s2 + 1]); pp.y = pk2(sc[8 * s2 + 2], sc[8 * s2 + 3]);
                    pp.z = pk2(sc[8 * s2 + 4], sc[8 * s2 + 5]); pp.w = pk2(sc[8 * s2 + 6], sc[8 * s2 + 7]);
                    const bf16x8 pf = __builtin_bit_cast(bf16x8, pp);
                    const int kb = (kt0 + kt) * 32 + 16 * s2 + 4 * hh;
#pragma unroll
                    for (int db = 0; db < 2; ++db) {
                        const u16* vp = Vt + (db * 32 + r) * 260 + kb;
                        const s16x4 lo = *(const s16x4*)vp, hi = *(const s16x4*)(vp + 8);
                        const bf16x8 vf = __builtin_shufflevector(lo, hi, 0, 1, 2, 3, 4, 5, 6, 7);
                        o[db] = mfma32(vf, pf, o[db]);
                    }
                }
                asm volatile("" ::: "memory");
            }
            l += __shfl_xor(l, 32);
            l += __expf(sink - m);
            const float inv = 1.0f / l;
#pragma unroll
            for (int db = 0; db < 2; ++db)
#pragma unroll
                for (int q4 = 0; q4 < 4; ++q4) {
                    const int d = db * 32 + 8 * q4 + 4 * hh;
                    u32x2 ov; ov.x = pk2(o[db][4 * q4] * inv, o[db][4 * q4 + 1] * inv); ov.y = pk2(o[db][4 * q4 + 2] * inv, o[db][4 * q4 + 3] * inv);
                    *(u32x2*)(YA + (size_t)qtok * 512 + h * 64 + d) = ov;
                }
        }
        __syncthreads();
    }
}

DI void route_token(const float (&lg)[20], int& bucket, float& w0, float& w1) {
    int gi = 0; float gm = lg[0];
#pragma unroll
    for (int j = 1; j < 4; ++j) if (lg[j] > gm) { gm = lg[j]; gi = j; }
    float den = 0.f;
#pragma unroll
    for (int j = 0; j < 4; ++j) den += __expf(lg[j] - gm);
    const float gp = 1.0f / den;
    float f[4];
#pragma unroll
    for (int j = 0; j < 4; ++j) f[j] = gi == 0 ? lg[4 + j] : (gi == 1 ? lg[8 + j] : (gi == 2 ? lg[12 + j] : lg[16 + j]));
    int i1 = 0; float v1 = f[0];
#pragma unroll
    for (int j = 1; j < 4; ++j) if (f[j] > v1) { v1 = f[j]; i1 = j; }
    int i2 = -1; float v2 = -3.0e38f;
#pragma unroll
    for (int j = 0; j < 4; ++j) if (j != i1 && f[j] > v2) { v2 = f[j]; i2 = j; }
    const float e2 = __expf(v2 - v1);
    const float p1 = gp / (1.0f + e2), p2 = gp * e2 / (1.0f + e2);
    const int a = i1 < i2 ? i1 : i2, b = i1 < i2 ? i2 : i1;
    const int pidx = a == 0 ? b - 1 : (a == 1 ? b + 1 : 5);
    bucket = gi * 6 + pidx;
    w0 = i1 < i2 ? p1 : p2; w1 = i1 < i2 ? p2 : p1;
}

DI void phase_router(const Params& p, char* lds) {
    float* Wl = (float*)lds;
    int* hist = (int*)(lds + 20 * 1024 * 4);
    const float* WR = (const float*)(p.ws + OFF_WR);
    const float* X = p.out;
    float* rstd2 = (float*)(p.ws + OFF_RSTD2);
    int* bucket = (int*)(p.ws + OFF_BUCKET);
    float* rw = (float*)(p.ws + OFF_RW);
    int* cnt = (int*)(p.ws + OFF_CNT);
    const int tid = threadIdx.x, lane = tid & 63, w = tid >> 6;
    for (int i = tid; i < 20 * 1024 / 4; i += NTHR) ((f32x4*)Wl)[i] = ((const f32x4*)WR)[i];
    for (int rb = blockIdx.x; rb < 256; rb += gridDim.x) {
        if (tid < 24) hist[tid] = 0;
        __syncthreads();
#pragma unroll 1
        for (int it = 0; it < 4; ++it) {
            const int tokb = rb * 128 + w * 16 + it * 4;
            float acc[4][20]; float ssq[4];
#pragma unroll
            for (int t = 0; t < 4; ++t) { ssq[t] = 0.f;
#pragma unroll
                for (int n = 0; n < 20; ++n) acc[t][n] = 0.f; }
#pragma unroll
            for (int i = 0; i < 4; ++i) {
                f32x4 xv[4];
#pragma unroll
                for (int t = 0; t < 4; ++t) { xv[t] = *((const f32x4*)(X + (size_t)(tokb + t) * DM) + lane + 64 * i); ssq[t] += xv[t].x * xv[t].x + xv[t].y * xv[t].y + xv[t].z * xv[t].z + xv[t].w * xv[t].w; }
#pragma unroll
                for (int n = 0; n < 20; ++n) {
                    const f32x4 wv = *((const f32x4*)(Wl + n * 1024) + lane + 64 * i);
#pragma unroll
                    for (int t = 0; t < 4; ++t) acc[t][n] += xv[t].x * wv.x + xv[t].y * wv.y + xv[t].z * wv.z + xv[t].w * wv.w;
                }
            }
#pragma unroll
            for (int t = 0; t < 4; ++t) {
#pragma unroll
                for (int o = 1; o < 64; o <<= 1) ssq[t] += __shfl_xor(ssq[t], o);
#pragma unroll
                for (int n = 0; n < 20; ++n) {
#pragma unroll
                    for (int o = 1; o < 64; o <<= 1) acc[t][n] += __shfl_xor(acc[t][n], o);
                }
            }
#pragma unroll
            for (int t = 0; t < 4; ++t) {
                const float rs = rsqrtf(ssq[t] * (1.0f / DM) + 1e-6f);
                float lg[20];
#pragma unroll
                for (int n = 0; n < 20; ++n) lg[n] = acc[t][n] * rs;
                int bk; float w0, w1;
                route_token(lg, bk, w0, w1);
                if (lane == 0) {
                    const int tok = tokb + t;
                    rstd2[tok] = rs; bucket[tok] = bk; rw[tok * 2] = w0; rw[tok * 2 + 1] = w1;
                    atomicAdd(&hist[bk], 1);
                }
            }
        }
        __syncthreads();
        if (tid < 24) cnt[rb * 24 + tid] = hist[tid];
        __syncthreads();
    }
}

DI void phase_perm(const Params& p, char* lds) {
    int* tot = (int*)lds;
    int* pre = tot + 32;
    int* base = pre + 32;
    int* lb = base + 32;
    const int* cnt = (const int*)(p.ws + OFF_CNT);
    const int* bucket = (const int*)(p.ws + OFF_BUCKET);
    int* perm = (int*)(p.ws + OFF_PERM);
    int* tileb = (int*)(p.ws + OFF_TILEB);
    int* meta = (int*)(p.ws + OFF_META);
    const int tid = threadIdx.x;
    for (int rb = blockIdx.x; rb < 256; rb += gridDim.x) {
        if (tid < 24) { int t = 0, pr = 0; for (int j = 0; j < 256; ++j) { const int c = cnt[j * 24 + tid]; t += c; if (j < rb) pr += c; } tot[tid] = t; pre[tid] = pr; }
        if (tid >= 64 && tid < 64 + 128) lb[tid - 64] = bucket[rb * 128 + tid - 64];
        __syncthreads();
        if (tid == 0) { int b = 0; for (int t = 0; t < 24; ++t) { base[t] = b; b += ((tot[t] + TM - 1) / TM) * TM; } base[24] = b; }
        __syncthreads();
        if (tid < 128) {
            const int bk = lb[tid]; int rank = 0;
            for (int t = 0; t < tid; ++t) rank += (lb[t] == bk) ? 1 : 0;
            perm[base[bk] + pre[bk] + rank] = rb * 128 + tid;
        }
        if (rb == 0) {
            for (int t = 0; t < 24; ++t) { const int e = base[t + 1] - base[t]; for (int r = tot[t] + tid; r < e; r += NTHR) perm[base[t] + r] = -1; }
            const int nt = base[24] / TM;
            for (int t = tid; t < nt; t += NTHR) { int bk = 0; for (int q = 1; q < 24; ++q) if (t * TM >= base[q]) bk = q; tileb[t] = bk; }
            if (tid == 0) meta[0] = nt;
        }
        __syncthreads();
    }
}

DI JobInProj mk_inproj(const Params& p) { JobInProj j; j.A = p.ws + OFF_R1; j.B = p.ws + OFF_WIN; j.rstd = (const float*)(p.ws + OFF_RSTD1); j.A2 = (u16*)(p.ws + OFF_A2); j.Q = (u16*)(p.ws + OFF_Q); j.KV = (u16*)(p.ws + OFF_KV); j.SGS = (u16*)(p.ws + OFF_R2); j.SGA = (u16*)(p.ws + OFF_R3); return j; }
DI JobS5G1 mk_g1(const Params& p) { JobS5G1 j; j.A2 = p.ws + OFF_A2; j.W1 = p.ws + OFF_W1T; j.Sloc = (float*)(p.ws + OFF_SLOC); return j; }
DI JobS5G2 mk_g2(const Params& p) { JobS5G2 j; j.A2 = p.ws + OFF_A2; j.W2 = p.ws + OFF_W2T; j.Zp = (u16*)(p.ws + OFF_Z); return j; }
DI JobGLU mk_glu(const Params& p) { JobGLU j; j.Zp = p.ws + OFF_Z; j.B = p.ws + OFF_WGLU; j.SGS = (const u16*)(p.ws + OFF_R2); j.MS = (u16*)(p.ws + OFF_R1); return j; }
DI JobAttnUp mk_attnup(const Params& p) { JobAttnUp j; j.A = p.ws + OFF_YA; j.B = p.ws + OFF_WATT; j.SGA = (const u16*)(p.ws + OFF_R3); j.MS = (u16*)(p.ws + OFF_R1); return j; }
DI JobOut mk_out(const Params& p) { JobOut j; j.A = p.ws + OFF_R1; j.B = p.ws + OFF_WOUT; j.Xin = p.layer == 0 ? p.in[0] : p.out; j.Xout = p.out; j.XB2 = (u16*)(p.ws + OFF_R2); return j; }
DI JobMoeUp mk_moeup(const Params& p) { JobMoeUp j; j.XB2 = p.ws + OFF_R2; j.WUP = p.ws + OFF_WUP; j.perm = (const int*)(p.ws + OFF_PERM); j.tileb = (const int*)(p.ws + OFF_TILEB); j.meta = (const int*)(p.ws + OFF_META); j.rstd2 = (const float*)(p.ws + OFF_RSTD2); j.rw = (const float*)(p.ws + OFF_RW); j.ACT = (u16*)(p.ws + OFF_R3); return j; }
DI JobMoeDown mk_moedown(const Params& p) { JobMoeDown j; j.ACT = p.ws + OFF_R3; j.WDN = p.ws + OFF_WDN; j.perm = (const int*)(p.ws + OFF_PERM); j.tileb = (const int*)(p.ws + OFF_TILEB); j.meta = (const int*)(p.ws + OFF_META); j.X = p.out; return j; }

extern __shared__ __attribute__((aligned(16))) char smem[];
__global__ void __launch_bounds__(NTHR) k_prep(Params p) { phase_prep(p, smem); }
__global__ void __launch_bounds__(NTHR) k_xb(Params p) { phase_xb(p); }
__global__ void __launch_bounds__(NTHR) k_inproj(Params p) { gemm_phase(mk_inproj(p), smem); }
__global__ void __launch_bounds__(NTHR) k_g1(Params p) { gemm_phase(mk_g1(p), smem); }
__global__ void __launch_bounds__(NTHR) k_scan(Params p) { phase_scan(p); }
__global__ void __launch_bounds__(NTHR) k_g2(Params p) { gemm_phase(mk_g2(p), smem); }
__global__ void __launch_bounds__(NTHR) k_attn(Params p) { phase_attn(p, smem); }
__global__ void __launch_bounds__(NTHR) k_glu(Params p) { gemm_phase(mk_glu(p), smem); }
__global__ void __launch_bounds__(NTHR) k_attnup(Params p) { gemm_phase(mk_attnup(p), smem); }
__global__ void __launch_bounds__(NTHR) k_out(Params p) { gemm_phase(mk_out(p), smem); }
__global__ void __launch_bounds__(NTHR) k_router(Params p) { phase_router(p, smem); }
__global__ void __launch_bounds__(NTHR) k_perm(Params p) { phase_perm(p, smem); }
__global__ void __launch_bounds__(NTHR) k_moeup(Params p) { gemm_phase(mk_moeup(p), smem); }
__global__ void __launch_bounds__(NTHR) k_moedown(Params p) { gemm_phase(mk_moedown(p), smem); }

typedef void (*kfn_t)(Params);

extern "C" void kernel_launch(void* const* d_in, const int* in_sizes, int n_in, void* d_out, int out_size, void* d_ws, size_t ws_size, hipStream_t stream) {
    static const kfn_t fns[14] = {k_prep, k_xb, k_inproj, k_g1, k_scan, k_g2, k_attn, k_glu, k_attnup, k_out, k_router, k_perm, k_moeup, k_moedown};
    static const int lds_sz[14] = {73728, 0, 73728, 73728, 0, 73728, 73728, 73728, 73728, 73728, 86016, 4096, 73728, 73728};
    static int inited = 0;
    if (!inited) {
        for (int i = 0; i < 14; ++i) (void)hipFuncSetAttribute((const void*)fns[i], hipFuncAttributeMaxDynamicSharedMemorySize, lds_sz[i]);
        inited = 1;
    }
    if (n_in != 23 || ws_size < WS_END || out_size != NTOK * DM) { fprintf(stderr, "kernel_launch: unexpected shapes (n_in %d ws %zu out %d)\n", n_in, ws_size, out_size); return; }
    Params p{};
    for (int i = 0; i < 23; ++i) p.in[i] = (const float*)d_in[i];
    p.out = (float*)d_out; p.ws = (char*)d_ws;
    const int grid = 1024;
    for (int L = 0; L < 2; ++L) {
        p.layer = L;
        for (int i = 0; i < 14; ++i) hipLaunchKernelGGL(fns[i], dim3(grid), dim3(NTHR), lds_sz[i], stream, p);
    }
}
```

```cpp
#include <hip/hip_runtime.h>
#include <hip/hip_cooperative_groups.h>
#include <stdint.h>
#include <stdio.h>

#define DI __device__ __forceinline__
typedef unsigned short u16;
typedef short bf16x8 __attribute__((ext_vector_type(8)));
typedef short s16x4 __attribute__((ext_vector_type(4)));
typedef float f32x4 __attribute__((ext_vector_type(4)));
typedef float f32x2 __attribute__((ext_vector_type(2)));
typedef float f32x16 __attribute__((ext_vector_type(16)));
typedef unsigned u32x4 __attribute__((ext_vector_type(4)));
typedef unsigned u32x2 __attribute__((ext_vector_type(2)));
typedef __bf16 bf2_t __attribute__((ext_vector_type(2)));

constexpr int NTOK = 32768, DM = 1024, SEQ = 2048, NBATCH = 16, INC = 3328;
constexpr int TCH = 32, NCH = SEQ / TCH, S5M = NBATCH * NCH, S5K1 = TCH * 16, S5K2 = S5K1 + 128;
constexpr int TM = 256;
constexpr int MAXTILES = (NTOK + 24 * (TM - 1)) / TM + 1;
constexpr int NTHR = 512;
constexpr int LDS_BYTES = 98304;

#ifndef REP_PREP
#define REP_PREP 1
#endif
#ifndef REP_XB
#define REP_XB 1
#endif
#ifndef REP_ATTN
#define REP_ATTN 1
#endif
#ifndef REP_ROUTER
#define REP_ROUTER 1
#endif
#ifndef REP_INPROJ
#define REP_INPROJ 1
#endif
#ifndef REP_GLU
#define REP_GLU 1
#endif
#ifndef REP_MOEUP
#define REP_MOEUP 1
#endif
#ifndef REP_OUT0
#define REP_OUT0 1
#endif
#ifndef REP_EPI
#define REP_EPI 1
#endif
#ifndef REP_KLOOP
#define REP_KLOOP 1
#endif
#ifndef REP_G2
#define REP_G2 1
#endif
constexpr size_t MiB = 1u << 20;
constexpr size_t OFF_R1 = 0;
constexpr size_t OFF_R2 = 64 * MiB;
constexpr size_t OFF_R3 = 128 * MiB;
constexpr size_t OFF_A2 = 192 * MiB;
constexpr size_t OFF_Q = 232 * MiB;
constexpr size_t OFF_KV = 264 * MiB;
constexpr size_t OFF_SLOC = 280 * MiB;
constexpr size_t OFF_Z = OFF_Q;
constexpr size_t OFF_YA = 296 * MiB;
constexpr size_t WSET = 80 * MiB;
constexpr size_t OFF_WIN = 328 * MiB;
constexpr size_t OFF_WGLU = OFF_WIN + 7 * MiB;
constexpr size_t OFF_WATT = OFF_WGLU + 2 * MiB;
constexpr size_t OFF_WOUT = OFF_WATT + 1 * MiB;
constexpr size_t OFF_WUP = OFF_WOUT + 2 * MiB;
constexpr size_t OFF_WDN = OFF_WUP + 16 * MiB;
DI size_t pa_off(const int L) { return OFF_WIN + (size_t)(1 - L) * WSET; }
constexpr size_t OFF_W1T = OFF_WDN + 24 * MiB;
constexpr size_t OFF_W2T = OFF_W1T + 8 * MiB;
constexpr size_t OFF_SMALL = OFF_WIN + 2 * WSET;
constexpr size_t OFF_WR = OFF_SMALL;
constexpr size_t OFF_LT = OFF_WR + 128 * 1024;
constexpr size_t OFF_RSTD1 = OFF_LT + 64 * 1024;
constexpr size_t OFF_RSTD2 = OFF_RSTD1 + 128 * 1024;
constexpr size_t OFF_BUCKET = OFF_RSTD2 + 128 * 1024;
constexpr size_t OFF_RW = OFF_BUCKET + 128 * 1024;
constexpr size_t OFF_PERM = OFF_RW + 256 * 1024;
constexpr size_t OFF_CNT = OFF_PERM + 256 * 1024;
constexpr size_t OFF_TILEB = OFF_CNT + 32 * 1024;
constexpr size_t OFF_META = OFF_TILEB + 4 * 1024;
constexpr size_t OFF_SSQ4 = OFF_META + 1024;
constexpr size_t OFF_PERM2 = OFF_SSQ4 + 512 * 1024;
constexpr size_t WS_END = OFF_PERM2 + (size_t)24 * 32768 * 4;
constexpr size_t OFF_BAR = WS_END;
#define XCD_BAR_WORDS 3456
constexpr size_t OFF_MOEQ = OFF_BAR + XCD_BAR_WORDS * 4;
constexpr size_t CTL_BYTES = XCD_BAR_WORDS * 4 + 2 * 256 * 4;

struct Params {
    const float* in[23];
    float* out;
    char* ws;
};

DI int TID() { int t = threadIdx.x; asm volatile("" : "+v"(t)); return t; }
DI unsigned OZ() { unsigned z = 0; asm volatile("" : "+s"(z)); return z; }
template <class T> DI T* opq(T* x) { unsigned long long v = (unsigned long long)x; asm volatile("" : "+s"(v)); return (T*)(__attribute__((address_space(1))) char*)v; }
DI float shx(float v, int m, int lane) { return __builtin_bit_cast(float, __builtin_amdgcn_ds_bpermute((lane ^ m) << 2, __builtin_bit_cast(int, v))); }
DI const char* uptr(const char* p) { const unsigned long long v = (unsigned long long)p; const unsigned lo = (unsigned)__builtin_amdgcn_readfirstlane((int)(unsigned)v), hi = (unsigned)__builtin_amdgcn_readfirstlane((int)(unsigned)(v >> 32)); return (const char*)(__attribute__((address_space(1))) const char*)(((unsigned long long)hi << 32) | lo); }
DI void st16_sc1(void* p, u32x4 v) { asm volatile("global_store_dwordx4 %0, %1, off sc1\n\ts_nop 1" :: "v"(p), "v"(v) : "memory"); }
DI int BID() { int b = blockIdx.x; asm volatile("" : "+s"(b)); return b; }
DI unsigned pk2(float a, float b) { f32x2 v = {a, b}; bf2_t r = __builtin_convertvector(v, bf2_t); return __builtin_bit_cast(unsigned, r); }
DI float bf_lo(unsigned u) { return __uint_as_float(u << 16); }
DI float bf_hi(unsigned u) { return __uint_as_float(u & 0xffff0000u); }
DI float sigmoidf_(float x) { return __builtin_amdgcn_rcpf(1.0f + __builtin_amdgcn_exp2f(-1.4426950408889634f * x)); }
DI float gelu_tanh(float x) { const float u = 0.7978845608028654f * (x + 0.044715f * x * x * x); return x * __builtin_amdgcn_rcpf(1.0f + __builtin_amdgcn_exp2f(-2.8853900817779268f * u)); }
DI f32x16 mfma32(bf16x8 a, bf16x8 b, f32x16 c) { return __builtin_amdgcn_mfma_f32_32x32x16_bf16(a, b, c, 0, 0, 0); }
DI f32x4 mfma16(bf16x8 a, bf16x8 b, f32x4 c) { return __builtin_amdgcn_mfma_f32_16x16x32_bf16(a, b, c, 0, 0, 0); }

struct TJob { unsigned long long src, dst, scale; int ld_src, ld_dst, dcol0, rmul, radd, k0, n0; };
DI void tconv_load(const TJob& j, int tid, f32x4 (&v)[2]) {
    const float* src = (const float*)(__attribute__((address_space(1))) const char*)j.src;
#pragma unroll
    for (int i = 0; i < 2; ++i) v[i] = *(const f32x4*)(src + (size_t)(j.k0 + (tid >> 4) + 32 * i) * j.ld_src + j.n0 + (tid & 15) * 4);
}
DI void tconv_to_lds(const TJob& j, int tid, const f32x4 (&v)[2], float* sm) {
    const float* scale = (const float*)(__attribute__((address_space(1))) const char*)j.scale;
#pragma unroll
    for (int i = 0; i < 2; ++i) {
        const int k = (tid >> 4) + 32 * i, n = (tid & 15) * 4;
        const float sc = j.scale ? scale[j.k0 + k] : 1.0f;
        sm[(n + 0) * 65 + k] = v[i].x * sc; sm[(n + 1) * 65 + k] = v[i].y * sc; sm[(n + 2) * 65 + k] = v[i].z * sc; sm[(n + 3) * 65 + k] = v[i].w * sc;
    }
}
DI void tconv_store(const TJob& j, int tid, const float* sm) {
    u16* dst = (u16*)(__attribute__((address_space(1))) char*)j.dst;
    const int n = tid >> 3, c = tid & 7;
    const float* s = sm + n * 65 + c * 8;
    u32x4 o; o.x = pk2(s[0], s[1]); o.y = pk2(s[2], s[3]); o.z = pk2(s[4], s[5]); o.w = pk2(s[6], s[7]);
    const int nn = j.n0 + n, drow = j.rmul == 1 ? nn + j.radd : (nn >> 7) * 256 + j.radd + (nn & 127);
    *(u32x4*)(dst + (size_t)drow * j.ld_dst + j.dcol0 + j.k0 + c * 8) = o;
}

constexpr int T_WIN = (1024 / 64) * (INC / 64);
constexpr int T_GLU = 2 * (512 / 64) * (1024 / 64);
constexpr int T_ATT = (512 / 64) * (1024 / 64);
constexpr int T_OUT = (1024 / 64) * (1024 / 64);
constexpr int T_UP = 16 * 2 * (1024 / 64) * (256 / 64);
constexpr int T_DN = 24 * 2 * (256 / 64) * (1024 / 64);
constexpr int T_ALL = T_WIN + T_GLU + T_ATT + T_OUT + T_UP + T_DN;
static_assert(T_ALL % 4 == 0, "tiles are processed four at a time");

DI void pair_experts(int pidx, int& a, int& b) {
    a = pidx < 3 ? 0 : (pidx < 5 ? 1 : 2);
    b = pidx < 3 ? pidx + 1 : (pidx < 5 ? pidx - 1 : 3);
}

DI TJob prep_tjob(const Params& p, const int L, int t) {
    const unsigned long long ws = (unsigned long long)opq(p.ws) + (unsigned long long)L * WSET;
    TJob j; j.scale = 0; j.dcol0 = 0; j.rmul = 1; j.radd = 0;
    if (t < T_WIN) { const int kb = t / (INC / 64), nb = t % (INC / 64);
        j.src = (unsigned long long)(opq(p.in[2]) + (size_t)L * 1024 * INC); j.ld_src = INC; j.dst = ws + OFF_WIN; j.ld_dst = 1024; j.scale = (unsigned long long)(opq(p.in[1]) + L * 1024); j.k0 = kb * 64; j.n0 = nb * 64; return j; }
    t -= T_WIN;
    if (t < T_GLU) { const int half = t / 128, r = t % 128, kb = r / 16, nb = r % 16;
        j.src = (unsigned long long)((half ? opq(p.in[12]) : opq(p.in[11])) + (size_t)L * 512 * 1024); j.ld_src = 1024; j.dst = ws + OFF_WGLU; j.ld_dst = 512; j.rmul = 2; j.radd = half * 128; j.k0 = kb * 64; j.n0 = nb * 64; return j; }
    t -= T_GLU;
    if (t < T_ATT) { const int kb = t / 16, nb = t % 16;
        j.src = (unsigned long long)(opq(p.in[16]) + (size_t)L * 512 * 1024); j.ld_src = 1024; j.dst = ws + OFF_WATT; j.ld_dst = 512; j.k0 = kb * 64; j.n0 = nb * 64; return j; }
    t -= T_ATT;
    if (t < T_OUT) { const int kb = t / 16, nb = t % 16;
        j.src = (unsigned long long)(opq(p.in[17]) + (size_t)L * 1024 * 1024); j.ld_src = 1024; j.dst = ws + OFF_WOUT; j.ld_dst = 1024; j.k0 = kb * 64; j.n0 = nb * 64; return j; }
    t -= T_OUT;
    if (t < T_UP) { const int e = t / 128, r = t % 128, half = r / 64, r2 = r % 64, kb = r2 / 4, nb = r2 % 4;
        j.src = (unsigned long long)(opq(p.in[21]) + ((size_t)(L * 16 + e) * 1024) * 512 + half * 256); j.ld_src = 512; j.dst = ws + OFF_WUP + (size_t)e * 512 * 1024 * 2; j.ld_dst = 1024; j.rmul = 2; j.radd = half * 128;
        j.scale = (unsigned long long)(opq(p.in[18]) + L * 1024); j.k0 = kb * 64; j.n0 = nb * 64; return j; }
    t -= T_UP;
    { const int pr = t / 128, r = t % 128, slot = r / 64, r2 = r % 64, kb = r2 / 16, nb = r2 % 16;
      const int grp = pr / 6; int a, b; pair_experts(pr % 6, a, b); const int e = grp * 4 + (slot ? b : a);
      j.src = (unsigned long long)(opq(p.in[22]) + ((size_t)(L * 16 + e) * 256) * 1024); j.ld_src = 1024; j.dst = ws + OFF_WDN + (size_t)pr * 1024 * 512 * 2; j.ld_dst = 512; j.dcol0 = slot * 256; j.k0 = kb * 64; j.n0 = nb * 64; }
    return j;
}

DI void prep_s5_item(const Params& p, const int L, int item, float* sm) {
    const int tid = TID(), g = item >> 3, s = item & 7;
    float* LBre = sm;
    float* LBim = LBre + 33 * 64;
    float* BBre = LBim + 33 * 64;
    float* BBim = BBre + 1024;
    float* Cre = BBim + 1024;
    float* Cim = Cre + 128;
    float* Kt = Cim + 128;
    const float* lam_re = opq(p.in[3]) + (size_t)(L * 32 + g) * 64;
    const float* lam_im = opq(p.in[4]) + (size_t)(L * 32 + g) * 64;
    const float dt = expf(opq(p.in[5])[L * 32 + g]);
    const float* b_re = opq(p.in[6]) + (size_t)(L * 32 + g) * 1024;
    const float* b_im = opq(p.in[7]) + (size_t)(L * 32 + g) * 1024;
    const float* c_re = opq(p.in[8]) + (size_t)(L * 32 + g) * 1024;
    const float* c_im = opq(p.in[9]) + (size_t)(L * 32 + g) * 1024;
    const float* dsk = opq(p.in[10]) + L * 512 + g * 16;
    for (int i = tid; i < 33 * 64; i += NTHR) {
        const int lag = i >> 6, pp = i & 63;
        const float mag = expf(lam_re[pp] * dt * (float)lag);
        double a = (double)lam_im[pp] * (double)dt * (double)lag;
        a -= 6.283185307179586476925 * rint(a * 0.15915494309189533577);
        const float af = (float)a;
        LBre[i] = mag * cosf(af); LBim[i] = mag * sinf(af);
    }
    if (tid < 128) { Cre[tid] = c_re[(2 * s) * 64 + tid]; Cim[tid] = c_im[(2 * s) * 64 + tid]; }
    for (int i = tid; i < 1024; i += NTHR) {
        const int pp = i >> 4;
        const float lr = lam_re[pp], li = lam_im[pp];
        const float a = lr * dt; const float bb = li * dt;
        double br = (double)bb; br -= 6.283185307179586476925 * rint(br * 0.15915494309189533577);
        const float bf = (float)br;
        const float sh = sinf(0.5f * bf);
        const float xr = expm1f(a) * cosf(bf) - 2.0f * sh * sh;
        const float xi = expf(a) * sinf(bf);
        const float den = 1.0f / (lr * lr + li * li);
        const float fr = (xr * lr + xi * li) * den, fi = (xi * lr - xr * li) * den;
        const float vr = b_re[i], vi = b_im[i];
        BBre[i] = fr * vr - fi * vi; BBim[i] = fr * vi + fi * vr;
    }
    __syncthreads();
    if (s == 0 && tid < 64) { float* LT = (float*)(opq(p.ws) + OFF_LT) + (size_t)(g * 64 + tid) * 2; LT[0] = LBre[32 * 64 + tid]; LT[1] = LBim[32 * 64 + tid]; }
    for (int i = tid; i < 32 * 32; i += NTHR) {
        const int lag = i >> 5, hl = (i >> 4) & 1, hi = i & 15;
        float acc = 0.f;
        for (int pp = 0; pp < 64; ++pp) {
            const float cr = Cre[hl * 64 + pp], ci = Cim[hl * 64 + pp];
            const float lr = LBre[lag * 64 + pp], li = LBim[lag * 64 + pp];
            const float tr = cr * lr - ci * li, ti = cr * li + ci * lr;
            acc += tr * BBre[pp * 16 + hi] - ti * BBim[pp * 16 + hi];
        }
        Kt[i] = acc;
    }
    __syncthreads();
    u16* W1 = (u16*)(opq(p.ws) + (size_t)L * WSET + OFF_W1T) + (size_t)g * 256 * 512;
    for (int i = tid; i < 16 * 256; i += NTHR) {
        const int n = 16 * s + (i >> 8), k = (i & 255) * 2, pp = n >> 1, ri = n & 1, j = k >> 4, hi = k & 15;
        const float lr = LBre[(31 - j) * 64 + pp], li = LBim[(31 - j) * 64 + pp];
        float v[2];
#pragma unroll
        for (int e = 0; e < 2; ++e) { const float br = BBre[pp * 16 + hi + e], bi = BBim[pp * 16 + hi + e]; v[e] = ri ? (lr * bi + li * br) : (lr * br - li * bi); }
        *(unsigned*)(W1 + (size_t)n * 512 + k) = pk2(v[0], v[1]);
    }
    u16* W2 = (u16*)(opq(p.ws) + (size_t)L * WSET + OFF_W2T) + (size_t)g * 512 * 640;
    for (int idx = tid; idx < 64 * 320; idx += NTHR) {
        const int rr = idx / 320, k = (idx % 320) * 2, ii = rr >> 1, hl = rr & 1, ho = 2 * s + hl, n = ii * 16 + ho;
        float v[2];
        if (k < 512) {
            const int j = k >> 4, hi = k & 15;
#pragma unroll
            for (int e = 0; e < 2; ++e) {
                float x = 0.f;
                if (j <= ii) x = Kt[(ii - j) * 32 + hl * 16 + hi + e];
                if (j == ii && hi + e == ho) x += dsk[ho];
                v[e] = x;
            }
        } else {
            const int pp = (k - 512) >> 1;
            const float cr = Cre[hl * 64 + pp], ci = Cim[hl * 64 + pp];
            const float lr = LBre[(ii + 1) * 64 + pp], li = LBim[(ii + 1) * 64 + pp];
            v[0] = cr * lr - ci * li; v[1] = -(cr * li + ci * lr);
        }
        *(unsigned*)(W2 + (size_t)n * 640 + k) = pk2(v[0], v[1]);
    }
    __syncthreads();
}

DI void prep_router_w(const Params& p, const int L) {
    u16* WRH = (u16*)(opq(p.ws) + OFF_WR);
    u16* WRL = WRH + 21 * 1024;
    const float* nf = opq(p.in[18]) + L * 1024;
    const float* wc = opq(p.in[19]) + (size_t)L * 1024 * 4;
    const float* wf = opq(p.in[20]) + (size_t)L * 1024 * 16;
    for (int i = TID(); i < 21 * 1024; i += NTHR) {
        const int n = i >> 10, k = i & 1023;
        const float v = n < 20 ? nf[k] * (n < 4 ? wc[k * 4 + n] : wf[k * 16 + (n - 4)]) : 0.f;
        const unsigned h = pk2(v, 0.f) & 0xffffu;
        const float vh = __uint_as_float(h << 16);
        WRH[i] = (u16)h;
        WRL[i] = (u16)(pk2(v - vh, 0.f) & 0xffffu);
    }
}

DI void phase_prep(const Params& p, const int L, char* lds) {
    float* sm = (float*)lds;
    const int bid = BID(), G = gridDim.x;
    for (int it = bid; it < 257; it += G) {
        if (it < 256) prep_s5_item(p, L, it, sm);
        else prep_router_w(p, L);
    }
    const int tid = TID();
    for (int gi = bid; gi < T_WIN / 4; gi += G) {
        TJob j0 = prep_tjob(p, L, 4 * gi), j1 = prep_tjob(p, L, 4 * gi + 1), j2 = prep_tjob(p, L, 4 * gi + 2), j3 = prep_tjob(p, L, 4 * gi + 3);
        f32x4 v0[2], v1[2], v2[2], v3[2];
        tconv_load(j0, tid, v0); tconv_load(j1, tid, v1); tconv_load(j2, tid, v2); tconv_load(j3, tid, v3);
        tconv_to_lds(j0, tid, v0, sm); tconv_to_lds(j1, tid, v1, sm + 4224); tconv_to_lds(j2, tid, v2, sm + 8448); tconv_to_lds(j3, tid, v3, sm + 12672);
        __syncthreads();
        tconv_store(j0, tid, sm); tconv_store(j1, tid, sm + 4224); tconv_store(j2, tid, sm + 8448); tconv_store(j3, tid, sm + 12672);
        __syncthreads();
    }
}

constexpr int PREPQ_ITEMS = 257 + T_ALL / 4;
DI void prep_from_queue(const Params& p, char* lds, int budget, const int L, const int first) {
    float* sm = (float*)lds;
    unsigned* qc = (unsigned*)(opq(p.ws) + OFF_BAR) + 12 + L;
    int* qslot = (int*)(lds + 81920);
    const int tid = TID();
    for (int n = 0; n < budget; ++n) {
        if (threadIdx.x == 0) *qslot = (int)__hip_atomic_fetch_add(qc, 1u, __ATOMIC_RELAXED, __HIP_MEMORY_SCOPE_AGENT);
        __syncthreads();
        const int it = __builtin_amdgcn_readfirstlane(*qslot) + first;
        __syncthreads();
        if (it >= PREPQ_ITEMS) break;
        if (it < 256) prep_s5_item(p, L, it, sm);
        else if (it == 256) prep_router_w(p, L);
        else {
            const int gi = it - 257;
            TJob j0 = prep_tjob(p, L, 4 * gi), j1 = prep_tjob(p, L, 4 * gi + 1), j2 = prep_tjob(p, L, 4 * gi + 2), j3 = prep_tjob(p, L, 4 * gi + 3);
            f32x4 v0[2], v1[2], v2[2], v3[2];
            tconv_load(j0, tid, v0); tconv_load(j1, tid, v1); tconv_load(j2, tid, v2); tconv_load(j3, tid, v3);
            tconv_to_lds(j0, tid, v0, sm); tconv_to_lds(j1, tid, v1, sm + 4224); tconv_to_lds(j2, tid, v2, sm + 8448); tconv_to_lds(j3, tid, v3, sm + 12672);
            __syncthreads();
            tconv_store(j0, tid, sm); tconv_store(j1, tid, sm + 4224); tconv_store(j2, tid, sm + 8448); tconv_store(j3, tid, sm + 12672);
            __syncthreads();
        }
    }
}

DI void phase_xb(const Params& p) {
    const float* X = opq(p.in[0]);
    u16* XB = (u16*)(opq(p.ws) + OFF_R1);
    float* ssq4 = (float*)(opq(p.ws) + OFF_SSQ4);
    const int tid_ = TID(), lane = tid_ & 63, w = tid_ >> 6;
    for (int row = BID() * 8 + w; row < NTOK; row += gridDim.x * 8) {
        const f32x4* xr = (const f32x4*)(X + (size_t)row * DM) + lane;
        f32x4 v[4]; float s = 0.f;
#pragma unroll
        for (int j = 0; j < 4; ++j) v[j] = xr[64 * j];
        u32x2* o8 = (u32x2*)(XB + (size_t)row * DM) + lane;
#pragma unroll
        for (int j = 0; j < 4; ++j) { u32x2 q; q.x = pk2(v[j].x, v[j].y); q.y = pk2(v[j].z, v[j].w); o8[64 * j] = q;
            const float a = bf_lo(q.x), b = bf_hi(q.x), c = bf_lo(q.y), d = bf_hi(q.y); s += a * a + b * b + c * c + d * d; }
#pragma unroll
        for (int o = 1; o < 64; o <<= 1) s += shx(s, o, lane);
        if (lane == 0) *(f32x4*)(ssq4 + (size_t)row * 4) = (f32x4){s, 0.f, 0.f, 0.f};
    }
}

#define PG_LAS __attribute__((address_space(3)))
constexpr int PG_HTB = 128 * 64 * 2;
constexpr int PG_STAGE_BYTES = 8 * PG_HTB;
DI int pg_lds_byte(int r, int c) { const int st = (r >> 4) * 2 + (c >> 5), rr = r & 15, cc = c & 31, ob = rr * 64 + cc * 2; return st * 1024 + (ob ^ (((ob >> 9) & 1) << 5)); }
DI void pg_stage_rc(int b, int& R, int& C) { const int st = b / 1024, sb = b % 1024, swz = sb ^ (((sb >> 9) & 1) << 5); R = (st >> 1) * 16 + swz / 64; C = (st & 1) * 32 + (swz % 64) / 2; }

constexpr int ST16 = 264;
constexpr int ST16H = 136;
constexpr int ST32 = 260;
DI int rg_row(int rg, int rbase) { return (rg >> 2) * 128 + (rg & 3) * 16 + rbase; }

DI void pg_glds16(unsigned lds_dst, const char* base, unsigned voff) {
    unsigned keep;
    asm volatile("s_mov_b32 %0, m0\n\ts_mov_b32 m0, %1\n\ts_nop 0\n\tglobal_load_lds_dwordx4 %2, %3\n\ts_mov_b32 m0, %0" : "=&s"(keep) : "s"(lds_dst), "v"(voff), "s"(base) : "memory");
}

constexpr unsigned ROWC_OFF = 139264;
template <class J, class = void> struct has_rowdma { static constexpr bool v = false; };
template <class J> struct has_rowdma<J, decltype((void)J::ROWDMA)> { static constexpr bool v = J::ROWDMA; };

template <class J>
DI void pg_gemm_seq(const J& jb, char* lds_, const int u_begin, const int G, const int nu) {
    PG_LAS unsigned char* lds = (PG_LAS unsigned char*)lds_;
    const int tid = TID(), wid = __builtin_amdgcn_readfirstlane(tid >> 6), lane = tid & 63, wr = wid >> 2, wc = wid & 3, fr = lane & 15, fq = lane >> 4;
    const int bid = u_begin;
    const int K = jb.kdim(), nt = K / 64;
    if (bid >= nu) return;
    int Rr[2], Cc[2]; unsigned voffB[2];
#pragma unroll
    for (int i = 0; i < 2; ++i) { pg_stage_rc(tid * 16 + i * 8192, Rr[i], Cc[i]); const int rho = Rr[i] & 31, Rb = (Rr[i] & ~31) + 8 * ((rho & 15) >> 2) + 4 * (rho >> 4) + (rho & 3); voffB[i] = (unsigned)(Rb * K + Cc[i]) * 2u; }
    const size_t kstepA = jb.a_kstep();
    const size_t hstepA = jb.a_hstep();
    const size_t kstepB = 128;
    const size_t hstepB = (size_t)128 * K * 2;
    const unsigned ldsw = (unsigned)wid * 1024u;
    const unsigned ldsb = (unsigned)(size_t)lds;
    const int aoff = pg_lds_byte(wr * 64 + fr, fq * 8), boff = pg_lds_byte(wc * 32 + fr, fq * 8);
#define PG_SA(b, h) ((b) * 65536 + (h) * PG_HTB)
#define PG_SB(b, h) ((b) * 65536 + 32768 + (h) * PG_HTB)
#define PG_STAGE(bufoff, gbase, voff) do { _Pragma("unroll") for (int _i = 0; _i < 2; ++_i) \
        pg_glds16(ldsb + (unsigned)(bufoff) + ldsw + _i * 8192u, (const char*)(gbase), (voff)[_i]); } while (0)
#define PG_STAGE_A(bufoff, gbase, h) do { if constexpr (J::GATHER) { if (h) PG_STAGE(bufoff, gbase, vo1); else PG_STAGE(bufoff, gbase, vo0); } else { PG_STAGE(bufoff, (gbase) + (h) * hstepA, vo0); } } while (0)
#define PG_LDA(dst, b, h) do { _Pragma("unroll") for (int m = 0; m < 4; ++m) _Pragma("unroll") for (int k = 0; k < 2; ++k) dst[m][k] = *(const PG_LAS bf16x8*)(lds + PG_SA(b, h) + aoff + m * 2048 + k * 1024); } while (0)
#define PG_LDB(dst, b, h) do { _Pragma("unroll") for (int n = 0; n < 2; ++n) _Pragma("unroll") for (int k = 0; k < 2; ++k) dst[n][k] = *(const PG_LAS bf16x8*)(lds + PG_SB(b, h) + boff + n * 2048 + k * 1024); } while (0)
#define PG_MMA(ai, bj, At, Bt) do { __builtin_amdgcn_s_setprio(1); _Pragma("unroll") for (int m = 0; m < 4; ++m) _Pragma("unroll") for (int n = 0; n < 2; ++n) _Pragma("unroll") for (int k = 0; k < 2; ++k) \
        acc[ai][bj][m][n] = __builtin_amdgcn_mfma_f32_16x16x32_bf16(Bt[n][k], At[m][k], acc[ai][bj][m][n], 0, 0, 0); __builtin_amdgcn_s_setprio(0); } while (0)
#define PG_WAIT_V(n) asm volatile("s_waitcnt vmcnt(" #n ")" ::: "memory")
#define PG_WAIT_L(n) asm volatile("s_waitcnt lgkmcnt(" #n ")" ::: "memory")
#define PG_BAR __builtin_amdgcn_s_barrier()
#define PG_SCHED __builtin_amdgcn_sched_barrier(0)
    typename J::Unit cur = jb.unit(bid);
    unsigned vo0[2], vo1[2];
#pragma unroll
    for (int i = 0; i < 2; ++i) { vo0[i] = jb.a_off(cur, Rr[i], Cc[i]); vo1[i] = J::GATHER ? jb.a_off(cur, Rr[i] + 128, Cc[i]) : 0u; }
    const char* cA = uptr(jb.a_base(cur)); const char* cB = uptr(jb.b_base(cur));
    int rpar = 0;
    if constexpr (has_rowdma<J>::v) { if (wid < 4) pg_glds16(ldsb + ROWC_OFF + (unsigned)wid * 1024u, uptr(jb.row_base(cur)), (unsigned)tid * 16u); }
    PG_STAGE(PG_SB(0, 0), cB, voffB); PG_STAGE_A(PG_SA(0, 0), cA, 0); PG_STAGE(PG_SB(0, 1), cB + hstepB, voffB); PG_STAGE_A(PG_SA(0, 1), cA, 1);
    for (int uidx = bid;;) {
        if (wr == 1) PG_BAR;
        PG_WAIT_V(4); PG_BAR;
        PG_STAGE(PG_SB(1, 0), cB + kstepB, voffB); PG_STAGE_A(PG_SA(1, 0), cA + kstepA, 0); PG_STAGE(PG_SB(1, 1), cB + hstepB + kstepB, voffB);
        PG_WAIT_V(6); PG_BAR;
        f32x4 acc[2][2][4][2];
#pragma unroll
        for (int a = 0; a < 2; ++a)
#pragma unroll
            for (int b = 0; b < 2; ++b)
#pragma unroll
                for (int m = 0; m < 4; ++m)
#pragma unroll
                    for (int n = 0; n < 2; ++n) acc[a][b][m][n] = (f32x4){0.f, 0.f, 0.f, 0.f};
        bf16x8 At[4][2], B0[2][2], B1[2][2];
        for (int t = 0; t < nt; t += 2) {
            const bool more = (t != nt - 2);
            const char* a1 = cA + (size_t)(t + 1) * kstepA;
            const char* a2 = cA + (size_t)(t + 2) * kstepA; const char* b2 = cB + (size_t)(t + 2) * kstepB;
            const char* a3 = a2 + kstepA; const char* b3 = b2 + kstepB;
            PG_LDB(B0, 0, 0); PG_SCHED; PG_LDA(At, 0, 0); PG_STAGE_A(PG_SA(1, 1), a1, 1);
            PG_WAIT_L(8); PG_BAR; PG_WAIT_L(0); PG_MMA(0, 0, At, B0); PG_BAR; PG_SCHED;
            PG_LDB(B1, 0, 1); if (more) PG_STAGE(PG_SB(0, 0), b2, voffB);
            PG_BAR; PG_WAIT_L(0); PG_MMA(0, 1, At, B1); PG_BAR;
            PG_LDA(At, 0, 1); if (more) PG_STAGE_A(PG_SA(0, 0), a2, 0);
            PG_BAR; PG_WAIT_L(0); PG_MMA(1, 0, At, B0); PG_BAR; PG_SCHED;
            if (more) { PG_STAGE(PG_SB(0, 1), b2 + hstepB, voffB); PG_WAIT_V(6); } else { PG_WAIT_V(0); }
            PG_BAR; PG_MMA(1, 1, At, B1); PG_BAR;
            PG_LDB(B0, 1, 0); PG_SCHED; PG_LDA(At, 1, 0); if (more) PG_STAGE_A(PG_SA(0, 1), a2, 1);
            PG_WAIT_L(8); PG_BAR; PG_WAIT_L(0); PG_MMA(0, 0, At, B0); PG_BAR; PG_SCHED;
            PG_LDB(B1, 1, 1); if (more) PG_STAGE(PG_SB(1, 0), b3, voffB);
            PG_BAR; PG_WAIT_L(0); PG_MMA(0, 1, At, B1); PG_BAR;
            PG_LDA(At, 1, 1); if (more) PG_STAGE_A(PG_SA(1, 0), a3, 0);
            PG_BAR; PG_WAIT_L(0); PG_MMA(1, 0, At, B0); PG_BAR; PG_SCHED;
            if (more) { PG_STAGE(PG_SB(1, 1), b3 + hstepB, voffB); PG_WAIT_V(6); }
            PG_BAR; PG_MMA(1, 1, At, B1); PG_BAR;
        }
        if (wr == 0) PG_BAR;
        PG_BAR;
        const int nidx = uidx + G;
        const bool has_next = nidx < nu;
        const typename J::Unit done = cur;
        if (has_next) {
            cur = jb.unit(nidx);
            if constexpr (J::GATHER) {
#pragma unroll
                for (int i = 0; i < 2; ++i) { int R2, C2; pg_stage_rc(TID() * 16 + i * 8192, R2, C2); vo0[i] = jb.a_off(cur, R2, C2); vo1[i] = jb.a_off(cur, R2 + 128, C2); }
            }
            cA = uptr(jb.a_base(cur)); cB = uptr(jb.b_base(cur));
            if constexpr (has_rowdma<J>::v) { if (wid < 4) pg_glds16(ldsb + ROWC_OFF + (unsigned)((rpar ^ 1) * 4096) + (unsigned)wid * 1024u, uptr(jb.row_base(cur)), (unsigned)TID() * 16u); }
            PG_STAGE(PG_SB(0, 0), cB, voffB); PG_STAGE_A(PG_SA(0, 0), cA, 0); PG_STAGE(PG_SB(0, 1), cB + hstepB, voffB); PG_STAGE_A(PG_SA(0, 1), cA, 1);
        }
        {
            const int l2 = TID() & 63;
            const int rbase = wr * 64 + (l2 & 15), cb = wc * 32 + 8 * (l2 >> 4);
            typename J::Ctx ctx;
            if constexpr (has_rowdma<J>::v) jb.epi_begin(done, rbase, ctx, (const PG_LAS unsigned char*)(lds + ROWC_OFF + rpar * 4096)); else jb.epi_begin(done, rbase, ctx);
            if constexpr (J::SMODE == 0 && J::NCOL == 128) {
                PG_LAS u16* T = (PG_LAS u16*)(lds + 65536);
#pragma unroll
                for (int rg = 0; rg < 8; ++rg) {
                    u32x4 o0, o1;
                    jb.epi_val(done, ctx, rg, acc[rg >> 2][0][rg & 3][0], acc[rg >> 2][0][rg & 3][1], acc[rg >> 2][1][rg & 3][0], acc[rg >> 2][1][rg & 3][1], o0, o1);
                    *(PG_LAS u32x4*)(T + rg_row(rg, rbase) * ST16H + cb) = o0;
                }
                __syncthreads();
                jb.epi_copy(done, ctx, (const PG_LAS u16*)T, TID());
                __syncthreads();
            } else if constexpr (J::SMODE == 0) {
                PG_LAS u16* T = (PG_LAS u16*)(lds + 65536);
#pragma unroll
                for (int h = 0; h < 2; ++h) {
#pragma unroll
                    for (int m = 0; m < 4; ++m) {
                        u32x4 o0, o1;
                        jb.epi_val(done, ctx, h * 4 + m, acc[h][0][m][0], acc[h][0][m][1], acc[h][1][m][0], acc[h][1][m][1], o0, o1);
                        PG_LAS u16* d = T + (m * 16 + rbase) * ST16 + cb;
                        *(PG_LAS u32x4*)d = o0; *(PG_LAS u32x4*)(d + 128) = o1;
                    }
                    __syncthreads();
                    jb.epi_copy(done, (const PG_LAS u16*)T, h, TID());
                    __syncthreads();
                }
            } else {
                PG_LAS float* T = (PG_LAS float*)(lds + 65536);
                typename J::Pre pa, pb;
                jb.epi_load(done, ctx, 0, TID(), pa);
#pragma unroll
                for (int ps = 0; ps < 4; ++ps) {
                    if (wr == (ps & 1)) {
#pragma unroll
                        for (int m = 0; m < 4; ++m) {
                            PG_LAS float* d = T + (m * 16 + (l2 & 15)) * ST32 + cb;
                            *(PG_LAS f32x4*)d = acc[ps >> 1][0][m][0]; *(PG_LAS f32x4*)(d + 4) = acc[ps >> 1][0][m][1];
                            *(PG_LAS f32x4*)(d + 128) = acc[ps >> 1][1][m][0]; *(PG_LAS f32x4*)(d + 132) = acc[ps >> 1][1][m][1];
                        }
                    }
                    __syncthreads();
                    if (ps < 3) jb.epi_load(done, ctx, ps + 1, TID(), pb);
                    jb.epi_copy(done, ctx, (const PG_LAS float*)T, ps, TID(), pa);
                    __syncthreads();
                    pa = pb;
                }
            }
        }
        if (!has_next) break;
        uidx = nidx; rpar ^= 1;
    }
#undef PG_SA
#undef PG_SB
#undef PG_STAGE
#undef PG_STAGE_A
#undef PG_LDA
#undef PG_LDB
#undef PG_MMA
#undef PG_WAIT_V
#undef PG_WAIT_L
#undef PG_BAR
#undef PG_SCHED
}

template <class J> DI void pg_gemm(const J& jb, char* lds_) { pg_gemm_seq(jb, lds_, BID(), (int)gridDim.x, jb.num_units()); }

DI void tile_order(int L, int nM, int nN, int& pm, int& pn) {
    const int nwg = nM * nN, q = nwg / 8, r = nwg % 8, xcd = L % 8, off = L / 8;
    const int wgid = (xcd < r ? xcd * (q + 1) : r * (q + 1) + (xcd - r) * q) + off;
    const int nig = 8 * nN, gid = wgid / nig, fm = gid * 8, gsz = (nM - fm) < 8 ? (nM - fm) : 8;
    pm = fm + ((wgid % nig) % gsz); pn = (wgid % nig) / gsz;
}

struct UnitMN { int m0, n0; };
struct NoCtx {};
DI u32x4 pack8(f32x4 a, f32x4 b) { u32x4 o; o.x = pk2(a.x, a.y); o.y = pk2(a.z, a.w); o.z = pk2(b.x, b.y); o.w = pk2(b.z, b.w); return o; }
DI f32x4 sig4(f32x4 v) { f32x4 o; o.x = sigmoidf_(v.x); o.y = sigmoidf_(v.y); o.z = sigmoidf_(v.z); o.w = sigmoidf_(v.w); return o; }
DI unsigned q4u8(f32x4 v) {
    const unsigned a = (unsigned)fmaf(v.x, 255.0f, 0.5f), b = (unsigned)fmaf(v.y, 255.0f, 0.5f), c = (unsigned)fmaf(v.z, 255.0f, 0.5f), d = (unsigned)fmaf(v.w, 255.0f, 0.5f);
    return a | (b << 8) | (c << 16) | (d << 24);
}
DI f32x4 unq4u8(unsigned w) { f32x4 o; o.x = (float)(w & 0xffu); o.y = (float)((w >> 8) & 0xffu); o.z = (float)((w >> 16) & 0xffu); o.w = (float)(w >> 24); return o * (1.0f / 255.0f); }
constexpr size_t OFF_SGS8 = OFF_R3, OFF_SGA8 = OFF_R3 + ((size_t)32 << 20);
DI f32x4 unp_lo(u32x4 u) { f32x4 o; o.x = bf_lo(u.x); o.y = bf_hi(u.x); o.z = bf_lo(u.y); o.w = bf_hi(u.y); return o; }
DI f32x4 unp_hi(u32x4 u) { f32x4 o; o.x = bf_lo(u.z); o.y = bf_hi(u.z); o.z = bf_lo(u.w); o.w = bf_hi(u.w); return o; }

template <int MODE> struct JobInProjT {
    typedef UnitMN Unit; static constexpr bool GATHER = false; static constexpr int SMODE = 0, NCOL = 256, EREP = REP_EPI;
    struct Ctx { float rs[8]; };
    const char* A; const char* B; const float* ssq4; u16* A2; char* ws;
    DI int num_units() const { return MODE == 0 ? (NTOK / 256) * 12 : 256; }
    DI Unit unit(int u) const { int pm, pn; if (MODE == 0) tile_order(u, NTOK / 256, 12, pm, pn); else { pm = u - 128; pn = 12; } Unit x; x.m0 = pm * 256; x.n0 = pn * 256; return x; }
    DI const char* a_base(const Unit& un) const { return A + (size_t)un.m0 * 2048; }
    DI const char* b_base(const Unit& un) const { return B + (size_t)un.n0 * 2048; }
    DI unsigned a_off(const Unit&, int R, int C) const { return (unsigned)(R * 1024 + C) * 2u; }
    DI size_t a_hstep() const { return 128 * 2048; }
    DI size_t a_kstep() const { return 128; }
    DI int kdim() const { return 1024; }
    static constexpr bool ROWDMA = true;
    DI const char* row_base(const Unit& un) const { return (const char*)ssq4 + (size_t)un.m0 * 16; }
    DI void epi_begin(const Unit&, int rbase, Ctx& c, const PG_LAS unsigned char* rc) const {
#pragma unroll
        for (int rg = 0; rg < 8; ++rg) { const f32x4 q = *(const PG_LAS f32x4*)(rc + rg_row(rg, rbase) * 16); c.rs[rg] = rsqrtf((q.x + q.y + q.z + q.w) * (1.0f / DM) + 1e-6f); }
    }
    DI void epi_val(const Unit& un, const Ctx& c, int rg, f32x4 v00, f32x4 v01, f32x4 v10, f32x4 v11, u32x4& o0, u32x4& o1) const {
        const float s = c.rs[rg];
        if (un.n0 >= 1280) { o0 = (u32x4){q4u8(sig4(v00 * s)), q4u8(sig4(v01 * s)), 0u, 0u}; o1 = (u32x4){q4u8(sig4(v10 * s)), q4u8(sig4(v11 * s)), 0u, 0u}; }
        else { o0 = pack8(v00 * s, v01 * s); o1 = pack8(v10 * s, v11 * s); }
    }
    DI void epi_copy(const Unit& un, const PG_LAS u16* T, int h, int tid) const {
        if (un.n0 < 512) {
#pragma unroll
            for (int it = 0; it < 4; ++it) {
                const int id = it * NTHR + tid, gl = id >> 7, r = id & 127, row = un.m0 + h * 128 + r;
                const PG_LAS u16* s = T + r * ST16 + gl * 16;
                const u32x4 a = *(const PG_LAS u32x4*)s, b = *(const PG_LAS u32x4*)(s + 8);
                const int g = (un.n0 >> 4) + gl, bb = row >> 11, t = row & 2047, ch = t >> 5, i = t & 31;
                u16* d = A2 + ((size_t)(g * S5M + bb * NCH + ch) * S5K2 + i * 16);
                *(u32x4*)d = a; *(u32x4*)(d + 8) = b;
            }
            return;
        }
        if (un.n0 >= 1280) {
            unsigned char* d8 = (unsigned char*)ws + (un.n0 < 2304 ? OFF_SGS8 + (size_t)(un.n0 - 1280) : OFF_SGA8 + (size_t)(un.n0 - 2304));
#pragma unroll
            for (int it = 0; it < 8; ++it) {
                const int id = it * NTHR + tid, r = id >> 5, c = (id & 31) * 8;
                *(u32x2*)(d8 + (size_t)(un.m0 + h * 128 + r) * 1024 + c) = *(const PG_LAS u32x2*)(T + r * ST16 + c);
            }
            return;
        }
        size_t doff; int ld, c0;
        if (un.n0 < 1024) { doff = OFF_Q; ld = 512; c0 = un.n0 - 512; }
        else { doff = OFF_KV; ld = 256; c0 = 0; }
        u16* dst = (u16*)(ws + doff);
#pragma unroll
        for (int it = 0; it < 8; ++it) {
            const int id = it * NTHR + tid, r = id >> 5, c = (id & 31) * 8;
            *(u32x4*)(dst + (size_t)(un.m0 + h * 128 + r) * ld + c0 + c) = *(const PG_LAS u32x4*)(T + r * ST16 + c);
        }
    }
};

struct UnitG { int g, m0, n0; };
struct JobS5G1 {
    typedef UnitG Unit; static constexpr bool GATHER = false; static constexpr int SMODE = 1, NCOL = 256, EREP = 1;
    typedef NoCtx Ctx;
    const char* A2; const char* W1; float* Sloc;
    DI int num_units() const { return 32 * (S5M / 256); }
    DI Unit unit(int u) const { const int xcd = u & 7, slot = u >> 3; Unit x; x.g = xcd * 4 + (slot >> 2); x.m0 = (slot & 3) * 256; x.n0 = 0; return x; }
    DI const char* a_base(const Unit& un) const { return A2 + (size_t)(un.g * S5M + un.m0) * S5K2 * 2; }
    DI const char* b_base(const Unit& un) const { return W1 + (size_t)un.g * 256 * 512 * 2; }
    DI unsigned a_off(const Unit&, int R, int C) const { return (unsigned)(R * S5K2 + C) * 2u; }
    DI size_t a_hstep() const { return 128 * S5K2 * 2; }
    DI size_t a_kstep() const { return 128; }
    DI int kdim() const { return S5K1; }
    DI void epi_begin(const Unit&, int, Ctx&) const {}
    struct Pre {}; DI void epi_load(const Unit&, const Ctx&, int, int, Pre&) const {}
    DI void epi_copy(const Unit& un, const Ctx&, const PG_LAS float* T, int ps, int tid, const Pre&) const {
        const int r0 = (ps >> 1) * 128 + (ps & 1) * 64;
#pragma unroll
        for (int it = 0; it < 4; ++it) {
            const int id = it * NTHR + tid, r = id >> 5, c = (id & 31) * 4;
            *(f32x4*)(Sloc + (size_t)(un.g * S5M + un.m0 + r0 + r) * 128 + c) = *(const PG_LAS f32x4*)(T + r * ST32 + c);
        }
    }
};

struct JobS5G2 {
    typedef UnitG Unit; static constexpr bool GATHER = false; static constexpr int SMODE = 0, NCOL = 256, EREP = 1;
    typedef NoCtx Ctx;
    const char* A2; const char* W2; u16* Zp;
    DI int num_units() const { return 32 * (S5M / 256) * 2; }
    DI Unit unit(int u) const { const int xcd = u & 7, slot = u >> 3; Unit x; x.g = xcd * 4 + (slot >> 3); const int r = slot & 7; x.m0 = (r >> 1) * 256; x.n0 = (r & 1) * 256; return x; }
    DI const char* a_base(const Unit& un) const { return A2 + (size_t)(un.g * S5M + un.m0) * S5K2 * 2; }
    DI const char* b_base(const Unit& un) const { return W2 + (size_t)(un.g * 512 + un.n0) * S5K2 * 2; }
    DI unsigned a_off(const Unit&, int R, int C) const { return (unsigned)(R * S5K2 + C) * 2u; }
    DI size_t a_hstep() const { return 128 * S5K2 * 2; }
    DI size_t a_kstep() const { return 128; }
    DI int kdim() const { return S5K2; }
    DI void epi_begin(const Unit&, int, Ctx&) const {}
    DI f32x4 gelu4(f32x4 v) const { f32x4 o; o.x = gelu_tanh(v.x); o.y = gelu_tanh(v.y); o.z = gelu_tanh(v.z); o.w = gelu_tanh(v.w); return o; }
    DI void epi_val(const Unit&, const Ctx&, int, f32x4 v00, f32x4 v01, f32x4 v10, f32x4 v11, u32x4& o0, u32x4& o1) const { o0 = pack8(gelu4(v00), gelu4(v01)); o1 = pack8(gelu4(v10), gelu4(v11)); }
    DI void epi_copy(const Unit& un, const PG_LAS u16* T, int h, int tid) const {
#pragma unroll
        for (int it = 0; it < 8; ++it) {
            const int id = it * NTHR + tid, r = id >> 5, c = (id & 31) * 8, rr = un.m0 + h * 128 + r, bb = rr >> 6, ch = rr & 63;
            *(u32x4*)(Zp + ((size_t)un.g * NTOK + bb * SEQ + ch * TCH) * 16 + un.n0 + c) = *(const PG_LAS u32x4*)(T + r * ST16 + c);
        }
    }
};

struct JobGLU {
    typedef UnitMN Unit; static constexpr bool GATHER = false; static constexpr int SMODE = 0, NCOL = 128, EREP = 1;
    struct Ctx { u32x2 sg[8]; u32x4 pa[8]; };
    const char* Zp; const char* B; const unsigned char* SGS; const u16* PA; u16* MS;
    DI int num_units() const { return (NTOK / 256) * 8; }
    DI Unit unit(int u) const { int pm, pn; tile_order(u, NTOK / 256, 8, pm, pn); Unit x; x.m0 = pm * 256; x.n0 = pn * 256; return x; }
    DI const char* a_base(const Unit& un) const { return Zp + (size_t)un.m0 * 32; }
    DI const char* b_base(const Unit& un) const { return B + (size_t)un.n0 * 1024; }
    DI unsigned a_off(const Unit&, int R, int C) const { return (unsigned)(((C >> 4) * NTOK + R) * 32 + (C & 15) * 2); }
    DI size_t a_hstep() const { return 128 * 32; }
    DI size_t a_kstep() const { return (size_t)4 * NTOK * 32; }
    DI int kdim() const { return 512; }
    DI void epi_begin(const Unit& un, int, Ctx& cx) const {
        const int tid = TID();
#pragma unroll
        for (int it = 0; it < 8; ++it) { const int id = it * NTHR + tid, r = id >> 4, c = (id & 15) * 8; const size_t off = (size_t)(un.m0 + r) * 1024 + (un.n0 >> 1) + c; cx.sg[it] = *(const u32x2*)(SGS + off); cx.pa[it] = *(const u32x4*)(PA + off); }
    }
    DI void epi_val(const Unit&, const Ctx&, int, f32x4 v00, f32x4 v01, f32x4 v10, f32x4 v11, u32x4& o0, u32x4& o1) const { o0 = pack8(v00 * sig4(v10), v01 * sig4(v11)); o1 = o0; }
    DI void epi_copy(const Unit& un, const Ctx& cx, const PG_LAS u16* T, int tid) const {
#pragma unroll
        for (int it = 0; it < 8; ++it) {
            const int id = it * NTHR + tid, r = id >> 4, c = (id & 15) * 8;
            const u32x4 v = *(const PG_LAS u32x4*)(T + r * ST16H + c);
            *(u32x4*)(MS + (size_t)(un.m0 + r) * 1024 + (un.n0 >> 1) + c) = pack8(unp_lo(v) * unq4u8(cx.sg[it].x) + unp_lo(cx.pa[it]), unp_hi(v) * unq4u8(cx.sg[it].y) + unp_hi(cx.pa[it]));
        }
    }
};

struct JobAttnUp {
    typedef UnitMN Unit; static constexpr bool GATHER = false; static constexpr int SMODE = 1, NCOL = 256, EREP = 1;
    typedef NoCtx Ctx;
    const char* A; const char* B; const unsigned char* SGA; u16* PA;
    DI int num_units() const { return (NTOK / 256) * 4; }
    DI Unit unit(int u) const { int pm, pn; tile_order(u, NTOK / 256, 4, pm, pn); Unit x; x.m0 = pm * 256; x.n0 = pn * 256; return x; }
    DI const char* a_base(const Unit& un) const { return A + (size_t)un.m0 * 1024; }
    DI const char* b_base(const Unit& un) const { return B + (size_t)un.n0 * 1024; }
    DI unsigned a_off(const Unit&, int R, int C) const { return (unsigned)(R * 512 + C) * 2u; }
    DI size_t a_hstep() const { return 128 * 1024; }
    DI size_t a_kstep() const { return 128; }
    DI int kdim() const { return 512; }
    DI void epi_begin(const Unit&, int, Ctx&) const {}
    struct Pre { u32x2 ga[4]; };
    DI void epi_load(const Unit& un, const Ctx&, int ps, int tid, Pre& p) const {
        const int r0 = (ps >> 1) * 128 + (ps & 1) * 64;
#pragma unroll
        for (int it = 0; it < 4; ++it) { const int id = it * NTHR + tid, r = id >> 5, c = (id & 31) * 8; const size_t off = (size_t)(un.m0 + r0 + r) * 1024 + un.n0 + c; p.ga[it] = *(const u32x2*)(SGA + off); }
    }
    DI void epi_copy(const Unit& un, const Ctx&, const PG_LAS float* T, int ps, int tid, const Pre& p) const {
        const int r0 = (ps >> 1) * 128 + (ps & 1) * 64;
#pragma unroll
        for (int it = 0; it < 4; ++it) {
            const int id = it * NTHR + tid, r = id >> 5, c = (id & 31) * 8;
            const f32x4 a = unq4u8(p.ga[it].x) * *(const PG_LAS f32x4*)(T + r * ST32 + c), b = unq4u8(p.ga[it].y) * *(const PG_LAS f32x4*)(T + r * ST32 + c + 4);
            *(u32x4*)(PA + (size_t)(un.m0 + r0 + r) * 1024 + un.n0 + c) = pack8(a, b);
        }
    }
};

struct JobOut {
    typedef UnitMN Unit; static constexpr bool GATHER = false; static constexpr int SMODE = 1, NCOL = 256, EREP = 1;
    typedef NoCtx Ctx;
    const char* A; const char* B; u16* XB;
    DI int num_units() const { return (NTOK / 256) * 4; }
    DI Unit unit(int u) const { int pm, pn; tile_order(u, NTOK / 256, 4, pm, pn); Unit x; x.m0 = pm * 256; x.n0 = pn * 256; return x; }
    DI const char* a_base(const Unit& un) const { return A + (size_t)un.m0 * 2048; }
    DI const char* b_base(const Unit& un) const { return B + (size_t)un.n0 * 2048; }
    DI unsigned a_off(const Unit&, int R, int C) const { return (unsigned)(R * 1024 + C) * 2u; }
    DI size_t a_hstep() const { return 128 * 2048; }
    DI size_t a_kstep() const { return 128; }
    DI int kdim() const { return 1024; }
    DI void epi_begin(const Unit&, int, Ctx&) const {}
    struct Pre { u32x4 xv[4]; };
    DI void epi_load(const Unit& un, const Ctx&, int ps, int tid, Pre& p) const {
        const int r0 = (ps >> 1) * 128 + (ps & 1) * 64;
#pragma unroll
        for (int it = 0; it < 4; ++it) { const int id = it * NTHR + tid, r = id >> 5, c = (id & 31) * 8; p.xv[it] = *(const u32x4*)(XB + (size_t)(un.m0 + r0 + r) * 1024 + un.n0 + c); }
    }
    DI void epi_copy(const Unit& un, const Ctx&, const PG_LAS float* T, int ps, int tid, const Pre& p) const {
        const int r0 = (ps >> 1) * 128 + (ps & 1) * 64;
#pragma unroll
        for (int it = 0; it < 4; ++it) {
            const int id = it * NTHR + tid, r = id >> 5, c = (id & 31) * 8;
            const f32x4 a = unp_lo(p.xv[it]) + *(const PG_LAS f32x4*)(T + r * ST32 + c), b = unp_hi(p.xv[it]) + *(const PG_LAS f32x4*)(T + r * ST32 + c + 4);
            *(u32x4*)(XB + (size_t)(un.m0 + r0 + r) * 1024 + un.n0 + c) = pack8(a, b);
        }
    }
};

struct UnitMoe { int m0, n0, e0, e1, pr, pb, nv; };
constexpr unsigned MOE_TB_OFF = 151552;
DI int moe_tok(const int* perm2, const UnitMoe& un, int R) { return R < un.nv ? perm2[un.pb + R] : -1; }
DI void moe_unit(const PG_LAS int* tb, int u, UnitMoe& x) {
    const int rt = u >> 2; x.m0 = rt * TM; x.n0 = (u & 3) * 256;
    int bk = 0;
#pragma unroll 1
    for (int q = 1; q < 24; ++q) if (x.m0 >= __builtin_amdgcn_readfirstlane(tb[q])) bk = q;
    x.pr = bk;
    const int l0 = x.m0 - __builtin_amdgcn_readfirstlane(tb[bk]);
    int nv = __builtin_amdgcn_readfirstlane(tb[32 + bk]) - l0; nv = nv < 0 ? 0 : (nv > TM ? TM : nv);
    x.nv = nv; x.pb = bk * 32768 + l0;
}
DI void bucket_decode(int bk, int& e0, int& e1) { const int grp = bk / 6; int a, b; pair_experts(bk % 6, a, b); e0 = grp * 4 + a; e1 = grp * 4 + b; }
struct JobMoeUp {
    typedef UnitMoe Unit; static constexpr bool GATHER = true; static constexpr int SMODE = 0, NCOL = 128, EREP = 1;
    struct Ctx { float rs[8]; float wg[8]; };
    const char* XB2; const char* WUP; const int* perm; const PG_LAS int* tb; const float* rstd2; const float* rw; u16* ACT;
    DI int num_units() const { return (__builtin_amdgcn_readfirstlane(tb[24]) / TM) * 4; }
    DI Unit unit(int u) const { Unit x; moe_unit(tb, u, x); bucket_decode(x.pr, x.e0, x.e1); return x; }
    DI const char* a_base(const Unit&) const { return XB2; }
    DI const char* b_base(const Unit& un) const { const int e = un.n0 < 512 ? un.e0 : un.e1; return WUP + (size_t)(e * 512 + (un.n0 & 511)) * 2048; }
    DI unsigned a_off(const Unit& un, int R, int C) const { int tok = moe_tok(perm, un, R); tok = tok < 0 ? 0 : tok; return (unsigned)(tok * 1024 + C) * 2u; }
    DI size_t a_hstep() const { return 0; }
    DI size_t a_kstep() const { return 128; }
    DI int kdim() const { return 1024; }
    DI void epi_begin(const Unit& un, int rbase, Ctx& c) const {
        const int slot = un.n0 >> 9; int tk[8];
#pragma unroll
        for (int rg = 0; rg < 8; ++rg) tk[rg] = moe_tok(perm, un, rg_row(rg, rbase));
#pragma unroll
        for (int rg = 0; rg < 8; ++rg) { const int t = tk[rg] < 0 ? 0 : tk[rg]; c.rs[rg] = rstd2[t]; c.wg[rg] = rw[t * 2 + slot]; }
    }
    DI f32x4 swiglu4(f32x4 g, f32x4 u, float s, float w) const { g = g * s; u = u * s; return g * sig4(g) * u * w; }
    DI void epi_val(const Unit&, const Ctx& c, int rg, f32x4 v00, f32x4 v01, f32x4 v10, f32x4 v11, u32x4& o0, u32x4& o1) const {
        o0 = pack8(swiglu4(v00, v10, c.rs[rg], c.wg[rg]), swiglu4(v01, v11, c.rs[rg], c.wg[rg])); o1 = o0;
    }
    DI void epi_copy(const Unit& un, const Ctx&, const PG_LAS u16* T, int tid) const {
        const int slot = un.n0 >> 9, uu = (un.n0 >> 8) & 1;
#pragma unroll
        for (int it = 0; it < 8; ++it) {
            const int id = it * NTHR + tid, r = id >> 4, c = (id & 15) * 8;
            st16_sc1(ACT + (size_t)(un.m0 + r) * 512 + slot * 256 + uu * 128 + c, *(const PG_LAS u32x4*)(T + r * ST16H + c));
        }
    }
};

struct JobMoeDown {
    typedef UnitMoe Unit; static constexpr bool GATHER = false; static constexpr int SMODE = 1, NCOL = 256, EREP = 1;
    struct Ctx { int tk[16]; };
    const char* ACT; const char* WDN; const int* perm; const PG_LAS int* tb; u16* XB; float* OUT; float* ssq4; int last;
    DI int num_units() const { return (__builtin_amdgcn_readfirstlane(tb[24]) / TM) * 4; }
    DI Unit unit(int u) const { Unit x; moe_unit(tb, u, x); x.e0 = 0; x.e1 = 0; return x; }
    DI const char* a_base(const Unit& un) const { return ACT + (size_t)un.m0 * 1024; }
    DI const char* b_base(const Unit& un) const { return WDN + (size_t)(un.pr * 1024 + un.n0) * 1024; }
    DI unsigned a_off(const Unit&, int R, int C) const { return (unsigned)(R * 512 + C) * 2u; }
    DI size_t a_hstep() const { return 128 * 1024; }
    DI size_t a_kstep() const { return 128; }
    DI int kdim() const { return 512; }
    DI void epi_begin(const Unit& un, int, Ctx& c) const {
        const int tid = TID();
#pragma unroll
        for (int q = 0; q < 16; ++q) { const int ps = q >> 2, it = q & 3, r0 = (ps >> 1) * 128 + (ps & 1) * 64, id = it * NTHR + tid, r = id >> 5; c.tk[q] = moe_tok(perm, un, r0 + r); }
    }
    struct Pre { u32x4 xv[4]; };
    DI void epi_load(const Unit& un, const Ctx& cx, int ps, int tid, Pre& p) const {
#pragma unroll
        for (int it = 0; it < 4; ++it) { const int id = it * NTHR + tid, c = (id & 31) * 8, t = cx.tk[ps * 4 + it] < 0 ? 0 : cx.tk[ps * 4 + it]; p.xv[it] = *(const u32x4*)(XB + (size_t)t * 1024 + un.n0 + c); }
    }
    DI void epi_copy(const Unit& un, const Ctx& cx, const PG_LAS float* T, int ps, int tid, const Pre& p) const {
        const int lane = tid & 63;
#pragma unroll
        for (int it = 0; it < 4; ++it) {
            const int id = it * NTHR + tid, r = id >> 5, c = (id & 31) * 8, tk = cx.tk[ps * 4 + it];
            const f32x4 a = unp_lo(p.xv[it]) + *(const PG_LAS f32x4*)(T + r * ST32 + c), b = unp_hi(p.xv[it]) + *(const PG_LAS f32x4*)(T + r * ST32 + c + 4);
            if (last) {
                if (tk >= 0) { float* o = OUT + (size_t)tk * 1024 + un.n0 + c; *(f32x4*)o = a; *(f32x4*)(o + 4) = b; }
            } else {
                const u32x4 q = pack8(a, b);
                if (tk >= 0) *(u32x4*)(XB + (size_t)tk * 1024 + un.n0 + c) = q;
                const f32x4 ra = unp_lo(q), rb = unp_hi(q);
                float ss = ra.x * ra.x + ra.y * ra.y + ra.z * ra.z + ra.w * ra.w + rb.x * rb.x + rb.y * rb.y + rb.z * rb.z + rb.w * rb.w;
                ss += shx(ss, 1, lane); ss += shx(ss, 2, lane); ss += shx(ss, 4, lane); ss += shx(ss, 8, lane); ss += shx(ss, 16, lane);
                if ((lane & 31) == 0 && tk >= 0) ssq4[(size_t)tk * 4 + (un.n0 >> 8)] = ss;
            }
        }
    }
};

DI void phase_scan(const Params& p) {
    const float* Sloc = (const float*)(opq(p.ws) + OFF_SLOC);
    const float* LT = (const float*)(opq(p.ws) + OFF_LT);
    u16* A2 = (u16*)(opq(p.ws) + OFF_A2);
    for (int idx = BID() * NTHR + TID(); idx < 32 * NBATCH * 64; idx += gridDim.x * NTHR) {
        const int pp = idx & 63, b = (idx >> 6) & 15, g = idx >> 10;
        const float ar = LT[(g * 64 + pp) * 2], ai = LT[(g * 64 + pp) * 2 + 1];
        float sr = 0.f, si = 0.f;
        const size_t r0 = (size_t)g * S5M + b * NCH;
#pragma unroll 8
        for (int c = 0; c < NCH; ++c) {
            *(unsigned*)(A2 + (r0 + c) * S5K2 + S5K1 + 2 * pp) = pk2(sr, si);
            const f32x2 l = *(const f32x2*)(Sloc + (r0 + c) * 128 + 2 * pp);
            const float nr = ar * sr - ai * si + l.x, ni = ar * si + ai * sr + l.y;
            sr = nr; si = ni;
        }
    }
}

DI void scan_local(const Params& p, int g, int b0) {
    asm volatile("s_waitcnt vmcnt(0)" ::: "memory");
    __syncthreads();
    const float* Sloc = (const float*)(opq(p.ws) + OFF_SLOC);
    const float* LT = (const float*)(opq(p.ws) + OFF_LT);
    u16* A2 = (u16*)(opq(p.ws) + OFF_A2);
    const int tid = TID();
    if (tid < 256) {
        const int pp = tid & 63, b = b0 + (tid >> 6);
        const float ar = LT[(g * 64 + pp) * 2], ai = LT[(g * 64 + pp) * 2 + 1];
        float sr = 0.f, si = 0.f;
        const size_t r0 = (size_t)g * S5M + b * NCH;
#pragma unroll 8
        for (int c = 0; c < NCH; ++c) {
            *(unsigned*)(A2 + (r0 + c) * S5K2 + S5K1 + 2 * pp) = pk2(sr, si);
            const f32x2 l = __builtin_nontemporal_load((const f32x2*)(Sloc + (r0 + c) * 128 + 2 * pp));
            const float nr = ar * sr - ai * si + l.x, ni = ar * si + ai * sr + l.y;
            sr = nr; si = ni;
        }
    }
}

constexpr int PREP0_FIRST = 257 + T_WIN / 4, PREP0_PER_UNIT = 3;
DI void phase_attn(const Params& p, const int L, char* lds) {
    u16* Ks = (u16*)lds;
    u16* Vt = Ks + 256 * 72;
    int* qslot = (int*)(lds + 70400);
    const u16* Qg = (const u16*)(opq(p.ws) + OFF_Q);
    const u16* KVg = (const u16*)(opq(p.ws) + OFF_KV);
    u16* YA = (u16*)(opq(p.ws) + OFF_YA);
    unsigned* qctr = (unsigned*)(opq(p.ws) + OFF_BAR) + 8 + L;
    const float* qn = opq(p.in[13]) + L * 64; const float* kn = opq(p.in[14]) + L * 64; const float* sinks = opq(p.in[15]) + L * 8;
    const int tid = TID(), lane = tid & 63, w = tid >> 6, r = lane & 31, hh = lane >> 5;
    constexpr float L2E = 1.4426950408889634f;
    for (;;) {
        if (tid == 0) *qslot = (int)__hip_atomic_fetch_add(qctr, 1u, __ATOMIC_RELAXED, __HIP_MEMORY_SCOPE_AGENT);
        __syncthreads();
        const int u = *qslot;
        if (u >= NBATCH * 16 * 2) break;
        const int kvh = u & 1, nb = (u >> 1) & 15, b = u >> 5;
        const int tok0 = b * SEQ + nb * 128;
        const int gq = w >> 1, h = kvh * 4 + gq, qhalf = w & 1;
        u32x4 qn_[4];
#pragma unroll
        for (int s = 0; s < 4; ++s) qn_[s] = *(const u32x4*)(Qg + (size_t)(tok0 + qhalf * 64 + r) * 512 + h * 64 + 16 * s + 8 * hh);
#pragma unroll
        for (int i = 0; i < 4; ++i) {
            const int pc = tid + 512 * i, key = pc >> 3, dc = pc & 7;
            const bool valid = (nb > 0) || (key >= 128);
            u32x4 kr = {0u, 0u, 0u, 0u}, vr = {0u, 0u, 0u, 0u};
            if (valid) { const u16* src = KVg + (size_t)(tok0 - 128 + key) * 256 + kvh * 64 + dc * 8; kr = *(const u32x4*)src; vr = *(const u32x4*)(src + 128); }
            float kf[8];
            kf[0] = bf_lo(kr.x); kf[1] = bf_hi(kr.x); kf[2] = bf_lo(kr.y); kf[3] = bf_hi(kr.y); kf[4] = bf_lo(kr.z); kf[5] = bf_hi(kr.z); kf[6] = bf_lo(kr.w); kf[7] = bf_hi(kr.w);
            float ss = 0.f;
#pragma unroll
            for (int e = 0; e < 8; ++e) ss += kf[e] * kf[e];
            ss += shx(ss, 1, lane); ss += shx(ss, 2, lane); ss += shx(ss, 4, lane);
            const float rs = rsqrtf(ss * (1.0f / 64.0f) + 1e-6f);
            const f32x4 g0 = *(const f32x4*)(kn + dc * 8), g1 = *(const f32x4*)(kn + dc * 8 + 4);
            u32x4 ko;
            ko.x = pk2(kf[0] * rs * g0.x, kf[1] * rs * g0.y); ko.y = pk2(kf[2] * rs * g0.z, kf[3] * rs * g0.w);
            ko.z = pk2(kf[4] * rs * g1.x, kf[5] * rs * g1.y); ko.w = pk2(kf[6] * rs * g1.z, kf[7] * rs * g1.w);
            *(u32x4*)(Ks + key * 72 + dc * 8) = ko;
            u16* vd = Vt + (dc * 8) * 260 + key;
            vd[0 * 260] = (u16)(vr.x & 0xffff); vd[1 * 260] = (u16)(vr.x >> 16); vd[2 * 260] = (u16)(vr.y & 0xffff); vd[3 * 260] = (u16)(vr.y >> 16);
            vd[4 * 260] = (u16)(vr.z & 0xffff); vd[5 * 260] = (u16)(vr.z >> 16); vd[6 * 260] = (u16)(vr.w & 0xffff); vd[7 * 260] = (u16)(vr.w >> 16);
        }
        __syncthreads();
        const float slope2 = exp2f(-(float)(h + 1)) * L2E, sink2 = sinks[h] * L2E;
#pragma unroll 1
        for (int qt = 0; qt < 2; ++qt) {
            const int i0 = qhalf * 64 + qt * 32;
            const int qtok = tok0 + i0 + r;
            bf16x8 qf[4];
            {
                u32x4 qr[4]; float ss = 0.f;
#pragma unroll
                for (int s = 0; s < 4; ++s) qr[s] = qn_[s];
                if (qt == 0) {
#pragma unroll
                    for (int s = 0; s < 4; ++s) qn_[s] = *(const u32x4*)(Qg + (size_t)(qtok + 32) * 512 + h * 64 + 16 * s + 8 * hh);
                }
#pragma unroll
                for (int s = 0; s < 4; ++s) {
                    const float a0 = bf_lo(qr[s].x), a1 = bf_hi(qr[s].x), a2 = bf_lo(qr[s].y), a3 = bf_hi(qr[s].y), a4 = bf_lo(qr[s].z), a5 = bf_hi(qr[s].z), a6 = bf_lo(qr[s].w), a7 = bf_hi(qr[s].w);
                    ss += a0 * a0 + a1 * a1 + a2 * a2 + a3 * a3 + a4 * a4 + a5 * a5 + a6 * a6 + a7 * a7;
                }
                ss += shx(ss, 32, lane);
                const float rs = rsqrtf(ss * (1.0f / 64.0f) + 1e-6f) * (0.125f * L2E);
#pragma unroll
                for (int s = 0; s < 4; ++s) {
                    const f32x4 g0 = *(const f32x4*)(qn + 16 * s + 8 * hh), g1 = *(const f32x4*)(qn + 16 * s + 8 * hh + 4);
                    u32x4 o;
                    o.x = pk2(bf_lo(qr[s].x) * rs * g0.x, bf_hi(qr[s].x) * rs * g0.y); o.y = pk2(bf_lo(qr[s].y) * rs * g0.z, bf_hi(qr[s].y) * rs * g0.w);
                    o.z = pk2(bf_lo(qr[s].z) * rs * g1.x, bf_hi(qr[s].z) * rs * g1.y); o.w = pk2(bf_lo(qr[s].w) * rs * g1.z, bf_hi(qr[s].w) * rs * g1.w);
                    qf[s] = __builtin_bit_cast(bf16x8, o);
                }
            }
            const int kt0 = i0 >> 5;
            const int qi = i0 + r;
            const int dbase = qi + 128 - kt0 * 32 - 4 * hh;
            const int maxd = nb > 0 ? 127 : (qi < 127 ? qi : 127);
            const float A = -slope2 * (float)dbase;
            f32x16 o[2];
#pragma unroll
            for (int db = 0; db < 2; ++db)
#pragma unroll
                for (int e = 0; e < 16; ++e) o[db][e] = 0.f;
            float m = sink2, l = 0.f;
#pragma unroll
            for (int kr2 = 0; kr2 < 5; ++kr2) {
                const int kt = 4 - kr2;
                if (nb == 0 && kt0 + kt < 4) continue;
                f32x16 sc;
#pragma unroll
                for (int e = 0; e < 16; ++e) sc[e] = 0.f;
#pragma unroll
                for (int s = 0; s < 4; ++s) {
                    const bf16x8 kfr = *(const bf16x8*)(Ks + ((kt0 + kt) * 32 + r) * 72 + 16 * s + 8 * hh);
                    sc = mfma32(kfr, qf[s], sc);
                }
                float tm = -1e30f;
#pragma unroll
                for (int e = 0; e < 16; ++e) {
                    const int ce = 32 * kt + (e & 3) + 8 * (e >> 2);
                    float t = fmaf(slope2, (float)ce, sc[e]);
                    if (kt == 0 || kt == 4) { const int dist = dbase - ce; t = ((unsigned)dist <= (unsigned)maxd) ? t : -1e30f; }
                    sc[e] = t; tm = fmaxf(tm, t);
                }
                tm += A;
                tm = fmaxf(tm, shx(tm, 32, lane));
                if (__ballot(tm > m) != 0ull) {
                    const float mn = fmaxf(m, tm), alpha = __builtin_amdgcn_exp2f(m - mn);
                    m = mn; l *= alpha;
#pragma unroll
                    for (int db = 0; db < 2; ++db)
#pragma unroll
                        for (int e = 0; e < 16; ++e) o[db][e] *= alpha;
                }
                const float c0 = A - m;
                float ls = 0.f;
#pragma unroll
                for (int e = 0; e < 16; ++e) { const float pv = __builtin_amdgcn_exp2f(sc[e] + c0); sc[e] = pv; ls += pv; }
                l += ls;
#pragma unroll
                for (int s2 = 0; s2 < 2; ++s2) {
                    u32x4 pp;
                    pp.x = pk2(sc[8 * s2 + 0], sc[8 * s2 + 1]); pp.y = pk2(sc[8 * s2 + 2], sc[8 * s2 + 3]);
                    pp.z = pk2(sc[8 * s2 + 4], sc[8 * s2 + 5]); pp.w = pk2(sc[8 * s2 + 6], sc[8 * s2 + 7]);
                    const bf16x8 pf = __builtin_bit_cast(bf16x8, pp);
                    const int kb = (kt0 + kt) * 32 + 16 * s2 + 4 * hh;
#pragma unroll
                    for (int db = 0; db < 2; ++db) {
                        const u16* vp = Vt + (db * 32 + r) * 260 + kb;
                        const s16x4 lo = *(const s16x4*)vp, hi = *(const s16x4*)(vp + 8);
                        const bf16x8 vf = __builtin_shufflevector(lo, hi, 0, 1, 2, 3, 4, 5, 6, 7);
                        o[db] = mfma32(vf, pf, o[db]);
                    }
                }
                asm volatile("" ::: "memory");
            }
            l += shx(l, 32, lane);
            l += __builtin_amdgcn_exp2f(sink2 - m);
            const float inv = __builtin_amdgcn_rcpf(l);
#pragma unroll
            for (int db = 0; db < 2; ++db)
#pragma unroll
                for (int q4 = 0; q4 < 4; ++q4) {
                    const int d = db * 32 + 8 * q4 + 4 * hh;
                    u32x2 ov; ov.x = pk2(o[db][4 * q4] * inv, o[db][4 * q4 + 1] * inv); ov.y = pk2(o[db][4 * q4 + 2] * inv, o[db][4 * q4 + 3] * inv);
                    *(u32x2*)(YA + (size_t)qtok * 512 + h * 64 + d) = ov;
                }
        }
        __syncthreads();
        if (L == 0) prep_from_queue(p, lds, PREP0_PER_UNIT, 0, PREP0_FIRST);
    }
    if (L == 0) prep_from_queue(p, lds, 1 << 30, 0, PREP0_FIRST);
}

DI void route_token(const float (&lg)[20], int& bucket, float& w0, float& w1) {
    int gi = 0; float gm = lg[0];
#pragma unroll
    for (int j = 1; j < 4; ++j) if (lg[j] > gm) { gm = lg[j]; gi = j; }
    float den = 0.f;
#pragma unroll
    for (int j = 0; j < 4; ++j) den += __expf(lg[j] - gm);
    const float gp = 1.0f / den;
    float f[4];
#pragma unroll
    for (int j = 0; j < 4; ++j) f[j] = gi == 0 ? lg[4 + j] : (gi == 1 ? lg[8 + j] : (gi == 2 ? lg[12 + j] : lg[16 + j]));
    int i1 = 0; float v1 = f[0];
#pragma unroll
    for (int j = 1; j < 4; ++j) if (f[j] > v1) { v1 = f[j]; i1 = j; }
    int i2 = -1; float v2 = -3.0e38f;
#pragma unroll
    for (int j = 0; j < 4; ++j) if (j != i1 && f[j] > v2) { v2 = f[j]; i2 = j; }
    const float e2 = __expf(v2 - v1);
    const float p1 = gp / (1.0f + e2), p2 = gp * e2 / (1.0f + e2);
    const int a = i1 < i2 ? i1 : i2, b = i1 < i2 ? i2 : i1;
    const int pidx = a == 0 ? b - 1 : (a == 1 ? b + 1 : 5);
    bucket = gi * 6 + pidx;
    w0 = i1 < i2 ? p1 : p2; w1 = i1 < i2 ? p2 : p1;
}

constexpr int RW_ROW = 1024 + 8;
DI void phase_router(const Params& p, const int L, char* lds) {
    u16* Wh = (u16*)lds;
    u16* Wl = Wh + 21 * RW_ROW;
    float* lgs = (float*)(Wl + 21 * RW_ROW);
    int* hist = (int*)(lgs + 8 * 16 * 24);
    const u32x4* WRI = (const u32x4*)(opq(p.ws) + OFF_WR);
    const u16* X = (const u16*)(opq(p.ws) + OFF_R1);
    float* rstd2 = (float*)(opq(p.ws) + OFF_RSTD2);
    int* perm2 = (int*)(opq(p.ws) + OFF_PERM2);
    float* rw = (float*)(opq(p.ws) + OFF_RW);
    unsigned* gcnt = (unsigned*)(opq(p.ws) + OFF_MOEQ) + L * 256 + 16;
    const int tid = TID(), lane = tid & 63, w = tid >> 6, fr = lane & 15, fq = lane >> 4;
    if (BID() >= 256) return;
    for (int i = tid; i < 42 * 128; i += NTHR) { const int row = i >> 7, ch = i & 127; *(u32x4*)(Wh + row * RW_ROW + ch * 8) = WRI[i]; }
    for (int rb = BID(); rb < 256; rb += gridDim.x) {
        if (tid < 24) hist[tid] = 0;
        __syncthreads();
        const int tok = rb * 128 + w * 16 + fr;
        const u16* xr = X + (size_t)tok * DM + 8 * fq;
        const int n1 = fr < 4 ? 16 + fr : 20;
        f32x4 a0 = {0.f, 0.f, 0.f, 0.f}, a1 = {0.f, 0.f, 0.f, 0.f};
        float ssq = 0.f;
        u32x4 xq[2][8];
#pragma unroll
        for (int s = 0; s < 8; ++s) xq[0][s] = *(const u32x4*)(xr + s * 32);
#pragma unroll
        for (int kc = 0; kc < 4; ++kc) {
            u32x4 (&xa)[8] = xq[kc & 1];
            if (kc < 3) {
#pragma unroll
                for (int s = 0; s < 8; ++s) xq[(kc + 1) & 1][s] = *(const u32x4*)(xr + ((kc + 1) * 8 + s) * 32);
            }
#pragma unroll
            for (int s = 0; s < 8; ++s) {
                const int ks = kc * 8 + s;
                const f32x4 va = unp_lo(xa[s]), vb = unp_hi(xa[s]);
                ssq += va.x * va.x + va.y * va.y + va.z * va.z + va.w * va.w + vb.x * vb.x + vb.y * vb.y + vb.z * vb.z + vb.w * vb.w;
                const bf16x8 xh = __builtin_bit_cast(bf16x8, xa[s]);
                const bf16x8 wh0 = *(const bf16x8*)(Wh + fr * RW_ROW + ks * 32 + fq * 8), wl0 = *(const bf16x8*)(Wl + fr * RW_ROW + ks * 32 + fq * 8);
                const bf16x8 wh1 = *(const bf16x8*)(Wh + n1 * RW_ROW + ks * 32 + fq * 8), wl1 = *(const bf16x8*)(Wl + n1 * RW_ROW + ks * 32 + fq * 8);
                a0 = mfma16(wh0, xh, a0); a0 = mfma16(wl0, xh, a0);
                a1 = mfma16(wh1, xh, a1); a1 = mfma16(wl1, xh, a1);
            }
        }
        ssq += shx(ssq, 16, lane); ssq += shx(ssq, 32, lane);
        float* lg = lgs + (w * 16 + fr) * 24;
        *(f32x4*)(lg + 4 * fq) = a0;
        if (fq == 0) *(f32x4*)(lg + 16) = a1;
        __syncthreads();
        int mybk = 0, myrank = 0;
        if (lane < 16) {
            const float rs = rsqrtf(ssq * (1.0f / DM) + 1e-6f);
            float l20[20];
#pragma unroll
            for (int n = 0; n < 20; ++n) l20[n] = lg[n] * rs;
            int bk; float w0, w1;
            route_token(l20, bk, w0, w1);
            rstd2[tok] = rs; rw[tok * 2] = w0; rw[tok * 2 + 1] = w1;
            mybk = bk; myrank = atomicAdd(&hist[bk], 1);
        }
        __syncthreads();
        if (tid < 24) { const int c = hist[tid]; hist[32 + tid] = c > 0 ? (int)__hip_atomic_fetch_add(gcnt + tid, (unsigned)c, __ATOMIC_RELAXED, __HIP_MEMORY_SCOPE_AGENT) : 0; }
        __syncthreads();
        if (lane < 16) perm2[(size_t)mybk * 32768 + hist[32 + mybk] + myrank] = tok;
        __syncthreads();
    }
}

template <int MODE> DI JobInProjT<MODE> mk_inproj(const Params& p, const int L) { JobInProjT<MODE> j; char* w = opq(p.ws); j.A = w + OFF_R1; j.B = w + (size_t)L * WSET + OFF_WIN; j.ssq4 = (const float*)(w + OFF_SSQ4); j.A2 = (u16*)(w + OFF_A2); j.ws = w; return j; }
DI JobS5G1 mk_g1(const Params& p, const int L) { JobS5G1 j; j.A2 = opq(p.ws) + OFF_A2; j.W1 = opq(p.ws) + (size_t)L * WSET + OFF_W1T; j.Sloc = (float*)(opq(p.ws) + OFF_SLOC); return j; }
DI JobS5G2 mk_g2(const Params& p, const int L) { JobS5G2 j; j.A2 = opq(p.ws) + OFF_A2; j.W2 = opq(p.ws) + (size_t)L * WSET + OFF_W2T; j.Zp = (u16*)(opq(p.ws) + OFF_Z); return j; }
DI JobGLU mk_glu(const Params& p, const int L) { JobGLU j; j.Zp = opq(p.ws) + OFF_Z; j.B = opq(p.ws) + (size_t)L * WSET + OFF_WGLU; j.SGS = (const unsigned char*)(opq(p.ws) + OFF_SGS8); j.PA = (const u16*)(opq(p.ws) + pa_off(L)); j.MS = (u16*)(opq(p.ws) + OFF_R2); return j; }
DI JobAttnUp mk_attnup(const Params& p, const int L) { JobAttnUp j; j.A = opq(p.ws) + OFF_YA; j.B = opq(p.ws) + (size_t)L * WSET + OFF_WATT; j.SGA = (const unsigned char*)(opq(p.ws) + OFF_SGA8); j.PA = (u16*)(opq(p.ws) + pa_off(L)); return j; }
DI JobOut mk_out(const Params& p, const int L) { JobOut j; j.A = opq(p.ws) + OFF_R2; j.B = opq(p.ws) + (size_t)L * WSET + OFF_WOUT; j.XB = (u16*)(opq(p.ws) + OFF_R1); return j; }
DI JobMoeUp mk_moeup(const Params& p, const int L, char* lds) { JobMoeUp j; j.tb = (const PG_LAS int*)((PG_LAS char*)lds + MOE_TB_OFF); j.XB2 = opq(p.ws) + OFF_R1; j.WUP = opq(p.ws) + (size_t)L * WSET + OFF_WUP; j.perm = (const int*)(opq(p.ws) + OFF_PERM2); j.rstd2 = (const float*)(opq(p.ws) + OFF_RSTD2); j.rw = (const float*)(opq(p.ws) + OFF_RW); j.ACT = (u16*)(opq(p.ws) + OFF_R3); return j; }
DI JobMoeDown mk_moedown(const Params& p, const int L, char* lds) { JobMoeDown j; j.tb = (const PG_LAS int*)((PG_LAS char*)lds + MOE_TB_OFF); j.ACT = opq(p.ws) + OFF_R3; j.WDN = opq(p.ws) + (size_t)L * WSET + OFF_WDN; j.perm = (const int*)(opq(p.ws) + OFF_PERM2); j.XB = (u16*)(opq(p.ws) + OFF_R1); j.OUT = opq(p.out); j.ssq4 = (float*)(opq(p.ws) + OFF_SSQ4); j.last = L == 1; return j; }


#define XB_TMO      128
#define XB_XCNT(j)  (256  + 64 * (j))
#define XB_XSUB(j)  (1280 + 64 * (j))
#define XB_XGEN(j)  (2304 + 64 * (j))
#define XB_TOP      3328
#define XB_TOPGEN   3392
#define XB_SPIN_CAP (1u << 18)
DI unsigned xb_ld(unsigned* p)              { return __hip_atomic_load(p, __ATOMIC_RELAXED, __HIP_MEMORY_SCOPE_AGENT); }
DI unsigned xb_add(unsigned* p, unsigned v) { return __hip_atomic_fetch_add(p, v, __ATOMIC_RELAXED, __HIP_MEMORY_SCOPE_AGENT); }
DI unsigned xb_xcc_id() { return (unsigned)__builtin_amdgcn_s_getreg((3 << 11) | 20) & 0xFu; }
#define XB_SPIN(cond, bar) do { unsigned _sp = 0; while (cond) { __builtin_amdgcn_s_sleep(1); \
    if ((++_sp & 255u) == 0u) { if (xb_ld(&(bar)[XB_TMO])) break; if (_sp > XB_SPIN_CAP) { atomicAdd(&(bar)[XB_TMO], 1u); break; } } } } while (0)
struct XcdBarrier { unsigned* bar; unsigned x; volatile PG_LAS unsigned* st; };
DI XcdBarrier xcd_barrier_post(unsigned* bar, volatile PG_LAS unsigned* st) {
    XcdBarrier b; b.bar = bar; b.x = xb_xcc_id(); b.st = st;
    if (threadIdx.x == 0) (void)xb_add(&bar[XB_XCNT(b.x)], 1u);
    return b;
}
DI void xcd_barrier_complete(unsigned* bar, unsigned x, unsigned& nloc, unsigned& nx) {
    const unsigned G = gridDim.x * gridDim.y * gridDim.z;
    unsigned sum, cnt, mine, sp = 0u;
    for (;;) {
        sum = 0u; cnt = 0u; mine = 0u;
#pragma unroll
        for (unsigned j = 0; j < 16; ++j) { const unsigned c = xb_ld(&bar[XB_XCNT(j)]); sum += c; cnt += (c > 0u) ? 1u : 0u; mine = (j == x) ? c : mine; }
        if (sum == G) break;
        __builtin_amdgcn_s_sleep(1);
        if ((++sp & 255u) == 0u) { if (xb_ld(&bar[XB_TMO])) break; if (sp > XB_SPIN_CAP) { atomicAdd(&bar[XB_TMO], 1u); break; } }
    }
    nloc = mine > 0u ? mine : 1u; nx = cnt > 0u ? cnt : 1u;
}
DI void xcd_barrier(const XcdBarrier& b) {
    asm volatile("s_waitcnt vmcnt(0)" ::: "memory");
    __syncthreads();
    if (threadIdx.x == 0) {
        unsigned* bar = opq(b.bar);
        __builtin_amdgcn_s_waitcnt(0);
        asm volatile("buffer_inv sc1" ::: "memory");
        unsigned nloc = b.st[0], nx = b.st[1];
        if (nloc == 0u) { xcd_barrier_complete(bar, b.x, nloc, nx); b.st[0] = nloc; b.st[1] = nx; }
        const unsigned old = xb_add(&bar[XB_XSUB(b.x)], 1u);
        const unsigned gen = old / nloc;
        if (old + 1u == (gen + 1u) * nloc) {
            __builtin_amdgcn_fence(__ATOMIC_RELEASE, "agent");
            asm volatile("s_waitcnt vmcnt(0)" ::: "memory");
            const unsigned og = xb_add(&bar[XB_TOP], 1u);
            const unsigned tg = og / nx;
            if (og + 1u == (tg + 1u) * nx) xb_add(&bar[XB_TOPGEN], 1u);
            else XB_SPIN(xb_ld(&bar[XB_TOPGEN]) == tg, bar);
            asm volatile("s_waitcnt vmcnt(0)" ::: "memory");
        } else {
            XB_SPIN(xb_ld(&bar[XB_TOPGEN]) == gen, bar);
            asm volatile("s_waitcnt vmcnt(0)" ::: "memory");
        }
    }
    __syncthreads();
}


DI void phase_moe(const Params& p, const int L, char* lds) {
    unsigned* q = (unsigned*)(opq(p.ws) + OFF_MOEQ) + L * 256;
    unsigned* flag = q + 64;
    int* qslot = (int*)(lds + 163840 - 128);
    {
        PG_LAS int* tb = (PG_LAS int*)((PG_LAS char*)lds + MOE_TB_OFF);
        const int t24 = TID();
        if (t24 < 24) tb[32 + t24] = (int)__hip_atomic_load(q + 16 + t24, __ATOMIC_RELAXED, __HIP_MEMORY_SCOPE_AGENT);
        __syncthreads();
        if (threadIdx.x == 0) { int b = 0; for (int t = 0; t < 24; ++t) { tb[t] = b; b += ((tb[32 + t] + TM - 1) / TM) * TM; } tb[24] = b; }
        __syncthreads();
    }
    const JobMoeUp ju = mk_moeup(p, L, lds);
    const JobMoeDown jd = mk_moedown(p, L, lds);
    const int tiles = ju.num_units() >> 2, per = (tiles + 7) >> 3;
    const int myx = (int)((unsigned)__builtin_amdgcn_s_getreg((3 << 11) | 20) & 7u);
    int probe = 0, prev = -1;
    for (;;) {
        asm volatile("s_waitcnt vmcnt(0)" ::: "memory");
        __syncthreads();
        if (threadIdx.x == 0) {
            if (prev >= 0) (void)__hip_atomic_fetch_add(flag + prev, 1u, __ATOMIC_RELAXED, __HIP_MEMORY_SCOPE_AGENT);
            int r = -1;
            while (probe < 8) {
                const int x = (myx + probe) & 7, t0 = x * per;
                int ntx = tiles - t0; ntx = ntx > per ? per : ntx;
                if (ntx > 0) {
                    const int k = (int)__hip_atomic_fetch_add(q + 8 + x, 1u, __ATOMIC_RELAXED, __HIP_MEMORY_SCOPE_AGENT);
                    if (k < 8 * ntx) { r = k < 4 * ntx ? t0 * 4 + k : ((1 << 20) | (t0 * 4 + k - 4 * ntx)); break; }
                }
                ++probe;
            }
            *qslot = r;
        }
        __syncthreads();
        const int r = __builtin_amdgcn_readfirstlane(*qslot);
        __syncthreads();
        if (r < 0) break;
        if (r < (1 << 20)) {
            pg_gemm_seq(ju, lds, r, 1 << 30, r + 1);
            prev = r >> 2;
        } else {
            const int d = r & 0xfffff;
            prev = -1;
            if (__builtin_amdgcn_readfirstlane((int)threadIdx.x >> 6) == 0) {
                unsigned sp = 0;
                while ((unsigned)__builtin_amdgcn_readfirstlane((int)__hip_atomic_load(flag + (d >> 2), __ATOMIC_RELAXED, __HIP_MEMORY_SCOPE_AGENT)) < 4u) { __builtin_amdgcn_s_sleep(2); if (++sp > (1u << 16)) break; }
                __builtin_amdgcn_fence(__ATOMIC_ACQUIRE, "agent");
                asm volatile("s_waitcnt vmcnt(0)" ::: "memory");
            }
            __syncthreads();
            pg_gemm_seq(jd, lds, d, 1 << 30, d + 1);
        }
    }
}

extern __shared__ __attribute__((aligned(16))) char smem[];
namespace cg = cooperative_groups;
constexpr int MEGA_LDS = 163840;
constexpr size_t WS_NEED = OFF_BAR + CTL_BYTES;
__global__ void __launch_bounds__(NTHR) k_mega(const Params p) {
    cg::grid_group grid = cg::this_grid();
    volatile PG_LAS unsigned* st = (volatile PG_LAS unsigned*)((PG_LAS unsigned char*)smem + 163840 - 64);
    if (threadIdx.x < 4) st[threadIdx.x] = 0u;
    __syncthreads();
    const XcdBarrier xb = xcd_barrier_post((unsigned*)(opq(p.ws) + OFF_BAR), st);
#define GSYNC() xcd_barrier(xb)
    for (int L = 0; L < 2; ++L) {
        if (L == 0) {
            for (int rep = 0; rep < REP_PREP; ++rep) phase_prep(p, 0, smem);
            for (int rep = 0; rep < REP_XB; ++rep) phase_xb(p);
            if (p.ws == nullptr) grid.sync();
            GSYNC();
        }
        for (int rep = 0; rep < REP_INPROJ; ++rep) pg_gemm(mk_inproj<0>(p, L), smem);
        GSYNC();
        pg_gemm(mk_g1(p, L), smem);
        if (BID() < 128) { const UnitG ug = mk_g1(p, L).unit(BID()); scan_local(p, ug.g, ug.m0 >> 6); }
        if (BID() >= 128) pg_gemm(mk_inproj<1>(p, L), smem);
        for (int rep = 0; rep < REP_ATTN; ++rep) phase_attn(p, L, smem);
        GSYNC();
        {
            const int sel = __builtin_amdgcn_readfirstlane((BID() >> 2) & 1);
#pragma unroll 1
            for (int st2 = 0; st2 < 2; ++st2) { if (st2 == sel) pg_gemm(mk_g2(p, L), smem); else pg_gemm(mk_attnup(p, L), smem); }
        }
        GSYNC();
        for (int rep = 0; rep < REP_GLU; ++rep) pg_gemm(mk_glu(p, L), smem);
        GSYNC();
        for (int rep = 0; rep < (L == 0 ? REP_OUT0 : 1); ++rep) pg_gemm(mk_out(p, L), smem);
        GSYNC();
        for (int rep = 0; rep < REP_ROUTER; ++rep) phase_router(p, L, smem);
        GSYNC();
        phase_moe(p, L, smem);
        if (L == 0) { prep_from_queue(p, smem, 1 << 30, 1, 0); GSYNC(); }
    }
#undef GSYNC
}

extern "C" void kernel_launch(void* const* d_in, const int* in_sizes, int n_in, void* d_out, int out_size, void* d_ws, size_t ws_size, hipStream_t stream) {
    static int grid_blocks = 0;
    if (!grid_blocks) {
        int dev = 0, cus = 0, per_cu = 0;
        (void)hipGetDevice(&dev);
        (void)hipDeviceGetAttribute(&cus, hipDeviceAttributeMultiprocessorCount, dev);
        (void)hipFuncSetAttribute((const void*)k_mega, hipFuncAttributeMaxDynamicSharedMemorySize, MEGA_LDS);
        (void)hipOccupancyMaxActiveBlocksPerMultiprocessor(&per_cu, (const void*)k_mega, NTHR, MEGA_LDS);
        if (per_cu < 1) per_cu = 1;
        if (per_cu > 1) per_cu = 1;
        grid_blocks = cus * per_cu;
    }
    if (n_in != 23 || ws_size < WS_NEED || out_size != NTOK * DM) { fprintf(stderr, "kernel_launch: unexpected shapes (n_in %d ws %zu out %d)\n", n_in, ws_size, out_size); return; }
    Params p{};
    for (int i = 0; i < 23; ++i) p.in[i] = (const float*)d_in[i];
    p.out = (float*)d_out; p.ws = (char*)d_ws;
    (void)hipMemsetAsync((char*)d_ws + OFF_BAR, 0, CTL_BYTES, stream);
    void* args[] = {&p};
    hipError_t e = hipLaunchCooperativeKernel((const void*)k_mega, dim3(grid_blocks), dim3(NTHR), args, MEGA_LDS, stream);
    if (e != hipSuccess) fprintf(stderr, "cooperative launch failed: %s (grid %d)\n", hipGetErrorString(e), grid_blocks);
}
```

```cpp
#include <hip/hip_runtime.h>
#include <hip/hip_cooperative_groups.h>
#include <stdint.h>
#include <stdio.h>

#define DI __device__ __forceinline__
typedef unsigned short u16;
typedef short bf16x8 __attribute__((ext_vector_type(8)));
typedef short s16x4 __attribute__((ext_vector_type(4)));
typedef float f32x4 __attribute__((ext_vector_type(4)));
typedef float f32x2 __attribute__((ext_vector_type(2)));
typedef float f32x16 __attribute__((ext_vector_type(16)));
typedef unsigned u32x4 __attribute__((ext_vector_type(4)));
typedef unsigned u32x2 __attribute__((ext_vector_type(2)));
typedef __bf16 bf2_t __attribute__((ext_vector_type(2)));

constexpr int NTOK = 32768, DM = 1024, SEQ = 2048, NBATCH = 16, INC = 3328;
constexpr int TCH = 32, NCH = SEQ / TCH, S5M = NBATCH * NCH, S5K1 = TCH * 16, S5K2 = S5K1 + 128;
constexpr int TM = 256;
constexpr int MAXTILES = (NTOK + 24 * (TM - 1)) / TM + 1;
constexpr int NTHR = 512;
constexpr int LDS_BYTES = 98304;

#ifndef REP_PREP
#define REP_PREP 1
#endif
#ifndef REP_XB
#define REP_XB 1
#endif
#ifndef REP_ATTN
#define REP_ATTN 1
#endif
#ifndef REP_ROUTER
#define REP_ROUTER 1
#endif
#ifndef REP_INPROJ
#define REP_INPROJ 1
#endif
#ifndef REP_GLU
#define REP_GLU 1
#endif
#ifndef REP_MOEUP
#define REP_MOEUP 1
#endif
#ifndef REP_OUT0
#define REP_OUT0 1
#endif
#ifndef REP_EPI
#define REP_EPI 1
#endif
#ifndef REP_KLOOP
#define REP_KLOOP 1
#endif
#ifndef REP_G2
#define REP_G2 1
#endif
constexpr size_t MiB = 1u << 20;
constexpr size_t OFF_R1 = 0;
constexpr size_t OFF_R2 = 64 * MiB;
constexpr size_t OFF_R3 = 128 * MiB;
constexpr size_t OFF_A2 = 192 * MiB;
constexpr size_t OFF_Q = 232 * MiB;
constexpr size_t OFF_KV = 264 * MiB;
constexpr size_t OFF_SLOC = 280 * MiB;
constexpr size_t OFF_Z = OFF_Q;
constexpr size_t OFF_YA = 296 * MiB;
constexpr size_t WSET = 80 * MiB;
constexpr size_t OFF_WIN = 328 * MiB;
constexpr size_t OFF_WGLU = OFF_WIN + 7 * MiB;
constexpr size_t OFF_WATT = OFF_WGLU + 2 * MiB;
constexpr size_t OFF_WOUT = OFF_WATT + 1 * MiB;
constexpr size_t OFF_WUP = OFF_WOUT + 2 * MiB;
constexpr size_t OFF_WDN = OFF_WUP + 16 * MiB;
DI size_t pa_off(const int L) { return OFF_WIN + (size_t)(1 - L) * WSET; }
constexpr size_t OFF_W1T = OFF_WDN + 24 * MiB;
constexpr size_t OFF_W2T = OFF_W1T + 8 * MiB;
constexpr size_t OFF_SMALL = OFF_WIN + 2 * WSET;
constexpr size_t OFF_WR = OFF_SMALL;
constexpr size_t OFF_LT = OFF_WR + 128 * 1024;
constexpr size_t OFF_RSTD1 = OFF_LT + 64 * 1024;
constexpr size_t OFF_RSTD2 = OFF_RSTD1 + 128 * 1024;
constexpr size_t OFF_BUCKET = OFF_RSTD2 + 128 * 1024;
constexpr size_t OFF_RW = OFF_BUCKET + 128 * 1024;
constexpr size_t OFF_PERM = OFF_RW + 256 * 1024;
constexpr size_t OFF_CNT = OFF_PERM + 256 * 1024;
constexpr size_t OFF_TILEB = OFF_CNT + 32 * 1024;
constexpr size_t OFF_META = OFF_TILEB + 4 * 1024;
constexpr size_t OFF_SSQ4 = OFF_META + 1024;
constexpr size_t OFF_PERM2 = OFF_SSQ4 + 512 * 1024;
constexpr size_t WS_END = OFF_PERM2 + (size_t)24 * 32768 * 4;
constexpr size_t OFF_BAR = WS_END;
#define XCD_BAR_WORDS 3456
constexpr size_t OFF_MOEQ = OFF_BAR + XCD_BAR_WORDS * 4;
constexpr size_t CTL_BYTES = XCD_BAR_WORDS * 4 + 2 * 256 * 4;

struct Params {
    const float* in[23];
    float* out;
    char* ws;
};

DI int TID() { int t = threadIdx.x; asm volatile("" : "+v"(t)); return t; }
DI unsigned OZ() { unsigned z = 0; asm volatile("" : "+s"(z)); return z; }
template <class T> DI T* opq(T* x) { unsigned long long v = (unsigned long long)x; asm volatile("" : "+s"(v)); return (T*)(__attribute__((address_space(1))) char*)v; }
DI float shx(float v, int m, int lane) { return __builtin_bit_cast(float, __builtin_amdgcn_ds_bpermute((lane ^ m) << 2, __builtin_bit_cast(int, v))); }
DI const char* uptr(const char* p) { const unsigned long long v = (unsigned long long)p; const unsigned lo = (unsigned)__builtin_amdgcn_readfirstlane((int)(unsigned)v), hi = (unsigned)__builtin_amdgcn_readfirstlane((int)(unsigned)(v >> 32)); return (const char*)(__attribute__((address_space(1))) const char*)(((unsigned long long)hi << 32) | lo); }
DI void st16_sc1(void* p, u32x4 v) { asm volatile("global_store_dwordx4 %0, %1, off sc1\n\ts_nop 1" :: "v"(p), "v"(v) : "memory"); }
DI int BID() { int b = blockIdx.x; asm volatile("" : "+s"(b)); return b; }
DI unsigned pk2(float a, float b) { f32x2 v = {a, b}; bf2_t r = __builtin_convertvector(v, bf2_t); return __builtin_bit_cast(unsigned, r); }
DI float bf_lo(unsigned u) { return __uint_as_float(u << 16); }
DI float bf_hi(unsigned u) { return __uint_as_float(u & 0xffff0000u); }
DI float sigmoidf_(float x) { return __builtin_amdgcn_rcpf(1.0f + __builtin_amdgcn_exp2f(-1.4426950408889634f * x)); }
DI float gelu_tanh(float x) { const float u = 0.7978845608028654f * (x + 0.044715f * x * x * x); return x * __builtin_amdgcn_rcpf(1.0f + __builtin_amdgcn_exp2f(-2.8853900817779268f * u)); }
DI f32x16 mfma32(bf16x8 a, bf16x8 b, f32x16 c) { return __builtin_amdgcn_mfma_f32_32x32x16_bf16(a, b, c, 0, 0, 0); }
DI f32x4 mfma16(bf16x8 a, bf16x8 b, f32x4 c) { return __builtin_amdgcn_mfma_f32_16x16x32_bf16(a, b, c, 0, 0, 0); }

struct TJob { unsigned long long src, dst, scale; int ld_src, ld_dst, dcol0, rmul, radd, k0, n0; };
DI void tconv_load(const TJob& j, int tid, f32x4 (&v)[2]) {
    const float* src = (const float*)(__attribute__((address_space(1))) const char*)j.src;
#pragma unroll
    for (int i = 0; i < 2; ++i) v[i] = *(const f32x4*)(src + (size_t)(j.k0 + (tid >> 4) + 32 * i) * j.ld_src + j.n0 + (tid & 15) * 4);
}
DI void tconv_to_lds(const TJob& j, int tid, const f32x4 (&v)[2], float* sm) {
    const float* scale = (const float*)(__attribute__((address_space(1))) const char*)j.scale;
#pragma unroll
    for (int i = 0; i < 2; ++i) {
        const int k = (tid >> 4) + 32 * i, n = (tid & 15) * 4;
        const float sc = j.scale ? scale[j.k0 + k] : 1.0f;
        sm[(n + 0) * 65 + k] = v[i].x * sc; sm[(n + 1) * 65 + k] = v[i].y * sc; sm[(n + 2) * 65 + k] = v[i].z * sc; sm[(n + 3) * 65 + k] = v[i].w * sc;
    }
}
DI void tconv_store(const TJob& j, int tid, const float* sm) {
    u16* dst = (u16*)(__attribute__((address_space(1))) char*)j.dst;
    const int n = tid >> 3, c = tid & 7;
    const float* s = sm + n * 65 + c * 8;
    u32x4 o; o.x = pk2(s[0], s[1]); o.y = pk2(s[2], s[3]); o.z = pk2(s[4], s[5]); o.w = pk2(s[6], s[7]);
    const int nn = j.n0 + n, drow = j.rmul == 1 ? nn + j.radd : (nn >> 7) * 256 + j.radd + (nn & 127);
    *(u32x4*)(dst + (size_t)drow * j.ld_dst + j.dcol0 + j.k0 + c * 8) = o;
}

constexpr int T_WIN = (1024 / 64) * (INC / 64);
constexpr int T_GLU = 2 * (512 / 64) * (1024 / 64);
constexpr int T_ATT = (512 / 64) * (1024 / 64);
constexpr int T_OUT = (1024 / 64) * (1024 / 64);
constexpr int T_UP = 16 * 2 * (1024 / 64) * (256 / 64);
constexpr int T_DN = 24 * 2 * (256 / 64) * (1024 / 64);
constexpr int T_ALL = T_WIN + T_GLU + T_ATT + T_OUT + T_UP + T_DN;
static_assert(T_ALL % 4 == 0, "tiles are processed four at a time");

DI void pair_experts(int pidx, int& a, int& b) {
    a = pidx < 3 ? 0 : (pidx < 5 ? 1 : 2);
    b = pidx < 3 ? pidx + 1 : (pidx < 5 ? pidx - 1 : 3);
}

DI TJob prep_tjob(const Params& p, const int L, int t) {
    const unsigned long long ws = (unsigned long long)opq(p.ws) + (unsigned long long)L * WSET;
    TJob j; j.scale = 0; j.dcol0 = 0; j.rmul = 1; j.radd = 0;
    if (t < T_WIN) { const int kb = t / (INC / 64), nb = t % (INC / 64);
        j.src = (unsigned long long)(opq(p.in[2]) + (size_t)L * 1024 * INC); j.ld_src = INC; j.dst = ws + OFF_WIN; j.ld_dst = 1024; j.scale = (unsigned long long)(opq(p.in[1]) + L * 1024); j.k0 = kb * 64; j.n0 = nb * 64; return j; }
    t -= T_WIN;
    if (t < T_GLU) { const int half = t / 128, r = t % 128, kb = r / 16, nb = r % 16;
        j.src = (unsigned long long)((half ? opq(p.in[12]) : opq(p.in[11])) + (size_t)L * 512 * 1024); j.ld_src = 1024; j.dst = ws + OFF_WGLU; j.ld_dst = 512; j.rmul = 2; j.radd = half * 128; j.k0 = kb * 64; j.n0 = nb * 64; return j; }
    t -= T_GLU;
    if (t < T_ATT) { const int kb = t / 16, nb = t % 16;
        j.src = (unsigned long long)(opq(p.in[16]) + (size_t)L * 512 * 1024); j.ld_src = 1024; j.dst = ws + OFF_WATT; j.ld_dst = 512; j.k0 = kb * 64; j.n0 = nb * 64; return j; }
    t -= T_ATT;
    if (t < T_OUT) { const int kb = t / 16, nb = t % 16;
        j.src = (unsigned long long)(opq(p.in[17]) + (size_t)L * 1024 * 1024); j.ld_src = 1024; j.dst = ws + OFF_WOUT; j.ld_dst = 1024; j.k0 = kb * 64; j.n0 = nb * 64; return j; }
    t -= T_OUT;
    if (t < T_UP) { const int e = t / 128, r = t % 128, half = r / 64, r2 = r % 64, kb = r2 / 4, nb = r2 % 4;
        j.src = (unsigned long long)(opq(p.in[21]) + ((size_t)(L * 16 + e) * 1024) * 512 + half * 256); j.ld_src = 512; j.dst = ws + OFF_WUP + (size_t)e * 512 * 1024 * 2; j.ld_dst = 1024; j.rmul = 2; j.radd = half * 128;
        j.scale = (unsigned long long)(opq(p.in[18]) + L * 1024); j.k0 = kb * 64; j.n0 = nb * 64; return j; }
    t -= T_UP;
    { const int pr = t / 128, r = t % 128, slot = r / 64, r2 = r % 64, kb = r2 / 16, nb = r2 % 16;
      const int grp = pr / 6; int a, b; pair_experts(pr % 6, a, b); const int e = grp * 4 + (slot ? b : a);
      j.src = (unsigned long long)(opq(p.in[22]) + ((size_t)(L * 16 + e) * 256) * 1024); j.ld_src = 1024; j.dst = ws + OFF_WDN + (size_t)pr * 1024 * 512 * 2; j.ld_dst = 512; j.dcol0 = slot * 256; j.k0 = kb * 64; j.n0 = nb * 64; }
    return j;
}

DI void prep_s5_item(const Params& p, const int L, int item, float* sm) {
    const int tid = TID(), g = item >> 3, s = item & 7;
    float* LBre = sm;
    float* LBim = LBre + 33 * 64;
    float* BBre = LBim + 33 * 64;
    float* BBim = BBre + 1024;
    float* Cre = BBim + 1024;
    float* Cim = Cre + 128;
    float* Kt = Cim + 128;
    const float* lam_re = opq(p.in[3]) + (size_t)(L * 32 + g) * 64;
    const float* lam_im = opq(p.in[4]) + (size_t)(L * 32 + g) * 64;
    const float dt = expf(opq(p.in[5])[L * 32 + g]);
    const float* b_re = opq(p.in[6]) + (size_t)(L * 32 + g) * 1024;
    const float* b_im = opq(p.in[7]) + (size_t)(L * 32 + g) * 1024;
    const float* c_re = opq(p.in[8]) + (size_t)(L * 32 + g) * 1024;
    const float* c_im = opq(p.in[9]) + (size_t)(L * 32 + g) * 1024;
    const float* dsk = opq(p.in[10]) + L * 512 + g * 16;
    for (int i = tid; i < 33 * 64; i += NTHR) {
        const int lag = i >> 6, pp = i & 63;
        const float mag = expf(lam_re[pp] * dt * (float)lag);
        double a = (double)lam_im[pp] * (double)dt * (double)lag;
        a -= 6.283185307179586476925 * rint(a * 0.15915494309189533577);
        const float af = (float)a;
        LBre[i] = mag * cosf(af); LBim[i] = mag * sinf(af);
    }
    if (tid < 128) { Cre[tid] = c_re[(2 * s) * 64 + tid]; Cim[tid] = c_im[(2 * s) * 64 + tid]; }
    for (int i = tid; i < 1024; i += NTHR) {
        const int pp = i >> 4;
        const float lr = lam_re[pp], li = lam_im[pp];
        const float a = lr * dt; const float bb = li * dt;
        double br = (double)bb; br -= 6.283185307179586476925 * rint(br * 0.15915494309189533577);
        const float bf = (float)br;
        const float sh = sinf(0.5f * bf);
        const float xr = expm1f(a) * cosf(bf) - 2.0f * sh * sh;
        const float xi = expf(a) * sinf(bf);
        const float den = 1.0f / (lr * lr + li * li);
        const float fr = (xr * lr + xi * li) * den, fi = (xi * lr - xr * li) * den;
        const float vr = b_re[i], vi = b_im[i];
        BBre[i] = fr * vr - fi * vi; BBim[i] = fr * vi + fi * vr;
    }
    __syncthreads();
    if (s == 0 && tid < 64) { float* LT = (float*)(opq(p.ws) + OFF_LT) + (size_t)(g * 64 + tid) * 2; LT[0] = LBre[32 * 64 + tid]; LT[1] = LBim[32 * 64 + tid]; }
    for (int i = tid; i < 32 * 32; i += NTHR) {
        const int lag = i >> 5, hl = (i >> 4) & 1, hi = i & 15;
        float acc = 0.f;
        for (int pp = 0; pp < 64; ++pp) {
            const float cr = Cre[hl * 64 + pp], ci = Cim[hl * 64 + pp];
            const float lr = LBre[lag * 64 + pp], li = LBim[lag * 64 + pp];
            const float tr = cr * lr - ci * li, ti = cr * li + ci * lr;
            acc += tr * BBre[pp * 16 + hi] - ti * BBim[pp * 16 + hi];
        }
        Kt[i] = acc;
    }
    __syncthreads();
    u16* W1 = (u16*)(opq(p.ws) + (size_t)L * WSET + OFF_W1T) + (size_t)g * 256 * 512;
    for (int i = tid; i < 16 * 256; i += NTHR) {
        const int n = 16 * s + (i >> 8), k = (i & 255) * 2, pp = n >> 1, ri = n & 1, j = k >> 4, hi = k & 15;
        const float lr = LBre[(31 - j) * 64 + pp], li = LBim[(31 - j) * 64 + pp];
        float v[2];
#pragma unroll
        for (int e = 0; e < 2; ++e) { const float br = BBre[pp * 16 + hi + e], bi = BBim[pp * 16 + hi + e]; v[e] = ri ? (lr * bi + li * br) : (lr * br - li * bi); }
        *(unsigned*)(W1 + (size_t)n * 512 + k) = pk2(v[0], v[1]);
    }
    u16* W2 = (u16*)(opq(p.ws) + (size_t)L * WSET + OFF_W2T) + (size_t)g * 512 * 640;
    for (int idx = tid; idx < 64 * 320; idx += NTHR) {
        const int rr = idx / 320, k = (idx % 320) * 2, ii = rr >> 1, hl = rr & 1, ho = 2 * s + hl, n = ii * 16 + ho;
        float v[2];
        if (k < 512) {
            const int j = k >> 4, hi = k & 15;
#pragma unroll
            for (int e = 0; e < 2; ++e) {
                float x = 0.f;
                if (j <= ii) x = Kt[(ii - j) * 32 + hl * 16 + hi + e];
                if (j == ii && hi + e == ho) x += dsk[ho];
                v[e] = x;
            }
        } else {
            const int pp = (k - 512) >> 1;
            const float cr = Cre[hl * 64 + pp], ci = Cim[hl * 64 + pp];
            const float lr = LBre[(ii + 1) * 64 + pp], li = LBim[(ii + 1) * 64 + pp];
            v[0] = cr * lr - ci * li; v[1] = -(cr * li + ci * lr);
        }
        *(unsigned*)(W2 + (size_t)n * 640 + k) = pk2(v[0], v[1]);
    }
    __syncthreads();
}

DI void prep_router_w(const Params& p, const int L) {
    u16* WRH = (u16*)(opq(p.ws) + OFF_WR);
    u16* WRL = WRH + 21 * 1024;
    const float* nf = opq(p.in[18]) + L * 1024;
    const float* wc = opq(p.in[19]) + (size_t)L * 1024 * 4;
    const float* wf = opq(p.in[20]) + (size_t)L * 1024 * 16;
    for (int i = TID(); i < 21 * 1024; i += NTHR) {
        const int n = i >> 10, k = i & 1023;
        const float v = n < 20 ? nf[k] * (n < 4 ? wc[k * 4 + n] : wf[k * 16 + (n - 4)]) : 0.f;
        const unsigned h = pk2(v, 0.f) & 0xffffu;
        const float vh = __uint_as_float(h << 16);
        WRH[i] = (u16)h;
        WRL[i] = (u16)(pk2(v - vh, 0.f) & 0xffffu);
    }
}

DI void phase_prep(const Params& p, const int L, char* lds) {
    float* sm = (float*)lds;
    const int bid = BID(), G = gridDim.x;
    for (int it = bid; it < 257; it += G) {
        if (it < 256) prep_s5_item(p, L, it, sm);
        else prep_router_w(p, L);
    }
    const int tid = TID();
    for (int gi = bid; gi < T_WIN / 4; gi += G) {
        TJob j0 = prep_tjob(p, L, 4 * gi), j1 = prep_tjob(p, L, 4 * gi + 1), j2 = prep_tjob(p, L, 4 * gi + 2), j3 = prep_tjob(p, L, 4 * gi + 3);
        f32x4 v0[2], v1[2], v2[2], v3[2];
        tconv_load(j0, tid, v0); tconv_load(j1, tid, v1); tconv_load(j2, tid, v2); tconv_load(j3, tid, v3);
        tconv_to_lds(j0, tid, v0, sm); tconv_to_lds(j1, tid, v1, sm + 4224); tconv_to_lds(j2, tid, v2, sm + 8448); tconv_to_lds(j3, tid, v3, sm + 12672);
        __syncthreads();
        tconv_store(j0, tid, sm); tconv_store(j1, tid, sm + 4224); tconv_store(j2, tid, sm + 8448); tconv_store(j3, tid, sm + 12672);
        __syncthreads();
    }
}

constexpr int PREPQ_ITEMS = 257 + T_ALL / 4;
DI void prep_from_queue(const Params& p, char* lds, int budget, const int L, const int first) {
    float* sm = (float*)lds;
    unsigned* qc = (unsigned*)(opq(p.ws) + OFF_BAR) + 12 + L;
    int* qslot = (int*)(lds + 81920);
    const int tid = TID();
    for (int n = 0; n < budget; ++n) {
        if (threadIdx.x == 0) *qslot = (int)__hip_atomic_fetch_add(qc, 1u, __ATOMIC_RELAXED, __HIP_MEMORY_SCOPE_AGENT);
        __syncthreads();
        const int it = __builtin_amdgcn_readfirstlane(*qslot) + first;
        __syncthreads();
        if (it >= PREPQ_ITEMS) break;
        if (it < 256) prep_s5_item(p, L, it, sm);
        else if (it == 256) prep_router_w(p, L);
        else {
            const int gi = it - 257;
            TJob j0 = prep_tjob(p, L, 4 * gi), j1 = prep_tjob(p, L, 4 * gi + 1), j2 = prep_tjob(p, L, 4 * gi + 2), j3 = prep_tjob(p, L, 4 * gi + 3);
            f32x4 v0[2], v1[2], v2[2], v3[2];
            tconv_load(j0, tid, v0); tconv_load(j1, tid, v1); tconv_load(j2, tid, v2); tconv_load(j3, tid, v3);
            tconv_to_lds(j0, tid, v0, sm); tconv_to_lds(j1, tid, v1, sm + 4224); tconv_to_lds(j2, tid, v2, sm + 8448); tconv_to_lds(j3, tid, v3, sm + 12672);
            __syncthreads();
            tconv_store(j0, tid, sm); tconv_store(j1, tid, sm + 4224); tconv_store(j2, tid, sm + 8448); tconv_store(j3, tid, sm + 12672);
            __syncthreads();
        }
    }
}

DI void phase_xb(const Params& p) {
    const float* X = opq(p.in[0]);
    u16* XB = (u16*)(opq(p.ws) + OFF_R1);
    float* ssq4 = (float*)(opq(p.ws) + OFF_SSQ4);
    const int tid_ = TID(), lane = tid_ & 63, w = tid_ >> 6;
    for (int row = BID() * 8 + w; row < NTOK; row += gridDim.x * 8) {
        const f32x4* xr = (const f32x4*)(X + (size_t)row * DM) + lane;
        f32x4 v[4]; float s = 0.f;
#pragma unroll
        for (int j = 0; j < 4; ++j) v[j] = xr[64 * j];
        u32x2* o8 = (u32x2*)(XB + (size_t)row * DM) + lane;
#pragma unroll
        for (int j = 0; j < 4; ++j) { u32x2 q; q.x = pk2(v[j].x, v[j].y); q.y = pk2(v[j].z, v[j].w); o8[64 * j] = q;
            const float a = bf_lo(q.x), b = bf_hi(q.x), c = bf_lo(q.y), d = bf_hi(q.y); s += a * a + b * b + c * c + d * d; }
#pragma unroll
        for (int o = 1; o < 64; o <<= 1) s += shx(s, o, lane);
        if (lane == 0) *(f32x4*)(ssq4 + (size_t)row * 4) = (f32x4){s, 0.f, 0.f, 0.f};
    }
}

#define PG_LAS __attribute__((address_space(3)))
constexpr int PG_HTB = 128 * 64 * 2;
constexpr int PG_STAGE_BYTES = 8 * PG_HTB;
DI int pg_lds_byte(int r, int c) { const int st = (r >> 4) * 2 + (c >> 5), rr = r & 15, cc = c & 31, ob = rr * 64 + cc * 2; return st * 1024 + (ob ^ (((ob >> 9) & 1) << 5)); }
DI void pg_stage_rc(int b, int& R, int& C) { const int st = b / 1024, sb = b % 1024, swz = sb ^ (((sb >> 9) & 1) << 5); R = (st >> 1) * 16 + swz / 64; C = (st & 1) * 32 + (swz % 64) / 2; }

constexpr int ST16 = 264;
constexpr int ST16H = 136;
constexpr int ST32 = 260;
DI int rg_row(int rg, int rbase) { return (rg >> 2) * 128 + (rg & 3) * 16 + rbase; }

DI void pg_glds16(unsigned lds_dst, const char* base, unsigned voff) {
    unsigned keep;
    asm volatile("s_mov_b32 %0, m0\n\ts_mov_b32 m0, %1\n\ts_nop 0\n\tglobal_load_lds_dwordx4 %2, %3\n\ts_mov_b32 m0, %0" : "=&s"(keep) : "s"(lds_dst), "v"(voff), "s"(base) : "memory");
}

constexpr unsigned ROWC_OFF = 139264;
template <class J, class = void> struct has_rowdma { static constexpr bool v = false; };
template <class J> struct has_rowdma<J, decltype((void)J::ROWDMA)> { static constexpr bool v = J::ROWDMA; };

template <class J>
DI void pg_gemm_seq(const J& jb, char* lds_, const int u_begin, const int G, const int nu) {
    PG_LAS unsigned char* lds = (PG_LAS unsigned char*)lds_;
    const int tid = TID(), wid = __builtin_amdgcn_readfirstlane(tid >> 6), lane = tid & 63, wr = wid >> 2, wc = wid & 3, fr = lane & 15, fq = lane >> 4;
    const int bid = u_begin;
    const int K = jb.kdim(), nt = K / 64;
    if (bid >= nu) return;
    int Rr[2], Cc[2]; unsigned voffB[2];
#pragma unroll
    for (int i = 0; i < 2; ++i) { pg_stage_rc(tid * 16 + i * 8192, Rr[i], Cc[i]); const int rho = Rr[i] & 31, Rb = (Rr[i] & ~31) + 8 * ((rho & 15) >> 2) + 4 * (rho >> 4) + (rho & 3); voffB[i] = (unsigned)(Rb * K + Cc[i]) * 2u; }
    const size_t kstepA = jb.a_kstep();
    const size_t hstepA = jb.a_hstep();
    const size_t kstepB = 128;
    const size_t hstepB = (size_t)128 * K * 2;
    const unsigned ldsw = (unsigned)wid * 1024u;
    const unsigned ldsb = (unsigned)(size_t)lds;
    const int aoff = pg_lds_byte(wr * 64 + fr, fq * 8), boff = pg_lds_byte(wc * 32 + fr, fq * 8);
#define PG_SA(b, h) ((b) * 65536 + (h) * PG_HTB)
#define PG_SB(b, h) ((b) * 65536 + 32768 + (h) * PG_HTB)
#define PG_STAGE(bufoff, gbase, voff) do { _Pragma("unroll") for (int _i = 0; _i < 2; ++_i) \
        pg_glds16(ldsb + (unsigned)(bufoff) + ldsw + _i * 8192u, (const char*)(gbase), (voff)[_i]); } while (0)
#define PG_STAGE_A(bufoff, gbase, h) do { if constexpr (J::GATHER) { if (h) PG_STAGE(bufoff, gbase, vo1); else PG_STAGE(bufoff, gbase, vo0); } else { PG_STAGE(bufoff, (gbase) + (h) * hstepA, vo0); } } while (0)
#define PG_LDA(dst, b, h) do { _Pragma("unroll") for (int m = 0; m < 4; ++m) _Pragma("unroll") for (int k = 0; k < 2; ++k) dst[m][k] = *(const PG_LAS bf16x8*)(lds + PG_SA(b, h) + aoff + m * 2048 + k * 1024); } while (0)
#define PG_LDB(dst, b, h) do { _Pragma("unroll") for (int n = 0; n < 2; ++n) _Pragma("unroll") for (int k = 0; k < 2; ++k) dst[n][k] = *(const PG_LAS bf16x8*)(lds + PG_SB(b, h) + boff + n * 2048 + k * 1024); } while (0)
#define PG_MMA(ai, bj, At, Bt) do { __builtin_amdgcn_s_setprio(1); _Pragma("unroll") for (int m = 0; m < 4; ++m) _Pragma("unroll") for (int n = 0; n < 2; ++n) _Pragma("unroll") for (int k = 0; k < 2; ++k) \
        acc[ai][bj][m][n] = __builtin_amdgcn_mfma_f32_16x16x32_bf16(Bt[n][k], At[m][k], acc[ai][bj][m][n], 0, 0, 0); __builtin_amdgcn_s_setprio(0); } while (0)
#define PG_WAIT_V(n) asm volatile("s_waitcnt vmcnt(" #n ")" ::: "memory")
#define PG_WAIT_L(n) asm volatile("s_waitcnt lgkmcnt(" #n ")" ::: "memory")
#define PG_BAR __builtin_amdgcn_s_barrier()
#define PG_SCHED __builtin_amdgcn_sched_barrier(0)
    typename J::Unit cur = jb.unit(bid);
    unsigned vo0[2], vo1[2];
#pragma unroll
    for (int i = 0; i < 2; ++i) { vo0[i] = jb.a_off(cur, Rr[i], Cc[i]); vo1[i] = J::GATHER ? jb.a_off(cur, Rr[i] + 128, Cc[i]) : 0u; }
    const char* cA = uptr(jb.a_base(cur)); const char* cB = uptr(jb.b_base(cur));
    int rpar = 0;
    if constexpr (has_rowdma<J>::v) { if (wid < 4) pg_glds16(ldsb + ROWC_OFF + (unsigned)wid * 1024u, uptr(jb.row_base(cur)), (unsigned)tid * 16u); }
    PG_STAGE(PG_SB(0, 0), cB, voffB); PG_STAGE_A(PG_SA(0, 0), cA, 0); PG_STAGE(PG_SB(0, 1), cB + hstepB, voffB); PG_STAGE_A(PG_SA(0, 1), cA, 1);
    for (int uidx = bid;;) {
        if (wr == 1) PG_BAR;
        PG_WAIT_V(4); PG_BAR;
        PG_STAGE(PG_SB(1, 0), cB + kstepB, voffB); PG_STAGE_A(PG_SA(1, 0), cA + kstepA, 0); PG_STAGE(PG_SB(1, 1), cB + hstepB + kstepB, voffB);
        PG_WAIT_V(6); PG_BAR;
        f32x4 acc[2][2][4][2];
#pragma unroll
        for (int a = 0; a < 2; ++a)
#pragma unroll
            for (int b = 0; b < 2; ++b)
#pragma unroll
                for (int m = 0; m < 4; ++m)
#pragma unroll
                    for (int n = 0; n < 2; ++n) acc[a][b][m][n] = (f32x4){0.f, 0.f, 0.f, 0.f};
        bf16x8 At[4][2], B0[2][2], B1[2][2];
        for (int t = 0; t < nt; t += 2) {
            const bool more = (t != nt - 2);
            const char* a1 = cA + (size_t)(t + 1) * kstepA;
            const char* a2 = cA + (size_t)(t + 2) * kstepA; const char* b2 = cB + (size_t)(t + 2) * kstepB;
            const char* a3 = a2 + kstepA; const char* b3 = b2 + kstepB;
            PG_LDB(B0, 0, 0); PG_SCHED; PG_LDA(At, 0, 0); PG_STAGE_A(PG_SA(1, 1), a1, 1);
            PG_WAIT_L(8); PG_BAR; PG_WAIT_L(0); PG_MMA(0, 0, At, B0); PG_BAR; PG_SCHED;
            PG_LDB(B1, 0, 1); if (more) PG_STAGE(PG_SB(0, 0), b2, voffB);
            PG_BAR; PG_WAIT_L(0); PG_MMA(0, 1, At, B1); PG_BAR;
            PG_LDA(At, 0, 1); if (more) PG_STAGE_A(PG_SA(0, 0), a2, 0);
            PG_BAR; PG_WAIT_L(0); PG_MMA(1, 0, At, B0); PG_BAR; PG_SCHED;
            if (more) { PG_STAGE(PG_SB(0, 1), b2 + hstepB, voffB); PG_WAIT_V(6); } else { PG_WAIT_V(0); }
            PG_BAR; PG_MMA(1, 1, At, B1); PG_BAR;
            PG_LDB(B0, 1, 0); PG_SCHED; PG_LDA(At, 1, 0); if (more) PG_STAGE_A(PG_SA(0, 1), a2, 1);
            PG_WAIT_L(8); PG_BAR; PG_WAIT_L(0); PG_MMA(0, 0, At, B0); PG_BAR; PG_SCHED;
            PG_LDB(B1, 1, 1); if (more) PG_STAGE(PG_SB(1, 0), b3, voffB);
            PG_BAR; PG_WAIT_L(0); PG_MMA(0, 1, At, B1); PG_BAR;
            PG_LDA(At, 1, 1); if (more) PG_STAGE_A(PG_SA(1, 0), a3, 0);
            PG_BAR; PG_WAIT_L(0); PG_MMA(1, 0, At, B0); PG_BAR; PG_SCHED;
            if (more) { PG_STAGE(PG_SB(1, 1), b3 + hstepB, voffB); PG_WAIT_V(6); }
            PG_BAR; PG_MMA(1, 1, At, B1); PG_BAR;
        }
        if (wr == 0) PG_BAR;
        PG_BAR;
        const int nidx = uidx + G;
        const bool has_next = nidx < nu;
        const typename J::Unit done = cur;
        if (has_next) {
            cur = jb.unit(nidx);
            if constexpr (J::GATHER) {
#pragma unroll
                for (int i = 0; i < 2; ++i) { int R2, C2; pg_stage_rc(TID() * 16 + i * 8192, R2, C2); vo0[i] = jb.a_off(cur, R2, C2); vo1[i] = jb.a_off(cur, R2 + 128, C2); }
            }
            cA = uptr(jb.a_base(cur)); cB = uptr(jb.b_base(cur));
            if constexpr (has_rowdma<J>::v) { if (wid < 4) pg_glds16(ldsb + ROWC_OFF + (unsigned)((rpar ^ 1) * 4096) + (unsigned)wid * 1024u, uptr(jb.row_base(cur)), (unsigned)TID() * 16u); }
            PG_STAGE(PG_SB(0, 0), cB, voffB); PG_STAGE_A(PG_SA(0, 0), cA, 0); PG_STAGE(PG_SB(0, 1), cB + hstepB, voffB); PG_STAGE_A(PG_SA(0, 1), cA, 1);
        }
        {
            const int l2 = TID() & 63;
            const int rbase = wr * 64 + (l2 & 15), cb = wc * 32 + 8 * (l2 >> 4);
            typename J::Ctx ctx;
            if constexpr (has_rowdma<J>::v) jb.epi_begin(done, rbase, ctx, (const PG_LAS unsigned char*)(lds + ROWC_OFF + rpar * 4096)); else jb.epi_begin(done, rbase, ctx);
            if constexpr (J::SMODE == 0 && J::NCOL == 128) {
                PG_LAS u16* T = (PG_LAS u16*)(lds + 65536);
#pragma unroll
                for (int rg = 0; rg < 8; ++rg) {
                    u32x4 o0, o1;
                    jb.epi_val(done, ctx, rg, acc[rg >> 2][0][rg & 3][0], acc[rg >> 2][0][rg & 3][1], acc[rg >> 2][1][rg & 3][0], acc[rg >> 2][1][rg & 3][1], o0, o1);
                    *(PG_LAS u32x4*)(T + rg_row(rg, rbase) * ST16H + cb) = o0;
                }
                __syncthreads();
                jb.epi_copy(done, ctx, (const PG_LAS u16*)T, TID());
                __syncthreads();
            } else if constexpr (J::SMODE == 0) {
                PG_LAS u16* T = (PG_LAS u16*)(lds + 65536);
#pragma unroll
                for (int h = 0; h < 2; ++h) {
#pragma unroll
                    for (int m = 0; m < 4; ++m) {
                        u32x4 o0, o1;
                        jb.epi_val(done, ctx, h * 4 + m, acc[h][0][m][0], acc[h][0][m][1], acc[h][1][m][0], acc[h][1][m][1], o0, o1);
                        PG_LAS u16* d = T + (m * 16 + rbase) * ST16 + cb;
                        *(PG_LAS u32x4*)d = o0; *(PG_LAS u32x4*)(d + 128) = o1;
                    }
                    __syncthreads();
                    jb.epi_copy(done, (const PG_LAS u16*)T, h, TID());
                    __syncthreads();
                }
            } else {
                PG_LAS float* T = (PG_LAS float*)(lds + 65536);
                typename J::Pre pa, pb;
                jb.epi_load(done, ctx, 0, TID(), pa);
#pragma unroll
                for (int ps = 0; ps < 4; ++ps) {
                    if (wr == (ps & 1)) {
#pragma unroll
                        for (int m = 0; m < 4; ++m) {
                            PG_LAS float* d = T + (m * 16 + (l2 & 15)) * ST32 + cb;
                            *(PG_LAS f32x4*)d = acc[ps >> 1][0][m][0]; *(PG_LAS f32x4*)(d + 4) = acc[ps >> 1][0][m][1];
                            *(PG_LAS f32x4*)(d + 128) = acc[ps >> 1][1][m][0]; *(PG_LAS f32x4*)(d + 132) = acc[ps >> 1][1][m][1];
                        }
                    }
                    __syncthreads();
                    if (ps < 3) jb.epi_load(done, ctx, ps + 1, TID(), pb);
                    jb.epi_copy(done, ctx, (const PG_LAS float*)T, ps, TID(), pa);
                    __syncthreads();
                    pa = pb;
                }
            }
        }
        if (!has_next) break;
        uidx = nidx; rpar ^= 1;
    }
#undef PG_SA
#undef PG_SB
#undef PG_STAGE
#undef PG_STAGE_A
#undef PG_LDA
#undef PG_LDB
#undef PG_MMA
#undef PG_WAIT_V
#undef PG_WAIT_L
#undef PG_BAR
#undef PG_SCHED
}

template <class J> DI void pg_gemm(const J& jb, char* lds_) { pg_gemm_seq(jb, lds_, BID(), (int)gridDim.x, jb.num_units()); }

DI void tile_order(int L, int nM, int nN, int& pm, int& pn) {
    const int nwg = nM * nN, q = nwg / 8, r = nwg % 8, xcd = L % 8, off = L / 8;
    const int wgid = (xcd < r ? xcd * (q + 1) : r * (q + 1) + (xcd - r) * q) + off;
    const int nig = 8 * nN, gid = wgid / nig, fm = gid * 8, gsz = (nM - fm) < 8 ? (nM - fm) : 8;
    pm = fm + ((wgid % nig) % gsz); pn = (wgid % nig) / gsz;
}

struct UnitMN { int m0, n0; };
struct NoCtx {};
DI u32x4 pack8(f32x4 a, f32x4 b) { u32x4 o; o.x = pk2(a.x, a.y); o.y = pk2(a.z, a.w); o.z = pk2(b.x, b.y); o.w = pk2(b.z, b.w); return o; }
DI f32x4 sig4(f32x4 v) { f32x4 o; o.x = sigmoidf_(v.x); o.y = sigmoidf_(v.y); o.z = sigmoidf_(v.z); o.w = sigmoidf_(v.w); return o; }
DI unsigned q4u8(f32x4 v) {
    const unsigned a = (unsigned)fmaf(v.x, 255.0f, 0.5f), b = (unsigned)fmaf(v.y, 255.0f, 0.5f), c = (unsigned)fmaf(v.z, 255.0f, 0.5f), d = (unsigned)fmaf(v.w, 255.0f, 0.5f);
    return a | (b << 8) | (c << 16) | (d << 24);
}
DI f32x4 unq4u8(unsigned w) { f32x4 o; o.x = (float)(w & 0xffu); o.y = (float)((w >> 8) & 0xffu); o.z = (float)((w >> 16) & 0xffu); o.w = (float)(w >> 24); return o * (1.0f / 255.0f); }
constexpr size_t OFF_SGS8 = OFF_R3, OFF_SGA8 = OFF_R3 + ((size_t)32 << 20);
DI f32x4 unp_lo(u32x4 u) { f32x4 o; o.x = bf_lo(u.x); o.y = bf_hi(u.x); o.z = bf_lo(u.y); o.w = bf_hi(u.y); return o; }
DI f32x4 unp_hi(u32x4 u) { f32x4 o; o.x = bf_lo(u.z); o.y = bf_hi(u.z); o.z = bf_lo(u.w); o.w = bf_hi(u.w); return o; }

template <int MODE> struct JobInProjT {
    typedef UnitMN Unit; static constexpr bool GATHER = false; static constexpr int SMODE = 0, NCOL = 256, EREP = REP_EPI;
    struct Ctx { float rs[8]; };
    const char* A; const char* B; const float* ssq4; u16* A2; char* ws;
    DI int num_units() const { return MODE == 0 ? (NTOK / 256) * 12 : 256; }
    DI Unit unit(int u) const { int pm, pn; if (MODE == 0) tile_order(u, NTOK / 256, 12, pm, pn); else { pm = u - 128; pn = 12; } Unit x; x.m0 = pm * 256; x.n0 = pn * 256; return x; }
    DI const char* a_base(const Unit& un) const { return A + (size_t)un.m0 * 2048; }
    DI const char* b_base(const Unit& un) const { return B + (size_t)un.n0 * 2048; }
    DI unsigned a_off(const Unit&, int R, int C) const { return (unsigned)(R * 1024 + C) * 2u; }
    DI size_t a_hstep() const { return 128 * 2048; }
    DI size_t a_kstep() const { return 128; }
    DI int kdim() const { return 1024; }
    static constexpr bool ROWDMA = true;
    DI const char* row_base(const Unit& un) const { return (const char*)ssq4 + (size_t)un.m0 * 16; }
    DI void epi_begin(const Unit&, int rbase, Ctx& c, const PG_LAS unsigned char* rc) const {
#pragma unroll
        for (int rg = 0; rg < 8; ++rg) { const f32x4 q = *(const PG_LAS f32x4*)(rc + rg_row(rg, rbase) * 16); c.rs[rg] = rsqrtf((q.x + q.y + q.z + q.w) * (1.0f / DM) + 1e-6f); }
    }
    DI void epi_val(const Unit& un, const Ctx& c, int rg, f32x4 v00, f32x4 v01, f32x4 v10, f32x4 v11, u32x4& o0, u32x4& o1) const {
        const float s = c.rs[rg];
        if (un.n0 >= 1280) { o0 = (u32x4){q4u8(sig4(v00 * s)), q4u8(sig4(v01 * s)), 0u, 0u}; o1 = (u32x4){q4u8(sig4(v10 * s)), q4u8(sig4(v11 * s)), 0u, 0u}; }
        else { o0 = pack8(v00 * s, v01 * s); o1 = pack8(v10 * s, v11 * s); }
    }
    DI void epi_copy(const Unit& un, const PG_LAS u16* T, int h, int tid) const {
        if (un.n0 < 512) {
#pragma unroll
            for (int it = 0; it < 4; ++it) {
                const int id = it * NTHR + tid, gl = id >> 7, r = id & 127, row = un.m0 + h * 128 + r;
                const PG_LAS u16* s = T + r * ST16 + gl * 16;
                const u32x4 a = *(const PG_LAS u32x4*)s, b = *(const PG_LAS u32x4*)(s + 8);
                const int g = (un.n0 >> 4) + gl, bb = row >> 11, t = row & 2047, ch = t >> 5, i = t & 31;
                u16* d = A2 + ((size_t)(g * S5M + bb * NCH + ch) * S5K2 + i * 16);
                *(u32x4*)d = a; *(u32x4*)(d + 8) = b;
            }
            return;
        }
        if (un.n0 >= 1280) {
            unsigned char* d8 = (unsigned char*)ws + (un.n0 < 2304 ? OFF_SGS8 + (size_t)(un.n0 - 1280) : OFF_SGA8 + (size_t)(un.n0 - 2304));
#pragma unroll
            for (int it = 0; it < 8; ++it) {
                const int id = it * NTHR + tid, r = id >> 5, c = (id & 31) * 8;
                *(u32x2*)(d8 + (size_t)(un.m0 + h * 128 + r) * 1024 + c) = *(const PG_LAS u32x2*)(T + r * ST16 + c);
            }
            return;
        }
        size_t doff; int ld, c0;
        if (un.n0 < 1024) { doff = OFF_Q; ld = 512; c0 = un.n0 - 512; }
        else { doff = OFF_KV; ld = 256; c0 = 0; }
        u16* dst = (u16*)(ws + doff);
#pragma unroll
        for (int it = 0; it < 8; ++it) {
            const int id = it * NTHR + tid, r = id >> 5, c = (id & 31) * 8;
            *(u32x4*)(dst + (size_t)(un.m0 + h * 128 + r) * ld + c0 + c) = *(const PG_LAS u32x4*)(T + r * ST16 + c);
        }
    }
};

struct UnitG { int g, m0, n0; };
struct JobS5G1 {
    typedef UnitG Unit; static constexpr bool GATHER = false; static constexpr int SMODE = 1, NCOL = 256, EREP = 1;
    typedef NoCtx Ctx;
    const char* A2; const char* W1; float* Sloc;
    DI int num_units() const { return 32 * (S5M / 256); }
    DI Unit unit(int u) const { const int xcd = u & 7, slot = u >> 3; Unit x; x.g = xcd * 4 + (slot >> 2); x.m0 = (slot & 3) * 256; x.n0 = 0; return x; }
    DI const char* a_base(const Unit& un) const { return A2 + (size_t)(un.g * S5M + un.m0) * S5K2 * 2; }
    DI const char* b_base(const Unit& un) const { return W1 + (size_t)un.g * 256 * 512 * 2; }
    DI unsigned a_off(const Unit&, int R, int C) const { return (unsigned)(R * S5K2 + C) * 2u; }
    DI size_t a_hstep() const { return 128 * S5K2 * 2; }
    DI size_t a_kstep() const { return 128; }
    DI int kdim() const { return S5K1; }
    DI void epi_begin(const Unit&, int, Ctx&) const {}
    struct Pre {}; DI void epi_load(const Unit&, const Ctx&, int, int, Pre&) const {}
    DI void epi_copy(const Unit& un, const Ctx&, const PG_LAS float* T, int ps, int tid, const Pre&) const {
        const int r0 = (ps >> 1) * 128 + (ps & 1) * 64;
#pragma unroll
        for (int it = 0; it < 4; ++it) {
            const int id = it * NTHR + tid, r = id >> 5, c = (id & 31) * 4;
            *(f32x4*)(Sloc + (size_t)(un.g * S5M + un.m0 + r0 + r) * 128 + c) = *(const PG_LAS f32x4*)(T + r * ST32 + c);
        }
    }
};

struct JobS5G2 {
    typedef UnitG Unit; static constexpr bool GATHER = false; static constexpr int SMODE = 0, NCOL = 256, EREP = 1;
    typedef NoCtx Ctx;
    const char* A2; const char* W2; u16* Zp;
    DI int num_units() const { return 32 * (S5M / 256) * 2; }
    DI Unit unit(int u) const { const int xcd = u & 7, slot = u >> 3; Unit x; x.g = xcd * 4 + (slot >> 3); const int r = slot & 7; x.m0 = (r >> 1) * 256; x.n0 = (r & 1) * 256; return x; }
    DI const char* a_base(const Unit& un) const { return A2 + (size_t)(un.g * S5M + un.m0) * S5K2 * 2; }
    DI const char* b_base(const Unit& un) const { return W2 + (size_t)(un.g * 512 + un.n0) * S5K2 * 2; }
    DI unsigned a_off(const Unit&, int R, int C) const { return (unsigned)(R * S5K2 + C) * 2u; }
    DI size_t a_hstep() const { return 128 * S5K2 * 2; }
    DI size_t a_kstep() const { return 128; }
    DI int kdim() const { return S5K2; }
    DI void epi_begin(const Unit&, int, Ctx&) const {}
    DI f32x4 gelu4(f32x4 v) const { f32x4 o; o.x = gelu_tanh(v.x); o.y = gelu_tanh(v.y); o.z = gelu_tanh(v.z); o.w = gelu_tanh(v.w); return o; }
    DI void epi_val(const Unit&, const Ctx&, int, f32x4 v00, f32x4 v01, f32x4 v10, f32x4 v11, u32x4& o0, u32x4& o1) const { o0 = pack8(gelu4(v00), gelu4(v01)); o1 = pack8(gelu4(v10), gelu4(v11)); }
    DI void epi_copy(const Unit& un, const PG_LAS u16* T, int h, int tid) const {
#pragma unroll
        for (int it = 0; it < 8; ++it) {
            const int id = it * NTHR + tid, r = id >> 5, c = (id & 31) * 8, rr = un.m0 + h * 128 + r, bb = rr >> 6, ch = rr & 63;
            *(u32x4*)(Zp + ((size_t)un.g * NTOK + bb * SEQ + ch * TCH) * 16 + un.n0 + c) = *(const PG_LAS u32x4*)(T + r * ST16 + c);
        }
    }
};

struct JobGLU {
    typedef UnitMN Unit; static constexpr bool GATHER = false; static constexpr int SMODE = 0, NCOL = 128, EREP = 1;
    struct Ctx { u32x2 sg[8]; u32x4 pa[8]; };
    const char* Zp; const char* B; const unsigned char* SGS; const u16* PA; u16* MS;
    DI int num_units() const { return (NTOK / 256) * 8; }
    DI Unit unit(int u) const { int pm, pn; tile_order(u, NTOK / 256, 8, pm, pn); Unit x; x.m0 = pm * 256; x.n0 = pn * 256; return x; }
    DI const char* a_base(const Unit& un) const { return Zp + (size_t)un.m0 * 32; }
    DI const char* b_base(const Unit& un) const { return B + (size_t)un.n0 * 1024; }
    DI unsigned a_off(const Unit&, int R, int C) const { return (unsigned)(((C >> 4) * NTOK + R) * 32 + (C & 15) * 2); }
    DI size_t a_hstep() const { return 128 * 32; }
    DI size_t a_kstep() const { return (size_t)4 * NTOK * 32; }
    DI int kdim() const { return 512; }
    DI void epi_begin(const Unit& un, int, Ctx& cx) const {
        const int tid = TID();
#pragma unroll
        for (int it = 0; it < 8; ++it) { const int id = it * NTHR + tid, r = id >> 4, c = (id & 15) * 8; const size_t off = (size_t)(un.m0 + r) * 1024 + (un.n0 >> 1) + c; cx.sg[it] = *(const u32x2*)(SGS + off); cx.pa[it] = *(const u32x4*)(PA + off); }
    }
    DI void epi_val(const Unit&, const Ctx&, int, f32x4 v00, f32x4 v01, f32x4 v10, f32x4 v11, u32x4& o0, u32x4& o1) const { o0 = pack8(v00 * sig4(v10), v01 * sig4(v11)); o1 = o0; }
    DI void epi_copy(const Unit& un, const Ctx& cx, const PG_LAS u16* T, int tid) const {
#pragma unroll
        for (int it = 0; it < 8; ++it) {
            const int id = it * NTHR + tid, r = id >> 4, c = (id & 15) * 8;
            const u32x4 v = *(const PG_LAS u32x4*)(T + r * ST16H + c);
            *(u32x4*)(MS + (size_t)(un.m0 + r) * 1024 + (un.n0 >> 1) + c) = pack8(unp_lo(v) * unq4u8(cx.sg[it].x) + unp_lo(cx.pa[it]), unp_hi(v) * unq4u8(cx.sg[it].y) + unp_hi(cx.pa[it]));
        }
    }
};

struct JobAttnUp {
    typedef UnitMN Unit; static constexpr bool GATHER = false; static constexpr int SMODE = 1, NCOL = 256, EREP = 1;
    typedef NoCtx Ctx;
    const char* A; const char* B; const unsigned char* SGA; u16* PA;
    DI int num_units() const { return (NTOK / 256) * 4; }
    DI Unit unit(int u) const { int pm, pn; tile_order(u, NTOK / 256, 4, pm, pn); Unit x; x.m0 = pm * 256; x.n0 = pn * 256; return x; }
    DI const char* a_base(const Unit& un) const { return A + (size_t)un.m0 * 1024; }
    DI const char* b_base(const Unit& un) const { return B + (size_t)un.n0 * 1024; }
    DI unsigned a_off(const Unit&, int R, int C) const { return (unsigned)(R * 512 + C) * 2u; }
    DI size_t a_hstep() const { return 128 * 1024; }
    DI size_t a_kstep() const { return 128; }
    DI int kdim() const { return 512; }
    DI void epi_begin(const Unit&, int, Ctx&) const {}
    struct Pre { u32x2 ga[4]; };
    DI void epi_load(const Unit& un, const Ctx&, int ps, int tid, Pre& p) const {
        const int r0 = (ps >> 1) * 128 + (ps & 1) * 64;
#pragma unroll
        for (int it = 0; it < 4; ++it) { const int id = it * NTHR + tid, r = id >> 5, c = (id & 31) * 8; const size_t off = (size_t)(un.m0 + r0 + r) * 1024 + un.n0 + c; p.ga[it] = *(const u32x2*)(SGA + off); }
    }
    DI void epi_copy(const Unit& un, const Ctx&, const PG_LAS float* T, int ps, int tid, const Pre& p) const {
        const int r0 = (ps >> 1) * 128 + (ps & 1) * 64;
#pragma unroll
        for (int it = 0; it < 4; ++it) {
            const int id = it * NTHR + tid, r = id >> 5, c = (id & 31) * 8;
            const f32x4 a = unq4u8(p.ga[it].x) * *(const PG_LAS f32x4*)(T + r * ST32 + c), b = unq4u8(p.ga[it].y) * *(const PG_LAS f32x4*)(T + r * ST32 + c + 4);
            *(u32x4*)(PA + (size_t)(un.m0 + r0 + r) * 1024 + un.n0 + c) = pack8(a, b);
        }
    }
};

struct JobOut {
    typedef UnitMN Unit; static constexpr bool GATHER = false; static constexpr int SMODE = 1, NCOL = 256, EREP = 1;
    typedef NoCtx Ctx;
    const char* A; const char* B; u16* XB;
    DI int num_units() const { return (NTOK / 256) * 4; }
    DI Unit unit(int u) const { int pm, pn; tile_order(u, NTOK / 256, 4, pm, pn); Unit x; x.m0 = pm * 256; x.n0 = pn * 256; return x; }
    DI const char* a_base(const Unit& un) const { return A + (size_t)un.m0 * 2048; }
    DI const char* b_base(const Unit& un) const { return B + (size_t)un.n0 * 2048; }
    DI unsigned a_off(const Unit&, int R, int C) const { return (unsigned)(R * 1024 + C) * 2u; }
    DI size_t a_hstep() const { return 128 * 2048; }
    DI size_t a_kstep() const { return 128; }
    DI int kdim() const { return 1024; }
    DI void epi_begin(const Unit&, int, Ctx&) const {}
    struct Pre { u32x4 xv[4]; };
    DI void epi_load(const Unit& un, const Ctx&, int ps, int tid, Pre& p) const {
        const int r0 = (ps >> 1) * 128 + (ps & 1) * 64;
#pragma unroll
        for (int it = 0; it < 4; ++it) { const int id = it * NTHR + tid, r = id >> 5, c = (id & 31) * 8; p.xv[it] = *(const u32x4*)(XB + (size_t)(un.m0 + r0 + r) * 1024 + un.n0 + c); }
    }
    DI void epi_copy(const Unit& un, const Ctx&, const PG_LAS float* T, int ps, int tid, const Pre& p) const {
        const int r0 = (ps >> 1) * 128 + (ps & 1) * 64;
#pragma unroll
        for (int it = 0; it < 4; ++it) {
            const int id = it * NTHR + tid, r = id >> 5, c = (id & 31) * 8;
            const f32x4 a = unp_lo(p.xv[it]) + *(const PG_LAS f32x4*)(T + r * ST32 + c), b = unp_hi(p.xv[it]) + *(const PG_LAS f32x4*)(T + r * ST32 + c + 4);
            *(u32x4*)(XB + (size_t)(un.m0 + r0 + r) * 1024 + un.n0 + c) = pack8(a, b);
        }
    }
};

struct UnitMoe { int m0, n0, e0, e1, pr, pb, nv; };
constexpr unsigned MOE_TB_OFF = 151552;
DI int moe_tok(const int* perm2, const UnitMoe& un, int R) { return R < un.nv ? perm2[un.pb + R] : -1; }
DI void moe_unit(const PG_LAS int* tb, int u, UnitMoe& x) {
    const int rt = u >> 2; x.m0 = rt * TM; x.n0 = (u & 3) * 256;
    int bk = 0;
#pragma unroll 1
    for (int q = 1; q < 24; ++q) if (x.m0 >= __builtin_amdgcn_readfirstlane(tb[q])) bk = q;
    x.pr = bk;
    const int l0 = x.m0 - __builtin_amdgcn_readfirstlane(tb[bk]);
    int nv = __builtin_amdgcn_readfirstlane(tb[32 + bk]) - l0; nv = nv < 0 ? 0 : (nv > TM ? TM : nv);
    x.nv = nv; x.pb = bk * 32768 + l0;
}
DI void bucket_decode(int bk, int& e0, int& e1) { const int grp = bk / 6; int a, b; pair_experts(bk % 6, a, b); e0 = grp * 4 + a; e1 = grp * 4 + b; }
struct JobMoeUp {
    typedef UnitMoe Unit; static constexpr bool GATHER = true; static constexpr int SMODE = 0, NCOL = 128, EREP = 1;
    struct Ctx { float rs[8]; float wg[8]; };
    const char* XB2; const char* WUP; const int* perm; const PG_LAS int* tb; const float* rstd2; const float* rw; u16* ACT;
    DI int num_units() const { return (__builtin_amdgcn_readfirstlane(tb[24]) / TM) * 4; }
    DI Unit unit(int u) const { Unit x; moe_unit(tb, u, x); bucket_decode(x.pr, x.e0, x.e1); return x; }
    DI const char* a_base(const Unit&) const { return XB2; }
    DI const char* b_base(const Unit& un) const { const int e = un.n0 < 512 ? un.e0 : un.e1; return WUP + (size_t)(e * 512 + (un.n0 & 511)) * 2048; }
    DI unsigned a_off(const Unit& un, int R, int C) const { int tok = moe_tok(perm, un, R); tok = tok < 0 ? 0 : tok; return (unsigned)(tok * 1024 + C) * 2u; }
    DI size_t a_hstep() const { return 0; }
    DI size_t a_kstep() const { return 128; }
    DI int kdim() const { return 1024; }
    DI void epi_begin(const Unit& un, int rbase, Ctx& c) const {
        const int slot = un.n0 >> 9; int tk[8];
#pragma unroll
        for (int rg = 0; rg < 8; ++rg) tk[rg] = moe_tok(perm, un, rg_row(rg, rbase));
#pragma unroll
        for (int rg = 0; rg < 8; ++rg) { const int t = tk[rg] < 0 ? 0 : tk[rg]; c.rs[rg] = rstd2[t]; c.wg[rg] = rw[t * 2 + slot]; }
    }
    DI f32x4 swiglu4(f32x4 g, f32x4 u, float s, float w) const { g = g * s; u = u * s; return g * sig4(g) * u * w; }
    DI void epi_val(const Unit&, const Ctx& c, int rg, f32x4 v00, f32x4 v01, f32x4 v10, f32x4 v11, u32x4& o0, u32x4& o1) const {
        o0 = pack8(swiglu4(v00, v10, c.rs[rg], c.wg[rg]), swiglu4(v01, v11, c.rs[rg], c.wg[rg])); o1 = o0;
    }
    DI void epi_copy(const Unit& un, const Ctx&, const PG_LAS u16* T, int tid) const {
        const int slot = un.n0 >> 9, uu = (un.n0 >> 8) & 1;
#pragma unroll
        for (int it = 0; it < 8; ++it) {
            const int id = it * NTHR + tid, r = id >> 4, c = (id & 15) * 8;
            st16_sc1(ACT + (size_t)(un.m0 + r) * 512 + slot * 256 + uu * 128 + c, *(const PG_LAS u32x4*)(T + r * ST16H + c));
        }
    }
};

struct JobMoeDown {
    typedef UnitMoe Unit; static constexpr bool GATHER = false; static constexpr int SMODE = 1, NCOL = 256, EREP = 1;
    struct Ctx { int tk[16]; };
    const char* ACT; const char* WDN; const int* perm; const PG_LAS int* tb; u16* XB; float* OUT; float* ssq4; int last;
    DI int num_units() const { return (__builtin_amdgcn_readfirstlane(tb[24]) / TM) * 4; }
    DI Unit unit(int u) const { Unit x; moe_unit(tb, u, x); x.e0 = 0; x.e1 = 0; return x; }
    DI const char* a_base(const Unit& un) const { return ACT + (size_t)un.m0 * 1024; }
    DI const char* b_base(const Unit& un) const { return WDN + (size_t)(un.pr * 1024 + un.n0) * 1024; }
    DI unsigned a_off(const Unit&, int R, int C) const { return (unsigned)(R * 512 + C) * 2u; }
    DI size_t a_hstep() const { return 128 * 1024; }
    DI size_t a_kstep() const { return 128; }
    DI int kdim() const { return 512; }
    DI void epi_begin(const Unit& un, int, Ctx& c) const {
        const int tid = TID();
#pragma unroll
        for (int q = 0; q < 16; ++q) { const int ps = q >> 2, it = q & 3, r0 = (ps >> 1) * 128 + (ps & 1) * 64, id = it * NTHR + tid, r = id >> 5; c.tk[q] = moe_tok(perm, un, r0 + r); }
    }
    struct Pre { u32x4 xv[4]; };
    DI void epi_load(const Unit& un, const Ctx& cx, int ps, int tid, Pre& p) const {
#pragma unroll
        for (int it = 0; it < 4; ++it) { const int id = it * NTHR + tid, c = (id & 31) * 8, t = cx.tk[ps * 4 + it] < 0 ? 0 : cx.tk[ps * 4 + it]; p.xv[it] = *(const u32x4*)(XB + (size_t)t * 1024 + un.n0 + c); }
    }
    DI void epi_copy(const Unit& un, const Ctx& cx, const PG_LAS float* T, int ps, int tid, const Pre& p) const {
        const int lane = tid & 63;
#pragma unroll
        for (int it = 0; it < 4; ++it) {
            const int id = it * NTHR + tid, r = id >> 5, c = (id & 31) * 8, tk = cx.tk[ps * 4 + it];
            const f32x4 a = unp_lo(p.xv[it]) + *(const PG_LAS f32x4*)(T + r * ST32 + c), b = unp_hi(p.xv[it]) + *(const PG_LAS f32x4*)(T + r * ST32 + c + 4);
            if (last) {
                if (tk >= 0) { float* o = OUT + (size_t)tk * 1024 + un.n0 + c; *(f32x4*)o = a; *(f32x4*)(o + 4) = b; }
            } else {
                const u32x4 q = pack8(a, b);
                if (tk >= 0) *(u32x4*)(XB + (size_t)tk * 1024 + un.n0 + c) = q;
                const f32x4 ra = unp_lo(q), rb = unp_hi(q);
                float ss = ra.x * ra.x + ra.y * ra.y + ra.z * ra.z + ra.w * ra.w + rb.x * rb.x + rb.y * rb.y + rb.z * rb.z + rb.w * rb.w;
                ss += shx(ss, 1, lane); ss += shx(ss, 2, lane); ss += shx(ss, 4, lane); ss += shx(ss, 8, lane); ss += shx(ss, 16, lane);
                if ((lane & 31) == 0 && tk >= 0) ssq4[(size_t)tk * 4 + (un.n0 >> 8)] = ss;
            }
        }
    }
};

DI void phase_scan(const Params& p) {
    const float* Sloc = (const float*)(opq(p.ws) + OFF_SLOC);
    const float* LT = (const float*)(opq(p.ws) + OFF_LT);
    u16* A2 = (u16*)(opq(p.ws) + OFF_A2);
    for (int idx = BID() * NTHR + TID(); idx < 32 * NBATCH * 64; idx += gridDim.x * NTHR) {
        const int pp = idx & 63, b = (idx >> 6) & 15, g = idx >> 10;
        const float ar = LT[(g * 64 + pp) * 2], ai = LT[(g * 64 + pp) * 2 + 1];
        float sr = 0.f, si = 0.f;
        const size_t r0 = (size_t)g * S5M + b * NCH;
#pragma unroll 8
        for (int c = 0; c < NCH; ++c) {
            *(unsigned*)(A2 + (r0 + c) * S5K2 + S5K1 + 2 * pp) = pk2(sr, si);
            const f32x2 l = *(const f32x2*)(Sloc + (r0 + c) * 128 + 2 * pp);
            const float nr = ar * sr - ai * si + l.x, ni = ar * si + ai * sr + l.y;
            sr = nr; si = ni;
        }
    }
}

DI void scan_local(const Params& p, int g, int b0) {
    asm volatile("s_waitcnt vmcnt(0)" ::: "memory");
    __syncthreads();
    const float* Sloc = (const float*)(opq(p.ws) + OFF_SLOC);
    const float* LT = (const float*)(opq(p.ws) + OFF_LT);
    u16* A2 = (u16*)(opq(p.ws) + OFF_A2);
    const int tid = TID();
    if (tid < 256) {
        const int pp = tid & 63, b = b0 + (tid >> 6);
        const float ar = LT[(g * 64 + pp) * 2], ai = LT[(g * 64 + pp) * 2 + 1];
        float sr = 0.f, si = 0.f;
        const size_t r0 = (size_t)g * S5M + b * NCH;
#pragma unroll 8
        for (int c = 0; c < NCH; ++c) {
            *(unsigned*)(A2 + (r0 + c) * S5K2 + S5K1 + 2 * pp) = pk2(sr, si);
            const f32x2 l = __builtin_nontemporal_load((const f32x2*)(Sloc + (r0 + c) * 128 + 2 * pp));
            const float nr = ar * sr - ai * si + l.x, ni = ar * si + ai * sr + l.y;
            sr = nr; si = ni;
        }
    }
}

constexpr int PREP0_FIRST = 257 + T_WIN / 4, PREP0_PER_UNIT = 3;
DI void phase_attn(const Params& p, const int L, char* lds) {
    u16* Ks = (u16*)lds;
    u16* Vt = Ks + 256 * 72;
    int* qslot = (int*)(lds + 70400);
    const u16* Qg = (const u16*)(opq(p.ws) + OFF_Q);
    const u16* KVg = (const u16*)(opq(p.ws) + OFF_KV);
    u16* YA = (u16*)(opq(p.ws) + OFF_YA);
    unsigned* qctr = (unsigned*)(opq(p.ws) + OFF_BAR) + 8 + L;
    const float* qn = opq(p.in[13]) + L * 64; const float* kn = opq(p.in[14]) + L * 64; const float* sinks = opq(p.in[15]) + L * 8;
    const int tid = TID(), lane = tid & 63, w = tid >> 6, r = lane & 31, hh = lane >> 5;
    constexpr float L2E = 1.4426950408889634f;
    for (;;) {
        if (tid == 0) *qslot = (int)__hip_atomic_fetch_add(qctr, 1u, __ATOMIC_RELAXED, __HIP_MEMORY_SCOPE_AGENT);
        __syncthreads();
        const int u = *qslot;
        if (u >= NBATCH * 16 * 2) break;
        const int kvh = u & 1, nb = (u >> 1) & 15, b = u >> 5;
        const int tok0 = b * SEQ + nb * 128;
        const int gq = w >> 1, h = kvh * 4 + gq, qhalf = w & 1;
        u32x4 qn_[4];
#pragma unroll
        for (int s = 0; s < 4; ++s) qn_[s] = *(const u32x4*)(Qg + (size_t)(tok0 + qhalf * 64 + r) * 512 + h * 64 + 16 * s + 8 * hh);
#pragma unroll
        for (int i = 0; i < 4; ++i) {
            const int pc = tid + 512 * i, key = pc >> 3, dc = pc & 7;
            const bool valid = (nb > 0) || (key >= 128);
            u32x4 kr = {0u, 0u, 0u, 0u}, vr = {0u, 0u, 0u, 0u};
            if (valid) { const u16* src = KVg + (size_t)(tok0 - 128 + key) * 256 + kvh * 64 + dc * 8; kr = *(const u32x4*)src; vr = *(const u32x4*)(src + 128); }
            float kf[8];
            kf[0] = bf_lo(kr.x); kf[1] = bf_hi(kr.x); kf[2] = bf_lo(kr.y); kf[3] = bf_hi(kr.y); kf[4] = bf_lo(kr.z); kf[5] = bf_hi(kr.z); kf[6] = bf_lo(kr.w); kf[7] = bf_hi(kr.w);
            float ss = 0.f;
#pragma unroll
            for (int e = 0; e < 8; ++e) ss += kf[e] * kf[e];
            ss += shx(ss, 1, lane); ss += shx(ss, 2, lane); ss += shx(ss, 4, lane);
            const float rs = rsqrtf(ss * (1.0f / 64.0f) + 1e-6f);
            const f32x4 g0 = *(const f32x4*)(kn + dc * 8), g1 = *(const f32x4*)(kn + dc * 8 + 4);
            u32x4 ko;
            ko.x = pk2(kf[0] * rs * g0.x, kf[1] * rs * g0.y); ko.y = pk2(kf[2] * rs * g0.z, kf[3] * rs * g0.w);
            ko.z = pk2(kf[4] * rs * g1.x, kf[5] * rs * g1.y); ko.w = pk2(kf[6] * rs * g1.z, kf[7] * rs * g1.w);
            *(u32x4*)(Ks + key * 72 + dc * 8) = ko;
            u16* vd = Vt + (dc * 8) * 260 + key;
            vd[0 * 260] = (u16)(vr.x & 0xffff); vd[1 * 260] = (u16)(vr.x >> 16); vd[2 * 260] = (u16)(vr.y & 0xffff); vd[3 * 260] = (u16)(vr.y >> 16);
            vd[4 * 260] = (u16)(vr.z & 0xffff); vd[5 * 260] = (u16)(vr.z >> 16); vd[6 * 260] = (u16)(vr.w & 0xffff); vd[7 * 260] = (u16)(vr.w >> 16);
        }
        __syncthreads();
        const float slope2 = exp2f(-(float)(h + 1)) * L2E, sink2 = sinks[h] * L2E;
#pragma unroll 1
        for (int qt = 0; qt < 2; ++qt) {
            const int i0 = qhalf * 64 + qt * 32;
            const int qtok = tok0 + i0 + r;
            bf16x8 qf[4];
            {
                u32x4 qr[4]; float ss = 0.f;
#pragma unroll
                for (int s = 0; s < 4; ++s) qr[s] = qn_[s];
                if (qt == 0) {
#pragma unroll
                    for (int s = 0; s < 4; ++s) qn_[s] = *(const u32x4*)(Qg + (size_t)(qtok + 32) * 512 + h * 64 + 16 * s + 8 * hh);
                }
#pragma unroll
                for (int s = 0; s < 4; ++s) {
                    const float a0 = bf_lo(qr[s].x), a1 = bf_hi(qr[s].x), a2 = bf_lo(qr[s].y), a3 = bf_hi(qr[s].y), a4 = bf_lo(qr[s].z), a5 = bf_hi(qr[s].z), a6 = bf_lo(qr[s].w), a7 = bf_hi(qr[s].w);
                    ss += a0 * a0 + a1 * a1 + a2 * a2 + a3 * a3 + a4 * a4 + a5 * a5 + a6 * a6 + a7 * a7;
                }
                ss += shx(ss, 32, lane);
                const float rs = rsqrtf(ss * (1.0f / 64.0f) + 1e-6f) * (0.125f * L2E);
#pragma unroll
                for (int s = 0; s < 4; ++s) {
                    const f32x4 g0 = *(const f32x4*)(qn + 16 * s + 8 * hh), g1 = *(const f32x4*)(qn + 16 * s + 8 * hh + 4);
                    u32x4 o;
                    o.x = pk2(bf_lo(qr[s].x) * rs * g0.x, bf_hi(qr[s].x) * rs * g0.y); o.y = pk2(bf_lo(qr[s].y) * rs * g0.z, bf_hi(qr[s].y) * rs * g0.w);
                    o.z = pk2(bf_lo(qr[s].z) * rs * g1.x, bf_hi(qr[s].z) * rs * g1.y); o.w = pk2(bf_lo(qr[s].w) * rs * g1.z, bf_hi(qr[s].w) * rs * g1.w);
                    qf[s] = __builtin_bit_cast(bf16x8, o);
                }
            }
            const int kt0 = i0 >> 5;
            const int qi = i0 + r;
            const int dbase = qi + 128 - kt0 * 32 - 4 * hh;
            const int maxd = nb > 0 ? 127 : (qi < 127 ? qi : 127);
            const float A = -slope2 * (float)dbase;
            f32x16 o[2];
#pragma unroll
            for (int db = 0; db < 2; ++db)
#pragma unroll
                for (int e = 0; e < 16; ++e) o[db][e] = 0.f;
            float m = sink2, l = 0.f;
#pragma unroll
            for (int kr2 = 0; kr2 < 5; ++kr2) {
                const int kt = 4 - kr2;
                if (nb == 0 && kt0 + kt < 4) continue;
                f32x16 sc;
#pragma unroll
                for (int e = 0; e < 16; ++e) sc[e] = 0.f;
#pragma unroll
                for (int s = 0; s < 4; ++s) {
                    const bf16x8 kfr = *(const bf16x8*)(Ks + ((kt0 + kt) * 32 + r) * 72 + 16 * s + 8 * hh);
                    sc = mfma32(kfr, qf[s], sc);
                }
                float tm = -1e30f;
#pragma unroll
                for (int e = 0; e < 16; ++e) {
                    const int ce = 32 * kt + (e & 3) + 8 * (e >> 2);
                    float t = fmaf(slope2, (float)ce, sc[e]);
                    if (kt == 0 || kt == 4) { const int dist = dbase - ce; t = ((unsigned)dist <= (unsigned)maxd) ? t : -1e30f; }
                    sc[e] = t; tm = fmaxf(tm, t);
                }
                tm += A;
                tm = fmaxf(tm, shx(tm, 32, lane));
                if (__ballot(tm > m) != 0ull) {
                    const float mn = fmaxf(m, tm), alpha = __builtin_amdgcn_exp2f(m - mn);
                    m = mn; l *= alpha;
#pragma unroll
                    for (int db = 0; db < 2; ++db)
#pragma unroll
                        for (int e = 0; e < 16; ++e) o[db][e] *= alpha;
                }
                const float c0 = A - m;
                float ls = 0.f;
#pragma unroll
                for (int e = 0; e < 16; ++e) { const float pv = __builtin_amdgcn_exp2f(sc[e] + c0); sc[e] = pv; ls += pv; }
                l += ls;
#pragma unroll
                for (int s2 = 0; s2 < 2; ++s2) {
                    u32x4 pp;
                    pp.x = pk2(sc[8 * s2 + 0], sc[8 * s2 + 1]); pp.y = pk2(sc[8 * s2 + 2], sc[8 * s2 + 3]);
                    pp.z = pk2(sc[8 * s2 + 4], sc[8 * s2 + 5]); pp.w = pk2(sc[8 * s2 + 6], sc[8 * s2 + 7]);
                    const bf16x8 pf = __builtin_bit_cast(bf16x8, pp);
                    const int kb = (kt0 + kt) * 32 + 16 * s2 + 4 * hh;
#pragma unroll
                    for (int db = 0; db < 2; ++db) {
                        const u16* vp = Vt + (db * 32 + r) * 260 + kb;
                        const s16x4 lo = *(const s16x4*)vp, hi = *(const s16x4*)(vp + 8);
                        const bf16x8 vf = __builtin_shufflevector(lo, hi, 0, 1, 2, 3, 4, 5, 6, 7);
                        o[db] = mfma32(vf, pf, o[db]);
                    }
                }
                asm volatile("" ::: "memory");
            }
            l += shx(l, 32, lane);
            l += __builtin_amdgcn_exp2f(sink2 - m);
            const float inv = __builtin_amdgcn_rcpf(l);
#pragma unroll
            for (int db = 0; db < 2; ++db)
#pragma unroll
                for (int q4 = 0; q4 < 4; ++q4) {
                    const int d = db * 32 + 8 * q4 + 4 * hh;
                    u32x2 ov; ov.x = pk2(o[db][4 * q4] * inv, o[db][4 * q4 + 1] * inv); ov.y = pk2(o[db][4 * q4 + 2] * inv, o[db][4 * q4 + 3] * inv);
                    *(u32x2*)(YA + (size_t)qtok * 512 + h * 64 + d) = ov;
                }
        }
        __syncthreads();
        if (L == 0) prep_from_queue(p, lds, PREP0_PER_UNIT, 0, PREP0_FIRST);
    }
    if (L == 0) prep_from_queue(p, lds, 1 << 30, 0, PREP0_FIRST);
}

DI void route_token(const float (&lg)[20], int& bucket, float& w0, float& w1) {
    int gi = 0; float gm = lg[0];
#pragma unroll
    for (int j = 1; j < 4; ++j) if (lg[j] > gm) { gm = lg[j]; gi = j; }
    float den = 0.f;
#pragma unroll
    for (int j = 0; j < 4; ++j) den += __expf(lg[j] - gm);
    const float gp = 1.0f / den;
    float f[4];
#pragma unroll
    for (int j = 0; j < 4; ++j) f[j] = gi == 0 ? lg[4 + j] : (gi == 1 ? lg[8 + j] : (gi == 2 ? lg[12 + j] : lg[16 + j]));
    int i1 = 0; float v1 = f[0];
#pragma unroll
    for (int j = 1; j < 4; ++j) if (f[j] > v1) { v1 = f[j]; i1 = j; }
    int i2 = -1; float v2 = -3.0e38f;
#pragma unroll
    for (int j = 0; j < 4; ++j) if (j != i1 && f[j] > v2) { v2 = f[j]; i2 = j; }
    const float e2 = __expf(v2 - v1);
    const float p1 = gp / (1.0f + e2), p2 = gp * e2 / (1.0f + e2);
    const int a = i1 < i2 ? i1 : i2, b = i1 < i2 ? i2 : i1;
    const int pidx = a == 0 ? b - 1 : (a == 1 ? b + 1 : 5);
    bucket = gi * 6 + pidx;
    w0 = i1 < i2 ? p1 : p2; w1 = i1 < i2 ? p2 : p1;
}

constexpr int RW_ROW = 1024 + 8;
DI void phase_router(const Params& p, const int L, char* lds) {
    u16* Wh = (u16*)lds;
    u16* Wl = Wh + 21 * RW_ROW;
    float* lgs = (float*)(Wl + 21 * RW_ROW);
    int* hist = (int*)(lgs + 8 * 16 * 24);
    const u32x4* WRI = (const u32x4*)(opq(p.ws) + OFF_WR);
    const u16* X = (const u16*)(opq(p.ws) + OFF_R1);
    float* rstd2 = (float*)(opq(p.ws) + OFF_RSTD2);
    int* perm2 = (int*)(opq(p.ws) + OFF_PERM2);
    float* rw = (float*)(opq(p.ws) + OFF_RW);
    unsigned* gcnt = (unsigned*)(opq(p.ws) + OFF_MOEQ) + L * 256 + 16;
    const int tid = TID(), lane = tid & 63, w = tid >> 6, fr = lane & 15, fq = lane >> 4;
    if (BID() >= 256) return;
    for (int i = tid; i < 42 * 128; i += NTHR) { const int row = i >> 7, ch = i & 127; *(u32x4*)(Wh + row * RW_ROW + ch * 8) = WRI[i]; }
    for (int rb = BID(); rb < 256; rb += gridDim.x) {
        if (tid < 24) hist[tid] = 0;
        __syncthreads();
        const int tok = rb * 128 + w * 16 + fr;
        const u16* xr = X + (size_t)tok * DM + 8 * fq;
        const int n1 = fr < 4 ? 16 + fr : 20;
        f32x4 a0 = {0.f, 0.f, 0.f, 0.f}, a1 = {0.f, 0.f, 0.f, 0.f};
        float ssq = 0.f;
        u32x4 xq[2][8];
#pragma unroll
        for (int s = 0; s < 8; ++s) xq[0][s] = *(const u32x4*)(xr + s * 32);
#pragma unroll
        for (int kc = 0; kc < 4; ++kc) {
            u32x4 (&xa)[8] = xq[kc & 1];
            if (kc < 3) {
#pragma unroll
                for (int s = 0; s < 8; ++s) xq[(kc + 1) & 1][s] = *(const u32x4*)(xr + ((kc + 1) * 8 + s) * 32);
            }
#pragma unroll
            for (int s = 0; s < 8; ++s) {
                const int ks = kc * 8 + s;
                const f32x4 va = unp_lo(xa[s]), vb = unp_hi(xa[s]);
                ssq += va.x * va.x + va.y * va.y + va.z * va.z + va.w * va.w + vb.x * vb.x + vb.y * vb.y + vb.z * vb.z + vb.w * vb.w;
                const bf16x8 xh = __builtin_bit_cast(bf16x8, xa[s]);
                const bf16x8 wh0 = *(const bf16x8*)(Wh + fr * RW_ROW + ks * 32 + fq * 8), wl0 = *(const bf16x8*)(Wl + fr * RW_ROW + ks * 32 + fq * 8);
                const bf16x8 wh1 = *(const bf16x8*)(Wh + n1 * RW_ROW + ks * 32 + fq * 8), wl1 = *(const bf16x8*)(Wl + n1 * RW_ROW + ks * 32 + fq * 8);
                a0 = mfma16(wh0, xh, a0); a0 = mfma16(wl0, xh, a0);
                a1 = mfma16(wh1, xh, a1); a1 = mfma16(wl1, xh, a1);
            }
        }
        ssq += shx(ssq, 16, lane); ssq += shx(ssq, 32, lane);
        float* lg = lgs + (w * 16 + fr) * 24;
        *(f32x4*)(lg + 4 * fq) = a0;
        if (fq == 0) *(f32x4*)(lg + 16) = a1;
        __syncthreads();
        int mybk = 0, myrank = 0;
        if (lane < 16) {
            const float rs = rsqrtf(ssq * (1.0f / DM) + 1e-6f);
            float l20[20];
#pragma unroll
            for (int n = 0; n < 20; ++n) l20[n] = lg[n] * rs;
            int bk; float w0, w1;
            route_token(l20, bk, w0, w1);
            rstd2[tok] = rs; rw[tok * 2] = w0; rw[tok * 2 + 1] = w1;
            mybk = bk; myrank = atomicAdd(&hist[bk], 1);
        }
        __syncthreads();
        if (tid < 24) { const int c = hist[tid]; hist[32 + tid] = c > 0 ? (int)__hip_atomic_fetch_add(gcnt + tid, (unsigned)c, __ATOMIC_RELAXED, __HIP_MEMORY_SCOPE_AGENT) : 0; }
        __syncthreads();
        if (lane < 16) perm2[(size_t)mybk * 32768 + hist[32 + mybk] + myrank] = tok;
        __syncthreads();
    }
}

template <int MODE> DI JobInProjT<MODE> mk_inproj(const Params& p, const int L) { JobInProjT<MODE> j; char* w = opq(p.ws); j.A = w + OFF_R1; j.B = w + (size_t)L * WSET + OFF_WIN; j.ssq4 = (const float*)(w + OFF_SSQ4); j.A2 = (u16*)(w + OFF_A2); j.ws = w; return j; }
DI JobS5G1 mk_g1(const Params& p, const int L) { JobS5G1 j; j.A2 = opq(p.ws) + OFF_A2; j.W1 = opq(p.ws) + (size_t)L * WSET + OFF_W1T; j.Sloc = (float*)(opq(p.ws) + OFF_SLOC); return j; }
DI JobS5G2 mk_g2(const Params& p, const int L) { JobS5G2 j; j.A2 = opq(p.ws) + OFF_A2; j.W2 = opq(p.ws) + (size_t)L * WSET + OFF_W2T; j.Zp = (u16*)(opq(p.ws) + OFF_Z); return j; }
DI JobGLU mk_glu(const Params& p, const int L) { JobGLU j; j.Zp = opq(p.ws) + OFF_Z; j.B = opq(p.ws) + (size_t)L * WSET + OFF_WGLU; j.SGS = (const unsigned char*)(opq(p.ws) + OFF_SGS8); j.PA = (const u16*)(opq(p.ws) + pa_off(L)); j.MS = (u16*)(opq(p.ws) + OFF_R2); return j; }
DI JobAttnUp mk_attnup(const Params& p, const int L) { JobAttnUp j; j.A = opq(p.ws) + OFF_YA; j.B = opq(p.ws) + (size_t)L * WSET + OFF_WATT; j.SGA = (const unsigned char*)(opq(p.ws) + OFF_SGA8); j.PA = (u16*)(opq(p.ws) + pa_off(L)); return j; }
DI JobOut mk_out(const Params& p, const int L) { JobOut j; j.A = opq(p.ws) + OFF_R2; j.B = opq(p.ws) + (size_t)L * WSET + OFF_WOUT; j.XB = (u16*)(opq(p.ws) + OFF_R1); return j; }
DI JobMoeUp mk_moeup(const Params& p, const int L, char* lds) { JobMoeUp j; j.tb = (const PG_LAS int*)((PG_LAS char*)lds + MOE_TB_OFF); j.XB2 = opq(p.ws) + OFF_R1; j.WUP = opq(p.ws) + (size_t)L * WSET + OFF_WUP; j.perm = (const int*)(opq(p.ws) + OFF_PERM2); j.rstd2 = (const float*)(opq(p.ws) + OFF_RSTD2); j.rw = (const float*)(opq(p.ws) + OFF_RW); j.ACT = (u16*)(opq(p.ws) + OFF_R3); return j; }
DI JobMoeDown mk_moedown(const Params& p, const int L, char* lds) { JobMoeDown j; j.tb = (const PG_LAS int*)((PG_LAS char*)lds + MOE_TB_OFF); j.ACT = opq(p.ws) + OFF_R3; j.WDN = opq(p.ws) + (size_t)L * WSET + OFF_WDN; j.perm = (const int*)(opq(p.ws) + OFF_PERM2); j.XB = (u16*)(opq(p.ws) + OFF_R1); j.OUT = opq(p.out); j.ssq4 = (float*)(opq(p.ws) + OFF_SSQ4); j.last = L == 1; return j; }


#define XB_TMO      128
#define XB_XCNT(j)  (256  + 64 * (j))
#define XB_XSUB(j)  (1280 + 64 * (j))
#define XB_XGEN(j)  (2304 + 64 * (j))
#define XB_TOP      3328
#define XB_TOPGEN   3392
#define XB_SPIN_CAP (1u << 18)
DI unsigned xb_ld(unsigned* p)              { return __hip_atomic_load(p, __ATOMIC_RELAXED, __HIP_MEMORY_SCOPE_AGENT); }
DI unsigned xb_add(unsigned* p, unsigned v) { return __hip_atomic_fetch_add(p, v, __ATOMIC_RELAXED, __HIP_MEMORY_SCOPE_AGENT); }
DI unsigned xb_xcc_id() { return (unsigned)__builtin_amdgcn_s_getreg((3 << 11) | 20) & 0xFu; }
#define XB_SPIN(cond, bar) do { unsigned _sp = 0; while (cond) { __builtin_amdgcn_s_sleep(1); \
    if ((++_sp & 255u) == 0u) { if (xb_ld(&(bar)[XB_TMO])) break; if (_sp > XB_SPIN_CAP) { atomicAdd(&(bar)[XB_TMO], 1u); break; } } } } while (0)
struct XcdBarrier { unsigned* bar; unsigned x; volatile PG_LAS unsigned* st; };
DI XcdBarrier xcd_barrier_post(unsigned* bar, volatile PG_LAS unsigned* st) {
    XcdBarrier b; b.bar = bar; b.x = xb_xcc_id(); b.st = st;
    if (threadIdx.x == 0) (void)xb_add(&bar[XB_XCNT(b.x)], 1u);
    return b;
}
DI void xcd_barrier_complete(unsigned* bar, unsigned x, unsigned& nloc, unsigned& nx) {
    const unsigned G = gridDim.x * gridDim.y * gridDim.z;
    unsigned sum, cnt, mine, sp = 0u;
    for (;;) {
        sum = 0u; cnt = 0u; mine = 0u;
#pragma unroll
        for (unsigned j = 0; j < 16; ++j) { const unsigned c = xb_ld(&bar[XB_XCNT(j)]); sum += c; cnt += (c > 0u) ? 1u : 0u; mine = (j == x) ? c : mine; }
        if (sum == G) break;
        __builtin_amdgcn_s_sleep(1);
        if ((++sp & 255u) == 0u) { if (xb_ld(&bar[XB_TMO])) break; if (sp > XB_SPIN_CAP) { atomicAdd(&bar[XB_TMO], 1u); break; } }
    }
    nloc = mine > 0u ? mine : 1u; nx = cnt > 0u ? cnt : 1u;
}
DI void xcd_barrier(const XcdBarrier& b) {
    asm volatile("s_waitcnt vmcnt(0)" ::: "memory");
    __syncthreads();
    if (threadIdx.x == 0) {
        unsigned* bar = opq(b.bar);
        __builtin_amdgcn_s_waitcnt(0);
        asm volatile("buffer_inv sc1" ::: "memory");
        unsigned nloc = b.st[0], nx = b.st[1];
        if (nloc == 0u) { xcd_barrier_complete(bar, b.x, nloc, nx); b.st[0] = nloc; b.st[1] = nx; }
        const unsigned old = xb_add(&bar[XB_XSUB(b.x)], 1u);
        const unsigned gen = old / nloc;
        if (old + 1u == (gen + 1u) * nloc) {
            __builtin_amdgcn_fence(__ATOMIC_RELEASE, "agent");
            asm volatile("s_waitcnt vmcnt(0)" ::: "memory");
            const unsigned og = xb_add(&bar[XB_TOP], 1u);
            const unsigned tg = og / nx;
            if (og + 1u == (tg + 1u) * nx) xb_add(&bar[XB_TOPGEN], 1u);
            else XB_SPIN(xb_ld(&bar[XB_TOPGEN]) == tg, bar);
            asm volatile("s_waitcnt vmcnt(0)" ::: "memory");
        } else {
            XB_SPIN(xb_ld(&bar[XB_TOPGEN]) == gen, bar);
            asm volatile("s_waitcnt vmcnt(0)" ::: "memory");
        }
    }
    __syncthreads();
}


DI void phase_moe(const Params& p, const int L, char* lds) {
    unsigned* q = (unsigned*)(opq(p.ws) + OFF_MOEQ) + L * 256;
    unsigned* flag = q + 64;
    int* qslot = (int*)(lds + 163840 - 128);
    {
        PG_LAS int* tb = (PG_LAS int*)((PG_LAS char*)lds + MOE_TB_OFF);
        const int t24 = TID();
        if (t24 < 24) tb[32 + t24] = (int)__hip_atomic_load(q + 16 + t24, __ATOMIC_RELAXED, __HIP_MEMORY_SCOPE_AGENT);
        __syncthreads();
        if (threadIdx.x == 0) { int b = 0; for (int t = 0; t < 24; ++t) { tb[t] = b; b += ((tb[32 + t] + TM - 1) / TM) * TM; } tb[24] = b; }
        __syncthreads();
    }
    const JobMoeUp ju = mk_moeup(p, L, lds);
    const JobMoeDown jd = mk_moedown(p, L, lds);
    const int tiles = ju.num_units() >> 2, per = (tiles + 7) >> 3;
    const int myx = (int)((unsigned)__builtin_amdgcn_s_getreg((3 << 11) | 20) & 7u);
    int probe = 0, prev = -1;
    for (;;) {
        asm volatile("s_waitcnt vmcnt(0)" ::: "memory");
        __syncthreads();
        if (threadIdx.x == 0) {
            if (prev >= 0) (void)__hip_atomic_fetch_add(flag + prev, 1u, __ATOMIC_RELAXED, __HIP_MEMORY_SCOPE_AGENT);
            int r = -1;
            while (probe < 8) {
                const int x = (myx + probe) & 7, t0 = x * per;
                int ntx = tiles - t0; ntx = ntx > per ? per : ntx;
                if (ntx > 0) {
                    const int k = (int)__hip_atomic_fetch_add(q + 8 + x, 1u, __ATOMIC_RELAXED, __HIP_MEMORY_SCOPE_AGENT);
                    if (k < 8 * ntx) { r = k < 4 * ntx ? t0 * 4 + k : ((1 << 20) | (t0 * 4 + k - 4 * ntx)); break; }
                }
                ++probe;
            }
            *qslot = r;
        }
        __syncthreads();
        const int r = __builtin_amdgcn_readfirstlane(*qslot);
        __syncthreads();
        if (r < 0) break;
        if (r < (1 << 20)) {
            pg_gemm_seq(ju, lds, r, 1 << 30, r + 1);
            prev = r >> 2;
        } else {
            const int d = r & 0xfffff;
            prev = -1;
            if (__builtin_amdgcn_readfirstlane((int)threadIdx.x >> 6) == 0) {
                unsigned sp = 0;
                while ((unsigned)__builtin_amdgcn_readfirstlane((int)__hip_atomic_load(flag + (d >> 2), __ATOMIC_RELAXED, __HIP_MEMORY_SCOPE_AGENT)) < 4u) { __builtin_amdgcn_s_sleep(2); if (++sp > (1u << 16)) break; }
                __builtin_amdgcn_fence(__ATOMIC_ACQUIRE, "agent");
                asm volatile("s_waitcnt vmcnt(0)" ::: "memory");
            }
            __syncthreads();
            pg_gemm_seq(jd, lds, d, 1 << 30, d + 1);
        }
    }
}

extern __shared__ __attribute__((aligned(16))) char smem[];
namespace cg = cooperative_groups;
constexpr int MEGA_LDS = 163840;
constexpr size_t WS_NEED = OFF_BAR + CTL_BYTES;
__global__ void __launch_bounds__(NTHR) k_mega(const Params p) {
    cg::grid_group grid = cg::this_grid();
    volatile PG_LAS unsigned* st = (volatile PG_LAS unsigned*)((PG_LAS unsigned char*)smem + 163840 - 64);
    if (threadIdx.x < 4) st[threadIdx.x] = 0u;
    __syncthreads();
    const XcdBarrier xb = xcd_barrier_post((unsigned*)(opq(p.ws) + OFF_BAR), st);
#define GSYNC() xcd_barrier(xb)
    for (int L = 0; L < 2; ++L) {
        if (L == 0) {
            for (int rep = 0; rep < REP_PREP; ++rep) phase_prep(p, 0, smem);
            for (int rep = 0; rep < REP_XB; ++rep) phase_xb(p);
            if (p.ws == nullptr) grid.sync();
            GSYNC();
        }
        for (int rep = 0; rep < REP_INPROJ; ++rep) pg_gemm(mk_inproj<0>(p, L), smem);
        GSYNC();
        pg_gemm(mk_g1(p, L), smem);
        if (BID() < 128) { const UnitG ug = mk_g1(p, L).unit(BID()); scan_local(p, ug.g, ug.m0 >> 6); }
        if (BID() >= 128) pg_gemm(mk_inproj<1>(p, L), smem);
        for (int rep = 0; rep < REP_ATTN; ++rep) phase_attn(p, L, smem);
        GSYNC();
        for (int rep = 0; rep < REP_G2; ++rep) pg_gemm(mk_g2(p, L), smem);
        pg_gemm(mk_attnup(p, L), smem);
        GSYNC();
        for (int rep = 0; rep < REP_GLU; ++rep) pg_gemm(mk_glu(p, L), smem);
        GSYNC();
        for (int rep = 0; rep < (L == 0 ? REP_OUT0 : 1); ++rep) pg_gemm(mk_out(p, L), smem);
        GSYNC();
        for (int rep = 0; rep < REP_ROUTER; ++rep) phase_router(p, L, smem);
        GSYNC();
        phase_moe(p, L, smem);
        if (L == 0) { prep_from_queue(p, smem, 1 << 30, 1, 0); GSYNC(); }
    }
#undef GSYNC
}

extern "C" void kernel_launch(void* const* d_in, const int* in_sizes, int n_in, void* d_out, int out_size, void* d_ws, size_t ws_size, hipStream_t stream) {
    static int grid_blocks = 0;
    if (!grid_blocks) {
        int dev = 0, cus = 0, per_cu = 0;
        (void)hipGetDevice(&dev);
        (void)hipDeviceGetAttribute(&cus, hipDeviceAttributeMultiprocessorCount, dev);
        (void)hipFuncSetAttribute((const void*)k_mega, hipFuncAttributeMaxDynamicSharedMemorySize, MEGA_LDS);
        (void)hipOccupancyMaxActiveBlocksPerMultiprocessor(&per_cu, (const void*)k_mega, NTHR, MEGA_LDS);
        if (per_cu < 1) per_cu = 1;
        if (per_cu > 1) per_cu = 1;
        grid_blocks = cus * per_cu;
    }
    if (n_in != 23 || ws_size < WS_NEED || out_size != NTOK * DM) { fprintf(stderr, "kernel_launch: unexpected shapes (n_in %d ws %zu out %d)\n", n_in, ws_size, out_size); return; }
    Params p{};
    for (int i = 0; i < 23; ++i) p.in[i] = (const float*)d_in[i];
    p.out = (float*)d_out; p.ws = (char*)d_ws;
    (void)hipMemsetAsync((char*)d_ws + OFF_BAR, 0, CTL_BYTES, stream);
    void* args[] = {&p};
    hipError_t e = hipLaunchCooperativeKernel((const void*)k_mega, dim3(grid_blocks), dim3(NTHR), args, MEGA_LDS, stream);
    if (e != hipSuccess) fprintf(stderr, "cooperative launch failed: %s (grid %d)\n", hipGetErrorString(e), grid_blocks);
}
```

```cpp
#include <hip/hip_runtime.h>
#include <hip/hip_cooperative_groups.h>
#include <stdint.h>
#include <stdio.h>

#define DI __device__ __forceinline__
typedef unsigned short u16;
typedef short bf16x8 __attribute__((ext_vector_type(8)));
typedef short s16x4 __attribute__((ext_vector_type(4)));
typedef float f32x4 __attribute__((ext_vector_type(4)));
typedef float f32x2 __attribute__((ext_vector_type(2)));
typedef float f32x16 __attribute__((ext_vector_type(16)));
typedef unsigned u32x4 __attribute__((ext_vector_type(4)));
typedef unsigned u32x2 __attribute__((ext_vector_type(2)));
typedef __bf16 bf2_t __attribute__((ext_vector_type(2)));

constexpr int NTOK = 32768, DM = 1024, SEQ = 2048, NBATCH = 16, INC = 3328;
constexpr int TCH = 32, NCH = SEQ / TCH, S5M = NBATCH * NCH, S5K1 = TCH * 16, S5K2 = S5K1 + 128;
constexpr int TM = 256;
constexpr int MAXTILES = (NTOK + 24 * (TM - 1)) / TM + 1;
constexpr int NTHR = 512;
constexpr int LDS_BYTES = 98304;

#ifndef REP_PREP
#define REP_PREP 1
#endif
#ifndef REP_XB
#define REP_XB 1
#endif
#ifndef REP_ATTN
#define REP_ATTN 1
#endif
#ifndef REP_ROUTER
#define REP_ROUTER 1
#endif
#ifndef REP_INPROJ
#define REP_INPROJ 1
#endif
#ifndef REP_GLU
#define REP_GLU 1
#endif
#ifndef REP_MOEUP
#define REP_MOEUP 1
#endif
#ifndef REP_OUT0
#define REP_OUT0 1
#endif
#ifndef REP_EPI
#define REP_EPI 1
#endif
#ifndef REP_KLOOP
#define REP_KLOOP 1
#endif
#ifndef REP_G2
#define REP_G2 1
#endif
constexpr size_t MiB = 1u << 20;
constexpr size_t OFF_R1 = 0;
constexpr size_t OFF_R2 = 64 * MiB;
constexpr size_t OFF_R3 = 128 * MiB;
constexpr size_t OFF_A2 = 192 * MiB;
constexpr size_t OFF_Q = 232 * MiB;
constexpr size_t OFF_KV = 264 * MiB;
constexpr size_t OFF_SLOC = 280 * MiB;
constexpr size_t OFF_Z = OFF_Q;
constexpr size_t OFF_YA = 296 * MiB;
constexpr size_t WSET = 80 * MiB;
constexpr size_t OFF_WIN = 328 * MiB;
constexpr size_t OFF_WGLU = OFF_WIN + 7 * MiB;
constexpr size_t OFF_WATT = OFF_WGLU + 2 * MiB;
constexpr size_t OFF_WOUT = OFF_WATT + 1 * MiB;
constexpr size_t OFF_WUP = OFF_WOUT + 2 * MiB;
constexpr size_t OFF_WDN = OFF_WUP + 16 * MiB;
DI size_t pa_off(const int L) { return OFF_WIN + (size_t)(1 - L) * WSET; }
constexpr size_t OFF_W1T = OFF_WDN + 24 * MiB;
constexpr size_t OFF_W2T = OFF_W1T + 8 * MiB;
constexpr size_t OFF_SMALL = OFF_WIN + 2 * WSET;
constexpr size_t OFF_WR = OFF_SMALL;
constexpr size_t OFF_LT = OFF_WR + 128 * 1024;
constexpr size_t OFF_RSTD1 = OFF_LT + 64 * 1024;
constexpr size_t OFF_RSTD2 = OFF_RSTD1 + 128 * 1024;
constexpr size_t OFF_BUCKET = OFF_RSTD2 + 128 * 1024;
constexpr size_t OFF_RW = OFF_BUCKET + 128 * 1024;
constexpr size_t OFF_PERM = OFF_RW + 256 * 1024;
constexpr size_t OFF_CNT = OFF_PERM + 256 * 1024;
constexpr size_t OFF_TILEB = OFF_CNT + 32 * 1024;
constexpr size_t OFF_META = OFF_TILEB + 4 * 1024;
constexpr size_t OFF_SSQ4 = OFF_META + 1024;
constexpr size_t OFF_PERM2 = OFF_SSQ4 + 512 * 1024;
constexpr size_t WS_END = OFF_PERM2 + (size_t)24 * 32768 * 4;
constexpr size_t OFF_BAR = WS_END;
#define XCD_BAR_WORDS 3456
constexpr size_t OFF_MOEQ = OFF_BAR + XCD_BAR_WORDS * 4;
constexpr size_t CTL_BYTES = XCD_BAR_WORDS * 4 + 2 * 256 * 4;

struct Params {
    const float* in[23];
    float* out;
    char* ws;
};

DI int TID() { int t = threadIdx.x; asm volatile("" : "+v"(t)); return t; }
DI unsigned OZ() { unsigned z = 0; asm volatile("" : "+s"(z)); return z; }
template <class T> DI T* opq(T* x) { unsigned long long v = (unsigned long long)x; asm volatile("" : "+s"(v)); return (T*)(__attribute__((address_space(1))) char*)v; }
DI float shx(float v, int m, int lane) { return __builtin_bit_cast(float, __builtin_amdgcn_ds_bpermute((lane ^ m) << 2, __builtin_bit_cast(int, v))); }
DI const char* uptr(const char* p) { const unsigned long long v = (unsigned long long)p; const unsigned lo = (unsigned)__builtin_amdgcn_readfirstlane((int)(unsigned)v), hi = (unsigned)__builtin_amdgcn_readfirstlane((int)(unsigned)(v >> 32)); return (const char*)(__attribute__((address_space(1))) const char*)(((unsigned long long)hi << 32) | lo); }
DI void st16_sc1(void* p, u32x4 v) { asm volatile("global_store_dwordx4 %0, %1, off sc1\n\ts_nop 1" :: "v"(p), "v"(v) : "memory"); }
DI int BID() { int b = blockIdx.x; asm volatile("" : "+s"(b)); return b; }
DI unsigned pk2(float a, float b) { f32x2 v = {a, b}; bf2_t r = __builtin_convertvector(v, bf2_t); return __builtin_bit_cast(unsigned, r); }
DI float bf_lo(unsigned u) { return __uint_as_float(u << 16); }
DI float bf_hi(unsigned u) { return __uint_as_float(u & 0xffff0000u); }
DI float sigmoidf_(float x) { return __builtin_amdgcn_rcpf(1.0f + __builtin_amdgcn_exp2f(-1.4426950408889634f * x)); }
DI float gelu_tanh(float x) { const float u = 0.7978845608028654f * (x + 0.044715f * x * x * x); return x * __builtin_amdgcn_rcpf(1.0f + __builtin_amdgcn_exp2f(-2.8853900817779268f * u)); }
DI f32x16 mfma32(bf16x8 a, bf16x8 b, f32x16 c) { return __builtin_amdgcn_mfma_f32_32x32x16_bf16(a, b, c, 0, 0, 0); }
DI f32x4 mfma16(bf16x8 a, bf16x8 b, f32x4 c) { return __builtin_amdgcn_mfma_f32_16x16x32_bf16(a, b, c, 0, 0, 0); }

struct TJob { unsigned long long src, dst, scale; int ld_src, ld_dst, dcol0, rmul, radd, k0, n0; };
DI void tconv_load(const TJob& j, int tid, f32x4 (&v)[2]) {
    const float* src = (const float*)(__attribute__((address_space(1))) const char*)j.src;
#pragma unroll
    for (int i = 0; i < 2; ++i) v[i] = *(const f32x4*)(src + (size_t)(j.k0 + (tid >> 4) + 32 * i) * j.ld_src + j.n0 + (tid & 15) * 4);
}
DI void tconv_to_lds(const TJob& j, int tid, const f32x4 (&v)[2], float* sm) {
    const float* scale = (const float*)(__attribute__((address_space(1))) const char*)j.scale;
#pragma unroll
    for (int i = 0; i < 2; ++i) {
        const int k = (tid >> 4) + 32 * i, n = (tid & 15) * 4;
        const float sc = j.scale ? scale[j.k0 + k] : 1.0f;
        sm[(n + 0) * 65 + k] = v[i].x * sc; sm[(n + 1) * 65 + k] = v[i].y * sc; sm[(n + 2) * 65 + k] = v[i].z * sc; sm[(n + 3) * 65 + k] = v[i].w * sc;
    }
}
DI void tconv_store(const TJob& j, int tid, const float* sm) {
    u16* dst = (u16*)(__attribute__((address_space(1))) char*)j.dst;
    const int n = tid >> 3, c = tid & 7;
    const float* s = sm + n * 65 + c * 8;
    u32x4 o; o.x = pk2(s[0], s[1]); o.y = pk2(s[2], s[3]); o.z = pk2(s[4], s[5]); o.w = pk2(s[6], s[7]);
    const int nn = j.n0 + n, drow = j.rmul == 1 ? nn + j.radd : (nn >> 7) * 256 + j.radd + (nn & 127);
    *(u32x4*)(dst + (size_t)drow * j.ld_dst + j.dcol0 + j.k0 + c * 8) = o;
}

constexpr int T_WIN = (1024 / 64) * (INC / 64);
constexpr int T_GLU = 2 * (512 / 64) * (1024 / 64);
constexpr int T_ATT = (512 / 64) * (1024 / 64);
constexpr int T_OUT = (1024 / 64) * (1024 / 64);
constexpr int T_UP = 16 * 2 * (1024 / 64) * (256 / 64);
constexpr int T_DN = 24 * 2 * (256 / 64) * (1024 / 64);
constexpr int T_ALL = T_WIN + T_GLU + T_ATT + T_OUT + T_UP + T_DN;
static_assert(T_ALL % 4 == 0, "tiles are processed four at a time");

DI void pair_experts(int pidx, int& a, int& b) {
    a = pidx < 3 ? 0 : (pidx < 5 ? 1 : 2);
    b = pidx < 3 ? pidx + 1 : (pidx < 5 ? pidx - 1 : 3);
}

DI TJob prep_tjob(const Params& p, const int L, int t) {
    const unsigned long long ws = (unsigned long long)opq(p.ws) + (unsigned long long)L * WSET;
    TJob j; j.scale = 0; j.dcol0 = 0; j.rmul = 1; j.radd = 0;
    if (t < T_WIN) { const int kb = t / (INC / 64), nb = t % (INC / 64);
        j.src = (unsigned long long)(opq(p.in[2]) + (size_t)L * 1024 * INC); j.ld_src = INC; j.dst = ws + OFF_WIN; j.ld_dst = 1024; j.scale = (unsigned long long)(opq(p.in[1]) + L * 1024); j.k0 = kb * 64; j.n0 = nb * 64; return j; }
    t -= T_WIN;
    if (t < T_GLU) { const int half = t / 128, r = t % 128, kb = r / 16, nb = r % 16;
        j.src = (unsigned long long)((half ? opq(p.in[12]) : opq(p.in[11])) + (size_t)L * 512 * 1024); j.ld_src = 1024; j.dst = ws + OFF_WGLU; j.ld_dst = 512; j.rmul = 2; j.radd = half * 128; j.k0 = kb * 64; j.n0 = nb * 64; return j; }
    t -= T_GLU;
    if (t < T_ATT) { const int kb = t / 16, nb = t % 16;
        j.src = (unsigned long long)(opq(p.in[16]) + (size_t)L * 512 * 1024); j.ld_src = 1024; j.dst = ws + OFF_WATT; j.ld_dst = 512; j.k0 = kb * 64; j.n0 = nb * 64; return j; }
    t -= T_ATT;
    if (t < T_OUT) { const int kb = t / 16, nb = t % 16;
        j.src = (unsigned long long)(opq(p.in[17]) + (size_t)L * 1024 * 1024); j.ld_src = 1024; j.dst = ws + OFF_WOUT; j.ld_dst = 1024; j.k0 = kb * 64; j.n0 = nb * 64; return j; }
    t -= T_OUT;
    if (t < T_UP) { const int e = t / 128, r = t % 128, half = r / 64, r2 = r % 64, kb = r2 / 4, nb = r2 % 4;
        j.src = (unsigned long long)(opq(p.in[21]) + ((size_t)(L * 16 + e) * 1024) * 512 + half * 256); j.ld_src = 512; j.dst = ws + OFF_WUP + (size_t)e * 512 * 1024 * 2; j.ld_dst = 1024; j.rmul = 2; j.radd = half * 128;
        j.scale = (unsigned long long)(opq(p.in[18]) + L * 1024); j.k0 = kb * 64; j.n0 = nb * 64; return j; }
    t -= T_UP;
    { const int pr = t / 128, r = t % 128, slot = r / 64, r2 = r % 64, kb = r2 / 16, nb = r2 % 16;
      const int grp = pr / 6; int a, b; pair_experts(pr % 6, a, b); const int e = grp * 4 + (slot ? b : a);
      j.src = (unsigned long long)(opq(p.in[22]) + ((size_t)(L * 16 + e) * 256) * 1024); j.ld_src = 1024; j.dst = ws + OFF_WDN + (size_t)pr * 1024 * 512 * 2; j.ld_dst = 512; j.dcol0 = slot * 256; j.k0 = kb * 64; j.n0 = nb * 64; }
    return j;
}

DI void prep_s5_item(const Params& p, const int L, int item, float* sm) {
    const int tid = TID(), g = item >> 3, s = item & 7;
    float* LBre = sm;
    float* LBim = LBre + 33 * 64;
    float* BBre = LBim + 33 * 64;
    float* BBim = BBre + 1024;
    float* Cre = BBim + 1024;
    float* Cim = Cre + 128;
    float* Kt = Cim + 128;
    const float* lam_re = opq(p.in[3]) + (size_t)(L * 32 + g) * 64;
    const float* lam_im = opq(p.in[4]) + (size_t)(L * 32 + g) * 64;
    const float dt = expf(opq(p.in[5])[L * 32 + g]);
    const float* b_re = opq(p.in[6]) + (size_t)(L * 32 + g) * 1024;
    const float* b_im = opq(p.in[7]) + (size_t)(L * 32 + g) * 1024;
    const float* c_re = opq(p.in[8]) + (size_t)(L * 32 + g) * 1024;
    const float* c_im = opq(p.in[9]) + (size_t)(L * 32 + g) * 1024;
    const float* dsk = opq(p.in[10]) + L * 512 + g * 16;
    for (int i = tid; i < 33 * 64; i += NTHR) {
        const int lag = i >> 6, pp = i & 63;
        const float mag = expf(lam_re[pp] * dt * (float)lag);
        double a = (double)lam_im[pp] * (double)dt * (double)lag;
        a -= 6.283185307179586476925 * rint(a * 0.15915494309189533577);
        const float af = (float)a;
        LBre[i] = mag * cosf(af); LBim[i] = mag * sinf(af);
    }
    if (tid < 128) { Cre[tid] = c_re[(2 * s) * 64 + tid]; Cim[tid] = c_im[(2 * s) * 64 + tid]; }
    for (int i = tid; i < 1024; i += NTHR) {
        const int pp = i >> 4;
        const float lr = lam_re[pp], li = lam_im[pp];
        const float a = lr * dt; const float bb = li * dt;
        double br = (double)bb; br -= 6.283185307179586476925 * rint(br * 0.15915494309189533577);
        const float bf = (float)br;
        const float sh = sinf(0.5f * bf);
        const float xr = expm1f(a) * cosf(bf) - 2.0f * sh * sh;
        const float xi = expf(a) * sinf(bf);
        const float den = 1.0f / (lr * lr + li * li);
        const float fr = (xr * lr + xi * li) * den, fi = (xi * lr - xr * li) * den;
        const float vr = b_re[i], vi = b_im[i];
        BBre[i] = fr * vr - fi * vi; BBim[i] = fr * vi + fi * vr;
    }
    __syncthreads();
    if (s == 0 && tid < 64) { float* LT = (float*)(opq(p.ws) + OFF_LT) + (size_t)(g * 64 + tid) * 2; LT[0] = LBre[32 * 64 + tid]; LT[1] = LBim[32 * 64 + tid]; }
    for (int i = tid; i < 32 * 32; i += NTHR) {
        const int lag = i >> 5, hl = (i >> 4) & 1, hi = i & 15;
        float acc = 0.f;
        for (int pp = 0; pp < 64; ++pp) {
            const float cr = Cre[hl * 64 + pp], ci = Cim[hl * 64 + pp];
            const float lr = LBre[lag * 64 + pp], li = LBim[lag * 64 + pp];
            const float tr = cr * lr - ci * li, ti = cr * li + ci * lr;
            acc += tr * BBre[pp * 16 + hi] - ti * BBim[pp * 16 + hi];
        }
        Kt[i] = acc;
    }
    __syncthreads();
    u16* W1 = (u16*)(opq(p.ws) + (size_t)L * WSET + OFF_W1T) + (size_t)g * 256 * 512;
    for (int i = tid; i < 16 * 256; i += NTHR) {
        const int n = 16 * s + (i >> 8), k = (i & 255) * 2, pp = n >> 1, ri = n & 1, j = k >> 4, hi = k & 15;
        const float lr = LBre[(31 - j) * 64 + pp], li = LBim[(31 - j) * 64 + pp];
        float v[2];
#pragma unroll
        for (int e = 0; e < 2; ++e) { const float br = BBre[pp * 16 + hi + e], bi = BBim[pp * 16 + hi + e]; v[e] = ri ? (lr * bi + li * br) : (lr * br - li * bi); }
        *(unsigned*)(W1 + (size_t)n * 512 + k) = pk2(v[0], v[1]);
    }
    u16* W2 = (u16*)(opq(p.ws) + (size_t)L * WSET + OFF_W2T) + (size_t)g * 512 * 640;
    for (int idx = tid; idx < 64 * 320; idx += NTHR) {
        const int rr = idx / 320, k = (idx % 320) * 2, ii = rr >> 1, hl = rr & 1, ho = 2 * s + hl, n = ii * 16 + ho;
        float v[2];
        if (k < 512) {
            const int j = k >> 4, hi = k & 15;
#pragma unroll
            for (int e = 0; e < 2; ++e) {
                float x = 0.f;
                if (j <= ii) x = Kt[(ii - j) * 32 + hl * 16 + hi + e];
                if (j == ii && hi + e == ho) x += dsk[ho];
                v[e] = x;
            }
        } else {
            const int pp = (k - 512) >> 1;
            const float cr = Cre[hl * 64 + pp], ci = Cim[hl * 64 + pp];
            const float lr = LBre[(ii + 1) * 64 + pp], li = LBim[(ii + 1) * 64 + pp];
            v[0] = cr * lr - ci * li; v[1] = -(cr * li + ci * lr);
        }
        *(unsigned*)(W2 + (size_t)n * 640 + k) = pk2(v[0], v[1]);
    }
    __syncthreads();
}

DI void prep_router_w(const Params& p, const int L) {
    u16* WRH = (u16*)(opq(p.ws) + OFF_WR);
    u16* WRL = WRH + 21 * 1024;
    const float* nf = opq(p.in[18]) + L * 1024;
    const float* wc = opq(p.in[19]) + (size_t)L * 1024 * 4;
    const float* wf = opq(p.in[20]) + (size_t)L * 1024 * 16;
    for (int i = TID(); i < 21 * 1024; i += NTHR) {
        const int n = i >> 10, k = i & 1023;
        const float v = n < 20 ? nf[k] * (n < 4 ? wc[k * 4 + n] : wf[k * 16 + (n - 4)]) : 0.f;
        const unsigned h = pk2(v, 0.f) & 0xffffu;
        const float vh = __uint_as_float(h << 16);
        WRH[i] = (u16)h;
        WRL[i] = (u16)(pk2(v - vh, 0.f) & 0xffffu);
    }
}

DI void phase_prep(const Params& p, const int L, char* lds) {
    float* sm = (float*)lds;
    const int bid = BID(), G = gridDim.x;
    for (int it = bid; it < 257; it += G) {
        if (it < 256) prep_s5_item(p, L, it, sm);
        else prep_router_w(p, L);
    }
    const int tid = TID();
    for (int gi = bid; gi < T_WIN / 4; gi += G) {
        TJob j0 = prep_tjob(p, L, 4 * gi), j1 = prep_tjob(p, L, 4 * gi + 1), j2 = prep_tjob(p, L, 4 * gi + 2), j3 = prep_tjob(p, L, 4 * gi + 3);
        f32x4 v0[2], v1[2], v2[2], v3[2];
        tconv_load(j0, tid, v0); tconv_load(j1, tid, v1); tconv_load(j2, tid, v2); tconv_load(j3, tid, v3);
        tconv_to_lds(j0, tid, v0, sm); tconv_to_lds(j1, tid, v1, sm + 4224); tconv_to_lds(j2, tid, v2, sm + 8448); tconv_to_lds(j3, tid, v3, sm + 12672);
        __syncthreads();
        tconv_store(j0, tid, sm); tconv_store(j1, tid, sm + 4224); tconv_store(j2, tid, sm + 8448); tconv_store(j3, tid, sm + 12672);
        __syncthreads();
    }
}

constexpr int PREPQ_ITEMS = 257 + T_ALL / 4;
DI void prep_from_queue(const Params& p, char* lds, int budget, const int L, const int first) {
    float* sm = (float*)lds;
    unsigned* qc = (unsigned*)(opq(p.ws) + OFF_BAR) + 12 + L;
    int* qslot = (int*)(lds + 81920);
    const int tid = TID();
    for (int n = 0; n < budget; ++n) {
        if (threadIdx.x == 0) *qslot = (int)__hip_atomic_fetch_add(qc, 1u, __ATOMIC_RELAXED, __HIP_MEMORY_SCOPE_AGENT);
        __syncthreads();
        const int it = __builtin_amdgcn_readfirstlane(*qslot) + first;
        __syncthreads();
        if (it >= PREPQ_ITEMS) break;
        if (it < 256) prep_s5_item(p, L, it, sm);
        else if (it == 256) prep_router_w(p, L);
        else {
            const int gi = it - 257;
            TJob j0 = prep_tjob(p, L, 4 * gi), j1 = prep_tjob(p, L, 4 * gi + 1), j2 = prep_tjob(p, L, 4 * gi + 2), j3 = prep_tjob(p, L, 4 * gi + 3);
            f32x4 v0[2], v1[2], v2[2], v3[2];
            tconv_load(j0, tid, v0); tconv_load(j1, tid, v1); tconv_load(j2, tid, v2); tconv_load(j3, tid, v3);
            tconv_to_lds(j0, tid, v0, sm); tconv_to_lds(j1, tid, v1, sm + 4224); tconv_to_lds(j2, tid, v2, sm + 8448); tconv_to_lds(j3, tid, v3, sm + 12672);
            __syncthreads();
            tconv_store(j0, tid, sm); tconv_store(j1, tid, sm + 4224); tconv_store(j2, tid, sm + 8448); tconv_store(j3, tid, sm + 12672);
            __syncthreads();
        }
    }
}

DI void phase_xb(const Params& p) {
    const float* X = opq(p.in[0]);
    u16* XB = (u16*)(opq(p.ws) + OFF_R1);
    float* ssq4 = (float*)(opq(p.ws) + OFF_SSQ4);
    const int tid_ = TID(), lane = tid_ & 63, w = tid_ >> 6;
    for (int row = BID() * 8 + w; row < NTOK; row += gridDim.x * 8) {
        const f32x4* xr = (const f32x4*)(X + (size_t)row * DM) + lane;
        f32x4 v[4]; float s = 0.f;
#pragma unroll
        for (int j = 0; j < 4; ++j) v[j] = xr[64 * j];
        u32x2* o8 = (u32x2*)(XB + (size_t)row * DM) + lane;
#pragma unroll
        for (int j = 0; j < 4; ++j) { u32x2 q; q.x = pk2(v[j].x, v[j].y); q.y = pk2(v[j].z, v[j].w); o8[64 * j] = q;
            const float a = bf_lo(q.x), b = bf_hi(q.x), c = bf_lo(q.y), d = bf_hi(q.y); s += a * a + b * b + c * c + d * d; }
#pragma unroll
        for (int o = 1; o < 64; o <<= 1) s += shx(s, o, lane);
        if (lane == 0) *(f32x4*)(ssq4 + (size_t)row * 4) = (f32x4){s, 0.f, 0.f, 0.f};
    }
}

#define PG_LAS __attribute__((address_space(3)))
constexpr int PG_HTB = 128 * 64 * 2;
constexpr int PG_STAGE_BYTES = 8 * PG_HTB;
DI int pg_lds_byte(int r, int c) { const int st = (r >> 4) * 2 + (c >> 5), rr = r & 15, cc = c & 31, ob = rr * 64 + cc * 2; return st * 1024 + (ob ^ (((ob >> 9) & 1) << 5)); }
DI void pg_stage_rc(int b, int& R, int& C) { const int st = b / 1024, sb = b % 1024, swz = sb ^ (((sb >> 9) & 1) << 5); R = (st >> 1) * 16 + swz / 64; C = (st & 1) * 32 + (swz % 64) / 2; }

constexpr int ST16 = 264;
constexpr int ST16H = 136;
constexpr int ST32 = 260;
DI int rg_row(int rg, int rbase) { return (rg >> 2) * 128 + (rg & 3) * 16 + rbase; }

DI void pg_glds16(unsigned lds_dst, const char* base, unsigned voff) {
    unsigned keep;
    asm volatile("s_mov_b32 %0, m0\n\ts_mov_b32 m0, %1\n\ts_nop 0\n\tglobal_load_lds_dwordx4 %2, %3\n\ts_mov_b32 m0, %0" : "=&s"(keep) : "s"(lds_dst), "v"(voff), "s"(base) : "memory");
}

constexpr unsigned ROWC_OFF = 139264;
template <class J, class = void> struct has_rowdma { static constexpr bool v = false; };
template <class J> struct has_rowdma<J, decltype((void)J::ROWDMA)> { static constexpr bool v = J::ROWDMA; };

template <class J>
DI void pg_gemm_seq(const J& jb, char* lds_, const int u_begin, const int G, const int nu) {
    PG_LAS unsigned char* lds = (PG_LAS unsigned char*)lds_;
    const int tid = TID(), wid = __builtin_amdgcn_readfirstlane(tid >> 6), lane = tid & 63, wr = wid >> 2, wc = wid & 3, fr = lane & 15, fq = lane >> 4;
    const int bid = u_begin;
    const int K = jb.kdim(), nt = K / 64;
    if (bid >= nu) return;
    int Rr[2], Cc[2]; unsigned voffB[2];
#pragma unroll
    for (int i = 0; i < 2; ++i) { pg_stage_rc(tid * 16 + i * 8192, Rr[i], Cc[i]); const int rho = Rr[i] & 31, Rb = (Rr[i] & ~31) + 8 * ((rho & 15) >> 2) + 4 * (rho >> 4) + (rho & 3); voffB[i] = (unsigned)(Rb * K + Cc[i]) * 2u; }
    const size_t kstepA = jb.a_kstep();
    const size_t hstepA = jb.a_hstep();
    const size_t kstepB = 128;
    const size_t hstepB = (size_t)128 * K * 2;
    const unsigned ldsw = (unsigned)wid * 1024u;
    const unsigned ldsb = (unsigned)(size_t)lds;
    const int aoff = pg_lds_byte(wr * 64 + fr, fq * 8), boff = pg_lds_byte(wc * 32 + fr, fq * 8);
#define PG_SA(b, h) ((b) * 65536 + (h) * PG_HTB)
#define PG_SB(b, h) ((b) * 65536 + 32768 + (h) * PG_HTB)
#define PG_STAGE(bufoff, gbase, voff) do { _Pragma("unroll") for (int _i = 0; _i < 2; ++_i) \
        pg_glds16(ldsb + (unsigned)(bufoff) + ldsw + _i * 8192u, (const char*)(gbase), (voff)[_i]); } while (0)
#define PG_STAGE_A(bufoff, gbase, h) do { if constexpr (J::GATHER) { if (h) PG_STAGE(bufoff, gbase, vo1); else PG_STAGE(bufoff, gbase, vo0); } else { PG_STAGE(bufoff, (gbase) + (h) * hstepA, vo0); } } while (0)
#define PG_LDA(dst, b, h) do { _Pragma("unroll") for (int m = 0; m < 4; ++m) _Pragma("unroll") for (int k = 0; k < 2; ++k) dst[m][k] = *(const PG_LAS bf16x8*)(lds + PG_SA(b, h) + aoff + m * 2048 + k * 1024); } while (0)
#define PG_LDB(dst, b, h) do { _Pragma("unroll") for (int n = 0; n < 2; ++n) _Pragma("unroll") for (int k = 0; k < 2; ++k) dst[n][k] = *(const PG_LAS bf16x8*)(lds + PG_SB(b, h) + boff + n * 2048 + k * 1024); } while (0)
#define PG_MMA(ai, bj, At, Bt) do { __builtin_amdgcn_s_setprio(1); _Pragma("unroll") for (int m = 0; m < 4; ++m) _Pragma("unroll") for (int n = 0; n < 2; ++n) _Pragma("unroll") for (int k = 0; k < 2; ++k) \
        acc[ai][bj][m][n] = __builtin_amdgcn_mfma_f32_16x16x32_bf16(Bt[n][k], At[m][k], acc[ai][bj][m][n], 0, 0, 0); __builtin_amdgcn_s_setprio(0); } while (0)
#define PG_WAIT_V(n) asm volatile("s_waitcnt vmcnt(" #n ")" ::: "memory")
#define PG_WAIT_L(n) asm volatile("s_waitcnt lgkmcnt(" #n ")" ::: "memory")
#define PG_BAR __builtin_amdgcn_s_barrier()
#define PG_SCHED __builtin_amdgcn_sched_barrier(0)
    typename J::Unit cur = jb.unit(bid);
    unsigned vo0[2], vo1[2];
#pragma unroll
    for (int i = 0; i < 2; ++i) { vo0[i] = jb.a_off(cur, Rr[i], Cc[i]); vo1[i] = J::GATHER ? jb.a_off(cur, Rr[i] + 128, Cc[i]) : 0u; }
    const char* cA = uptr(jb.a_base(cur)); const char* cB = uptr(jb.b_base(cur));
    int rpar = 0;
    if constexpr (has_rowdma<J>::v) { if (wid < 4) pg_glds16(ldsb + ROWC_OFF + (unsigned)wid * 1024u, uptr(jb.row_base(cur)), (unsigned)tid * 16u); }
    PG_STAGE(PG_SB(0, 0), cB, voffB); PG_STAGE_A(PG_SA(0, 0), cA, 0); PG_STAGE(PG_SB(0, 1), cB + hstepB, voffB); PG_STAGE_A(PG_SA(0, 1), cA, 1);
    for (int uidx = bid;;) {
        if (wr == 1) PG_BAR;
        PG_WAIT_V(4); PG_BAR;
        PG_STAGE(PG_SB(1, 0), cB + kstepB, voffB); PG_STAGE_A(PG_SA(1, 0), cA + kstepA, 0); PG_STAGE(PG_SB(1, 1), cB + hstepB + kstepB, voffB);
        PG_WAIT_V(6); PG_BAR;
        f32x4 acc[2][2][4][2];
#pragma unroll
        for (int a = 0; a < 2; ++a)
#pragma unroll
            for (int b = 0; b < 2; ++b)
#pragma unroll
                for (int m = 0; m < 4; ++m)
#pragma unroll
                    for (int n = 0; n < 2; ++n) acc[a][b][m][n] = (f32x4){0.f, 0.f, 0.f, 0.f};
        bf16x8 At[4][2], B0[2][2], B1[2][2];
        for (int t = 0; t < nt; t += 2) {
            const bool more = (t != nt - 2);
            const char* a1 = cA + (size_t)(t + 1) * kstepA;
            const char* a2 = cA + (size_t)(t + 2) * kstepA; const char* b2 = cB + (size_t)(t + 2) * kstepB;
            const char* a3 = a2 + kstepA; const char* b3 = b2 + kstepB;
            PG_LDB(B0, 0, 0); PG_SCHED; PG_LDA(At, 0, 0); PG_STAGE_A(PG_SA(1, 1), a1, 1);
            PG_WAIT_L(8); PG_BAR; PG_WAIT_L(0); PG_MMA(0, 0, At, B0); PG_BAR; PG_SCHED;
            PG_LDB(B1, 0, 1); if (more) PG_STAGE(PG_SB(0, 0), b2, voffB);
            PG_BAR; PG_WAIT_L(0); PG_MMA(0, 1, At, B1); PG_BAR;
            PG_LDA(At, 0, 1); if (more) PG_STAGE_A(PG_SA(0, 0), a2, 0);
            PG_BAR; PG_WAIT_L(0); PG_MMA(1, 0, At, B0); PG_BAR; PG_SCHED;
            if (more) { PG_STAGE(PG_SB(0, 1), b2 + hstepB, voffB); PG_WAIT_V(6); } else { PG_WAIT_V(0); }
            PG_BAR; PG_MMA(1, 1, At, B1); PG_BAR;
            PG_LDB(B0, 1, 0); PG_SCHED; PG_LDA(At, 1, 0); if (more) PG_STAGE_A(PG_SA(0, 1), a2, 1);
            PG_WAIT_L(8); PG_BAR; PG_WAIT_L(0); PG_MMA(0, 0, At, B0); PG_BAR; PG_SCHED;
            PG_LDB(B1, 1, 1); if (more) PG_STAGE(PG_SB(1, 0), b3, voffB);
            PG_BAR; PG_WAIT_L(0); PG_MMA(0, 1, At, B1); PG_BAR;
            PG_LDA(At, 1, 1); if (more) PG_STAGE_A(PG_SA(1, 0), a3, 0);
            PG_BAR; PG_WAIT_L(0); PG_MMA(1, 0, At, B0); PG_BAR; PG_SCHED;
            if (more) { PG_STAGE(PG_SB(1, 1), b3 + hstepB, voffB); PG_WAIT_V(6); }
            PG_BAR; PG_MMA(1, 1, At, B1); PG_BAR;
        }
        if (wr == 0) PG_BAR;
        PG_BAR;
        const int nidx = uidx + G;
        const bool has_next = nidx < nu;
        const typename J::Unit done = cur;
        if (has_next) {
            cur = jb.unit(nidx);
            if constexpr (J::GATHER) {
#pragma unroll
                for (int i = 0; i < 2; ++i) { int R2, C2; pg_stage_rc(TID() * 16 + i * 8192, R2, C2); vo0[i] = jb.a_off(cur, R2, C2); vo1[i] = jb.a_off(cur, R2 + 128, C2); }
            }
            cA = uptr(jb.a_base(cur)); cB = uptr(jb.b_base(cur));
            if constexpr (has_rowdma<J>::v) { if (wid < 4) pg_glds16(ldsb + ROWC_OFF + (unsigned)((rpar ^ 1) * 4096) + (unsigned)wid * 1024u, uptr(jb.row_base(cur)), (unsigned)TID() * 16u); }
            PG_STAGE(PG_SB(0, 0), cB, voffB); PG_STAGE_A(PG_SA(0, 0), cA, 0); PG_STAGE(PG_SB(0, 1), cB + hstepB, voffB); PG_STAGE_A(PG_SA(0, 1), cA, 1);
        }
        {
            const int l2 = TID() & 63;
            const int rbase = wr * 64 + (l2 & 15), cb = wc * 32 + 8 * (l2 >> 4);
            typename J::Ctx ctx;
            if constexpr (has_rowdma<J>::v) jb.epi_begin(done, rbase, ctx, (const PG_LAS unsigned char*)(lds + ROWC_OFF + rpar * 4096)); else jb.epi_begin(done, rbase, ctx);
            if constexpr (J::SMODE == 0 && J::NCOL == 128) {
                PG_LAS u16* T = (PG_LAS u16*)(lds + 65536);
#pragma unroll
                for (int rg = 0; rg < 8; ++rg) {
                    u32x4 o0, o1;
                    jb.epi_val(done, ctx, rg, acc[rg >> 2][0][rg & 3][0], acc[rg >> 2][0][rg & 3][1], acc[rg >> 2][1][rg & 3][0], acc[rg >> 2][1][rg & 3][1], o0, o1);
                    *(PG_LAS u32x4*)(T + rg_row(rg, rbase) * ST16H + cb) = o0;
                }
                __syncthreads();
                jb.epi_copy(done, ctx, (const PG_LAS u16*)T, TID());
                __syncthreads();
            } else if constexpr (J::SMODE == 0) {
                PG_LAS u16* T = (PG_LAS u16*)(lds + 65536);
#pragma unroll
                for (int h = 0; h < 2; ++h) {
#pragma unroll
                    for (int m = 0; m < 4; ++m) {
                        u32x4 o0, o1;
                        jb.epi_val(done, ctx, h * 4 + m, acc[h][0][m][0], acc[h][0][m][1], acc[h][1][m][0], acc[h][1][m][1], o0, o1);
                        PG_LAS u16* d = T + (m * 16 + rbase) * ST16 + cb;
                        *(PG_LAS u32x4*)d = o0; *(PG_LAS u32x4*)(d + 128) = o1;
                    }
                    __syncthreads();
                    jb.epi_copy(done, (const PG_LAS u16*)T, h, TID());
                    __syncthreads();
                }
            } else {
                PG_LAS float* T = (PG_LAS float*)(lds + 65536);
                typename J::Pre pa, pb;
                jb.epi_load(done, ctx, 0, TID(), pa);
#pragma unroll
                for (int ps = 0; ps < 4; ++ps) {
                    if (wr == (ps & 1)) {
#pragma unroll
                        for (int m = 0; m < 4; ++m) {
                            PG_LAS float* d = T + (m * 16 + (l2 & 15)) * ST32 + cb;
                            *(PG_LAS f32x4*)d = acc[ps >> 1][0][m][0]; *(PG_LAS f32x4*)(d + 4) = acc[ps >> 1][0][m][1];
                            *(PG_LAS f32x4*)(d + 128) = acc[ps >> 1][1][m][0]; *(PG_LAS f32x4*)(d + 132) = acc[ps >> 1][1][m][1];
                        }
                    }
                    __syncthreads();
                    if (ps < 3) jb.epi_load(done, ctx, ps + 1, TID(), pb);
                    jb.epi_copy(done, ctx, (const PG_LAS float*)T, ps, TID(), pa);
                    __syncthreads();
                    pa = pb;
                }
            }
        }
        if (!has_next) break;
        uidx = nidx; rpar ^= 1;
    }
#undef PG_SA
#undef PG_SB
#undef PG_STAGE
#undef PG_STAGE_A
#undef PG_LDA
#undef PG_LDB
#undef PG_MMA
#undef PG_WAIT_V
#undef PG_WAIT_L
#undef PG_BAR
#undef PG_SCHED
}

template <class J> DI void pg_gemm(const J& jb, char* lds_) { pg_gemm_seq(jb, lds_, BID(), (int)gridDim.x, jb.num_units()); }

DI void tile_order(int L, int nM, int nN, int& pm, int& pn) {
    const int nwg = nM * nN, q = nwg / 8, r = nwg % 8, xcd = L % 8, off = L / 8;
    const int wgid = (xcd < r ? xcd * (q + 1) : r * (q + 1) + (xcd - r) * q) + off;
    const int nig = 8 * nN, gid = wgid / nig, fm = gid * 8, gsz = (nM - fm) < 8 ? (nM - fm) : 8;
    pm = fm + ((wgid % nig) % gsz); pn = (wgid % nig) / gsz;
}

struct UnitMN { int m0, n0; };
struct NoCtx {};
DI u32x4 pack8(f32x4 a, f32x4 b) { u32x4 o; o.x = pk2(a.x, a.y); o.y = pk2(a.z, a.w); o.z = pk2(b.x, b.y); o.w = pk2(b.z, b.w); return o; }
DI f32x4 sig4(f32x4 v) { f32x4 o; o.x = sigmoidf_(v.x); o.y = sigmoidf_(v.y); o.z = sigmoidf_(v.z); o.w = sigmoidf_(v.w); return o; }
DI unsigned q4u8(f32x4 v) {
    const unsigned a = (unsigned)fmaf(v.x, 255.0f, 0.5f), b = (unsigned)fmaf(v.y, 255.0f, 0.5f), c = (unsigned)fmaf(v.z, 255.0f, 0.5f), d = (unsigned)fmaf(v.w, 255.0f, 0.5f);
    return a | (b << 8) | (c << 16) | (d << 24);
}
DI f32x4 unq4u8(unsigned w) { f32x4 o; o.x = (float)(w & 0xffu); o.y = (float)((w >> 8) & 0xffu); o.z = (float)((w >> 16) & 0xffu); o.w = (float)(w >> 24); return o * (1.0f / 255.0f); }
constexpr size_t OFF_SGS8 = OFF_R3, OFF_SGA8 = OFF_R3 + ((size_t)32 << 20);
DI f32x4 unp_lo(u32x4 u) { f32x4 o; o.x = bf_lo(u.x); o.y = bf_hi(u.x); o.z = bf_lo(u.y); o.w = bf_hi(u.y); return o; }
DI f32x4 unp_hi(u32x4 u) { f32x4 o; o.x = bf_lo(u.z); o.y = bf_hi(u.z); o.z = bf_lo(u.w); o.w = bf_hi(u.w); return o; }

template <int MODE> struct JobInProjT {
    typedef UnitMN Unit; static constexpr bool GATHER = false; static constexpr int SMODE = 0, NCOL = 256, EREP = REP_EPI;
    struct Ctx { float rs[8]; };
    const char* A; const char* B; const float* ssq4; u16* A2; char* ws;
    DI int num_units() const { return MODE == 0 ? (NTOK / 256) * 12 : 256; }
    DI Unit unit(int u) const { int pm, pn; if (MODE == 0) tile_order(u, NTOK / 256, 12, pm, pn); else { pm = u - 128; pn = 12; } Unit x; x.m0 = pm * 256; x.n0 = pn * 256; return x; }
    DI const char* a_base(const Unit& un) const { return A + (size_t)un.m0 * 2048; }
    DI const char* b_base(const Unit& un) const { return B + (size_t)un.n0 * 2048; }
    DI unsigned a_off(const Unit&, int R, int C) const { return (unsigned)(R * 1024 + C) * 2u; }
    DI size_t a_hstep() const { return 128 * 2048; }
    DI size_t a_kstep() const { return 128; }
    DI int kdim() const { return 1024; }
    static constexpr bool ROWDMA = true;
    DI const char* row_base(const Unit& un) const { return (const char*)ssq4 + (size_t)un.m0 * 16; }
    DI void epi_begin(const Unit&, int rbase, Ctx& c, const PG_LAS unsigned char* rc) const {
#pragma unroll
        for (int rg = 0; rg < 8; ++rg) { const f32x4 q = *(const PG_LAS f32x4*)(rc + rg_row(rg, rbase) * 16); c.rs[rg] = rsqrtf((q.x + q.y + q.z + q.w) * (1.0f / DM) + 1e-6f); }
    }
    DI void epi_val(const Unit& un, const Ctx& c, int rg, f32x4 v00, f32x4 v01, f32x4 v10, f32x4 v11, u32x4& o0, u32x4& o1) const {
        const float s = c.rs[rg];
        if (un.n0 >= 1280) { o0 = (u32x4){q4u8(sig4(v00 * s)), q4u8(sig4(v01 * s)), 0u, 0u}; o1 = (u32x4){q4u8(sig4(v10 * s)), q4u8(sig4(v11 * s)), 0u, 0u}; }
        else { o0 = pack8(v00 * s, v01 * s); o1 = pack8(v10 * s, v11 * s); }
    }
    DI void epi_copy(const Unit& un, const PG_LAS u16* T, int h, int tid) const {
        if (un.n0 < 512) {
#pragma unroll
            for (int it = 0; it < 4; ++it) {
                const int id = it * NTHR + tid, gl = id >> 7, r = id & 127, row = un.m0 + h * 128 + r;
                const PG_LAS u16* s = T + r * ST16 + gl * 16;
                const u32x4 a = *(const PG_LAS u32x4*)s, b = *(const PG_LAS u32x4*)(s + 8);
                const int g = (un.n0 >> 4) + gl, bb = row >> 11, t = row & 2047, ch = t >> 5, i = t & 31;
                u16* d = A2 + ((size_t)(g * S5M + bb * NCH + ch) * S5K2 + i * 16);
                *(u32x4*)d = a; *(u32x4*)(d + 8) = b;
            }
            return;
        }
        if (un.n0 >= 1280) {
            unsigned char* d8 = (unsigned char*)ws + (un.n0 < 2304 ? OFF_SGS8 + (size_t)(un.n0 - 1280) : OFF_SGA8 + (size_t)(un.n0 - 2304));
#pragma unroll
            for (int it = 0; it < 8; ++it) {
                const int id = it * NTHR + tid, r = id >> 5, c = (id & 31) * 8;
                *(u32x2*)(d8 + (size_t)(un.m0 + h * 128 + r) * 1024 + c) = *(const PG_LAS u32x2*)(T + r * ST16 + c);
            }
            return;
        }
        size_t doff; int ld, c0;
        if (un.n0 < 1024) { doff = OFF_Q; ld = 512; c0 = un.n0 - 512; }
        else { doff = OFF_KV; ld = 256; c0 = 0; }
        u16* dst = (u16*)(ws + doff);
#pragma unroll
        for (int it = 0; it < 8; ++it) {
            const int id = it * NTHR + tid, r = id >> 5, c = (id & 31) * 8;
            *(u32x4*)(dst + (size_t)(un.m0 + h * 128 + r) * ld + c0 + c) = *(const PG_LAS u32x4*)(T + r * ST16 + c);
        }
    }
};

struct UnitG { int g, m0, n0; };
struct JobS5G1 {
    typedef UnitG Unit; static constexpr bool GATHER = false; static constexpr int SMODE = 1, NCOL = 256, EREP = 1;
    typedef NoCtx Ctx;
    const char* A2; const char* W1; float* Sloc;
    DI int num_units() const { return 32 * (S5M / 256); }
    DI Unit unit(int u) const { const int xcd = u & 7, slot = u >> 3; Unit x; x.g = xcd * 4 + (slot >> 2); x.m0 = (slot & 3) * 256; x.n0 = 0; return x; }
    DI const char* a_base(const Unit& un) const { return A2 + (size_t)(un.g * S5M + un.m0) * S5K2 * 2; }
    DI const char* b_base(const Unit& un) const { return W1 + (size_t)un.g * 256 * 512 * 2; }
    DI unsigned a_off(const Unit&, int R, int C) const { return (unsigned)(R * S5K2 + C) * 2u; }
    DI size_t a_hstep() const { return 128 * S5K2 * 2; }
    DI size_t a_kstep() const { return 128; }
    DI int kdim() const { return S5K1; }
    DI void epi_begin(const Unit&, int, Ctx&) const {}
    struct Pre {}; DI void epi_load(const Unit&, const Ctx&, int, int, Pre&) const {}
    DI void epi_copy(const Unit& un, const Ctx&, const PG_LAS float* T, int ps, int tid, const Pre&) const {
        const int r0 = (ps >> 1) * 128 + (ps & 1) * 64;
#pragma unroll
        for (int it = 0; it < 4; ++it) {
            const int id = it * NTHR + tid, r = id >> 5, c = (id & 31) * 4;
            *(f32x4*)(Sloc + (size_t)(un.g * S5M + un.m0 + r0 + r) * 128 + c) = *(const PG_LAS f32x4*)(T + r * ST32 + c);
        }
    }
};

struct JobS5G2 {
    typedef UnitG Unit; static constexpr bool GATHER = false; static constexpr int SMODE = 0, NCOL = 256, EREP = 1;
    typedef NoCtx Ctx;
    const char* A2; const char* W2; u16* Zp;
    DI int num_units() const { return 32 * (S5M / 256) * 2; }
    DI Unit unit(int u) const { const int xcd = u & 7, slot = u >> 3; Unit x; x.g = xcd * 4 + (slot >> 3); const int r = slot & 7; x.m0 = (r >> 1) * 256; x.n0 = (r & 1) * 256; return x; }
    DI const char* a_base(const Unit& un) const { return A2 + (size_t)(un.g * S5M + un.m0) * S5K2 * 2; }
    DI const char* b_base(const Unit& un) const { return W2 + (size_t)(un.g * 512 + un.n0) * S5K2 * 2; }
    DI unsigned a_off(const Unit&, int R, int C) const { return (unsigned)(R * S5K2 + C) * 2u; }
    DI size_t a_hstep() const { return 128 * S5K2 * 2; }
    DI size_t a_kstep() const { return 128; }
    DI int kdim() const { return S5K2; }
    DI void epi_begin(const Unit&, int, Ctx&) const {}
    DI f32x4 gelu4(f32x4 v) const { f32x4 o; o.x = gelu_tanh(v.x); o.y = gelu_tanh(v.y); o.z = gelu_tanh(v.z); o.w = gelu_tanh(v.w); return o; }
    DI void epi_val(const Unit&, const Ctx&, int, f32x4 v00, f32x4 v01, f32x4 v10, f32x4 v11, u32x4& o0, u32x4& o1) const { o0 = pack8(gelu4(v00), gelu4(v01)); o1 = pack8(gelu4(v10), gelu4(v11)); }
    DI void epi_copy(const Unit& un, const PG_LAS u16* T, int h, int tid) const {
#pragma unroll
        for (int it = 0; it < 8; ++it) {
            const int id = it * NTHR + tid, r = id >> 5, c = (id & 31) * 8, rr = un.m0 + h * 128 + r, bb = rr >> 6, ch = rr & 63;
            *(u32x4*)(Zp + ((size_t)un.g * NTOK + bb * SEQ + ch * TCH) * 16 + un.n0 + c) = *(const PG_LAS u32x4*)(T + r * ST16 + c);
        }
    }
};

struct JobGLU {
    typedef UnitMN Unit; static constexpr bool GATHER = false; static constexpr int SMODE = 0, NCOL = 128, EREP = 1;
    struct Ctx { u32x2 sg[8]; u32x4 pa[8]; };
    const char* Zp; const char* B; const unsigned char* SGS; const u16* PA; u16* MS;
    DI int num_units() const { return (NTOK / 256) * 8; }
    DI Unit unit(int u) const { int pm, pn; tile_order(u, NTOK / 256, 8, pm, pn); Unit x; x.m0 = pm * 256; x.n0 = pn * 256; return x; }
    DI const char* a_base(const Unit& un) const { return Zp + (size_t)un.m0 * 32; }
    DI const char* b_base(const Unit& un) const { return B + (size_t)un.n0 * 1024; }
    DI unsigned a_off(const Unit&, int R, int C) const { return (unsigned)(((C >> 4) * NTOK + R) * 32 + (C & 15) * 2); }
    DI size_t a_hstep() const { return 128 * 32; }
    DI size_t a_kstep() const { return (size_t)4 * NTOK * 32; }
    DI int kdim() const { return 512; }
    DI void epi_begin(const Unit& un, int, Ctx& cx) const {
        const int tid = TID();
#pragma unroll
        for (int it = 0; it < 8; ++it) { const int id = it * NTHR + tid, r = id >> 4, c = (id & 15) * 8; const size_t off = (size_t)(un.m0 + r) * 1024 + (un.n0 >> 1) + c; cx.sg[it] = *(const u32x2*)(SGS + off); cx.pa[it] = *(const u32x4*)(PA + off); }
    }
    DI void epi_val(const Unit&, const Ctx&, int, f32x4 v00, f32x4 v01, f32x4 v10, f32x4 v11, u32x4& o0, u32x4& o1) const { o0 = pack8(v00 * sig4(v10), v01 * sig4(v11)); o1 = o0; }
    DI void epi_copy(const Unit& un, const Ctx& cx, const PG_LAS u16* T, int tid) const {
#pragma unroll
        for (int it = 0; it < 8; ++it) {
            const int id = it * NTHR + tid, r = id >> 4, c = (id & 15) * 8;
            const u32x4 v = *(const PG_LAS u32x4*)(T + r * ST16H + c);
            *(u32x4*)(MS + (size_t)(un.m0 + r) * 1024 + (un.n0 >> 1) + c) = pack8(unp_lo(v) * unq4u8(cx.sg[it].x) + unp_lo(cx.pa[it]), unp_hi(v) * unq4u8(cx.sg[it].y) + unp_hi(cx.pa[it]));
        }
    }
};

struct JobAttnUp {
    typedef UnitMN Unit; static constexpr bool GATHER = false; static constexpr int SMODE = 1, NCOL = 256, EREP = 1;
    typedef NoCtx Ctx;
    const char* A; const char* B; const unsigned char* SGA; u16* PA;
    DI int num_units() const { return (NTOK / 256) * 4; }
    DI Unit unit(int u) const { int pm, pn; tile_order(u, NTOK / 256, 4, pm, pn); Unit x; x.m0 = pm * 256; x.n0 = pn * 256; return x; }
    DI const char* a_base(const Unit& un) const { return A + (size_t)un.m0 * 1024; }
    DI const char* b_base(const Unit& un) const { return B + (size_t)un.n0 * 1024; }
    DI unsigned a_off(const Unit&, int R, int C) const { return (unsigned)(R * 512 + C) * 2u; }
    DI size_t a_hstep() const { return 128 * 1024; }
    DI size_t a_kstep() const { return 128; }
    DI int kdim() const { return 512; }
    DI void epi_begin(const Unit&, int, Ctx&) const {}
    struct Pre { u32x2 ga[4]; };
    DI void epi_load(const Unit& un, const Ctx&, int ps, int tid, Pre& p) const {
        const int r0 = (ps >> 1) * 128 + (ps & 1) * 64;
#pragma unroll
        for (int it = 0; it < 4; ++it) { const int id = it * NTHR + tid, r = id >> 5, c = (id & 31) * 8; const size_t off = (size_t)(un.m0 + r0 + r) * 1024 + un.n0 + c; p.ga[it] = *(const u32x2*)(SGA + off); }
    }
    DI void epi_copy(const Unit& un, const Ctx&, const PG_LAS float* T, int ps, int tid, const Pre& p) const {
        const int r0 = (ps >> 1) * 128 + (ps & 1) * 64;
#pragma unroll
        for (int it = 0; it < 4; ++it) {
            const int id = it * NTHR + tid, r = id >> 5, c = (id & 31) * 8;
            const f32x4 a = unq4u8(p.ga[it].x) * *(const PG_LAS f32x4*)(T + r * ST32 + c), b = unq4u8(p.ga[it].y) * *(const PG_LAS f32x4*)(T + r * ST32 + c + 4);
            *(u32x4*)(PA + (size_t)(un.m0 + r0 + r) * 1024 + un.n0 + c) = pack8(a, b);
        }
    }
};

struct JobOut {
    typedef UnitMN Unit; static constexpr bool GATHER = false; static constexpr int SMODE = 1, NCOL = 256, EREP = 1;
    typedef NoCtx Ctx;
    const char* A; const char* B; u16* XB;
    DI int num_units() const { return (NTOK / 256) * 4; }
    DI Unit unit(int u) const { int pm, pn; tile_order(u, NTOK / 256, 4, pm, pn); Unit x; x.m0 = pm * 256; x.n0 = pn * 256; return x; }
    DI const char* a_base(const Unit& un) const { return A + (size_t)un.m0 * 2048; }
    DI const char* b_base(const Unit& un) const { return B + (size_t)un.n0 * 2048; }
    DI unsigned a_off(const Unit&, int R, int C) const { return (unsigned)(R * 1024 + C) * 2u; }
    DI size_t a_hstep() const { return 128 * 2048; }
    DI size_t a_kstep() const { return 128; }
    DI int kdim() const { return 1024; }
    DI void epi_begin(const Unit&, int, Ctx&) const {}
    struct Pre { u32x4 xv[4]; };
    DI void epi_load(const Unit& un, const Ctx&, int ps, int tid, Pre& p) const {
        const int r0 = (ps >> 1) * 128 + (ps & 1) * 64;
#pragma unroll
        for (int it = 0; it < 4; ++it) { const int id = it * NTHR + tid, r = id >> 5, c = (id & 31) * 8; p.xv[it] = *(const u32x4*)(XB + (size_t)(un.m0 + r0 + r) * 1024 + un.n0 + c); }
    }
    DI void epi_copy(const Unit& un, const Ctx&, const PG_LAS float* T, int ps, int tid, const Pre& p) const {
        const int r0 = (ps >> 1) * 128 + (ps & 1) * 64;
#pragma unroll
        for (int it = 0; it < 4; ++it) {
            const int id = it * NTHR + tid, r = id >> 5, c = (id & 31) * 8;
            const f32x4 a = unp_lo(p.xv[it]) + *(const PG_LAS f32x4*)(T + r * ST32 + c), b = unp_hi(p.xv[it]) + *(const PG_LAS f32x4*)(T + r * ST32 + c + 4);
            *(u32x4*)(XB + (size_t)(un.m0 + r0 + r) * 1024 + un.n0 + c) = pack8(a, b);
        }
    }
};

struct UnitMoe { int m0, n0, e0, e1, pr, pb, nv; };
constexpr unsigned MOE_TB_OFF = 151552;
DI int moe_tok(const int* perm2, const UnitMoe& un, int R) { return R < un.nv ? perm2[un.pb + R] : -1; }
DI void moe_unit(const PG_LAS int* tb, int u, UnitMoe& x) {
    const int rt = u >> 2; x.m0 = rt * TM; x.n0 = (u & 3) * 256;
    int bk = 0;
#pragma unroll 1
    for (int q = 1; q < 24; ++q) if (x.m0 >= __builtin_amdgcn_readfirstlane(tb[q])) bk = q;
    x.pr = bk;
    const int l0 = x.m0 - __builtin_amdgcn_readfirstlane(tb[bk]);
    int nv = __builtin_amdgcn_readfirstlane(tb[32 + bk]) - l0; nv = nv < 0 ? 0 : (nv > TM ? TM : nv);
    x.nv = nv; x.pb = bk * 32768 + l0;
}
DI void bucket_decode(int bk, int& e0, int& e1) { const int grp = bk / 6; int a, b; pair_experts(bk % 6, a, b); e0 = grp * 4 + a; e1 = grp * 4 + b; }
struct JobMoeUp {
    typedef UnitMoe Unit; static constexpr bool GATHER = true; static constexpr int SMODE = 0, NCOL = 128, EREP = 1;
    struct Ctx { float rs[8]; float wg[8]; };
    const char* XB2; const char* WUP; const int* perm; const PG_LAS int* tb; const float* rstd2; const float* rw; u16* ACT;
    DI int num_units() const { return (__builtin_amdgcn_readfirstlane(tb[24]) / TM) * 4; }
    DI Unit unit(int u) const { Unit x; moe_unit(tb, u, x); bucket_decode(x.pr, x.e0, x.e1); return x; }
    DI const char* a_base(const Unit&) const { return XB2; }
    DI const char* b_base(const Unit& un) const { const int e = un.n0 < 512 ? un.e0 : un.e1; return WUP + (size_t)(e * 512 + (un.n0 & 511)) * 2048; }
    DI unsigned a_off(const Unit& un, int R, int C) const { int tok = moe_tok(perm, un, R); tok = tok < 0 ? 0 : tok; return (unsigned)(tok * 1024 + C) * 2u; }
    DI size_t a_hstep() const { return 0; }
    DI size_t a_kstep() const { return 128; }
    DI int kdim() const { return 1024; }
    DI void epi_begin(const Unit& un, int rbase, Ctx& c) const {
        const int slot = un.n0 >> 9; int tk[8];
#pragma unroll
        for (int rg = 0; rg < 8; ++rg) tk[rg] = moe_tok(perm, un, rg_row(rg, rbase));
#pragma unroll
        for (int rg = 0; rg < 8; ++rg) { const int t = tk[rg] < 0 ? 0 : tk[rg]; c.rs[rg] = rstd2[t]; c.wg[rg] = rw[t * 2 + slot]; }
    }
    DI f32x4 swiglu4(f32x4 g, f32x4 u, float s, float w) const { g = g * s; u = u * s; return g * sig4(g) * u * w; }
    DI void epi_val(const Unit&, const Ctx& c, int rg, f32x4 v00, f32x4 v01, f32x4 v10, f32x4 v11, u32x4& o0, u32x4& o1) const {
        o0 = pack8(swiglu4(v00, v10, c.rs[rg], c.wg[rg]), swiglu4(v01, v11, c.rs[rg], c.wg[rg])); o1 = o0;
    }
    DI void epi_copy(const Unit& un, const Ctx&, const PG_LAS u16* T, int tid) const {
        const int slot = un.n0 >> 9, uu = (un.n0 >> 8) & 1;
#pragma unroll
        for (int it = 0; it < 8; ++it) {
            const int id = it * NTHR + tid, r = id >> 4, c = (id & 15) * 8;
            st16_sc1(ACT + (size_t)(un.m0 + r) * 512 + slot * 256 + uu * 128 + c, *(const PG_LAS u32x4*)(T + r * ST16H + c));
        }
    }
};

struct JobMoeDown {
    typedef UnitMoe Unit; static constexpr bool GATHER = false; static constexpr int SMODE = 1, NCOL = 256, EREP = 1;
    struct Ctx { int tk[16]; };
    const char* ACT; const char* WDN; const int* perm; const PG_LAS int* tb; u16* XB; float* OUT; float* ssq4; int last;
    DI int num_units() const { return (__builtin_amdgcn_readfirstlane(tb[24]) / TM) * 4; }
    DI Unit unit(int u) const { Unit x; moe_unit(tb, u, x); x.e0 = 0; x.e1 = 0; return x; }
    DI const char* a_base(const Unit& un) const { return ACT + (size_t)un.m0 * 1024; }
    DI const char* b_base(const Unit& un) const { return WDN + (size_t)(un.pr * 1024 + un.n0) * 1024; }
    DI unsigned a_off(const Unit&, int R, int C) const { return (unsigned)(R * 512 + C) * 2u; }
    DI size_t a_hstep() const { return 128 * 1024; }
    DI size_t a_kstep() const { return 128; }
    DI int kdim() const { return 512; }
    DI void epi_begin(const Unit& un, int, Ctx& c) const {
        const int tid = TID();
#pragma unroll
        for (int q = 0; q < 16; ++q) { const int ps = q >> 2, it = q & 3, r0 = (ps >> 1) * 128 + (ps & 1) * 64, id = it * NTHR + tid, r = id >> 5; c.tk[q] = moe_tok(perm, un, r0 + r); }
    }
    struct Pre { u32x4 xv[4]; };
    DI void epi_load(const Unit& un, const Ctx& cx, int ps, int tid, Pre& p) const {
#pragma unroll
        for (int it = 0; it < 4; ++it) { const int id = it * NTHR + tid, c = (id & 31) * 8, t = cx.tk[ps * 4 + it] < 0 ? 0 : cx.tk[ps * 4 + it]; p.xv[it] = *(const u32x4*)(XB + (size_t)t * 1024 + un.n0 + c); }
    }
    DI void epi_copy(const Unit& un, const Ctx& cx, const PG_LAS float* T, int ps, int tid, const Pre& p) const {
        const int lane = tid & 63;
#pragma unroll
        for (int it = 0; it < 4; ++it) {
            const int id = it * NTHR + tid, r = id >> 5, c = (id & 31) * 8, tk = cx.tk[ps * 4 + it];
            const f32x4 a = unp_lo(p.xv[it]) + *(const PG_LAS f32x4*)(T + r * ST32 + c), b = unp_hi(p.xv[it]) + *(const PG_LAS f32x4*)(T + r * ST32 + c + 4);
            if (last) {
                if (tk >= 0) { float* o = OUT + (size_t)tk * 1024 + un.n0 + c; *(f32x4*)o = a; *(f32x4*)(o + 4) = b; }
            } else {
                const u32x4 q = pack8(a, b);
                if (tk >= 0) *(u32x4*)(XB + (size_t)tk * 1024 + un.n0 + c) = q;
                const f32x4 ra = unp_lo(q), rb = unp_hi(q);
                float ss = ra.x * ra.x + ra.y * ra.y + ra.z * ra.z + ra.w * ra.w + rb.x * rb.x + rb.y * rb.y + rb.z * rb.z + rb.w * rb.w;
                ss += shx(ss, 1, lane); ss += shx(ss, 2, lane); ss += shx(ss, 4, lane); ss += shx(ss, 8, lane); ss += shx(ss, 16, lane);
                if ((lane & 31) == 0 && tk >= 0) ssq4[(size_t)tk * 4 + (un.n0 >> 8)] = ss;
            }
        }
    }
};

DI void phase_scan(const Params& p) {
    const float* Sloc = (const float*)(opq(p.ws) + OFF_SLOC);
    const float* LT = (const float*)(opq(p.ws) + OFF_LT);
    u16* A2 = (u16*)(opq(p.ws) + OFF_A2);
    for (int idx = BID() * NTHR + TID(); idx < 32 * NBATCH * 64; idx += gridDim.x * NTHR) {
        const int pp = idx & 63, b = (idx >> 6) & 15, g = idx >> 10;
        const float ar = LT[(g * 64 + pp) * 2], ai = LT[(g * 64 + pp) * 2 + 1];
        float sr = 0.f, si = 0.f;
        const size_t r0 = (size_t)g * S5M + b * NCH;
#pragma unroll 8
        for (int c = 0; c < NCH; ++c) {
            *(unsigned*)(A2 + (r0 + c) * S5K2 + S5K1 + 2 * pp) = pk2(sr, si);
            const f32x2 l = *(const f32x2*)(Sloc + (r0 + c) * 128 + 2 * pp);
            const float nr = ar * sr - ai * si + l.x, ni = ar * si + ai * sr + l.y;
            sr = nr; si = ni;
        }
    }
}

DI void scan_local(const Params& p, int g, int b0) {
    asm volatile("s_waitcnt vmcnt(0)" ::: "memory");
    __syncthreads();
    const float* Sloc = (const float*)(opq(p.ws) + OFF_SLOC);
    const float* LT = (const float*)(opq(p.ws) + OFF_LT);
    u16* A2 = (u16*)(opq(p.ws) + OFF_A2);
    const int tid = TID();
    if (tid < 256) {
        const int pp = tid & 63, b = b0 + (tid >> 6);
        const float ar = LT[(g * 64 + pp) * 2], ai = LT[(g * 64 + pp) * 2 + 1];
        float sr = 0.f, si = 0.f;
        const size_t r0 = (size_t)g * S5M + b * NCH;
        f32x2 l[NCH];
#pragma unroll
        for (int c = 0; c < NCH; ++c) l[c] = __builtin_nontemporal_load((const f32x2*)(Sloc + (r0 + c) * 128 + 2 * pp));
#pragma unroll
        for (int c = 0; c < NCH; ++c) {
            *(unsigned*)(A2 + (r0 + c) * S5K2 + S5K1 + 2 * pp) = pk2(sr, si);
            const float nr = ar * sr - ai * si + l[c].x, ni = ar * si + ai * sr + l[c].y;
            sr = nr; si = ni;
        }
    }
}

constexpr int PREP0_FIRST = 257 + T_WIN / 4, PREP0_PER_UNIT = 3;
DI void phase_attn(const Params& p, const int L, char* lds) {
    u16* Ks = (u16*)lds;
    u16* Vt = Ks + 256 * 72;
    int* qslot = (int*)(lds + 70400);
    const u16* Qg = (const u16*)(opq(p.ws) + OFF_Q);
    const u16* KVg = (const u16*)(opq(p.ws) + OFF_KV);
    u16* YA = (u16*)(opq(p.ws) + OFF_YA);
    unsigned* qctr = (unsigned*)(opq(p.ws) + OFF_BAR) + 8 + L;
    const float* qn = opq(p.in[13]) + L * 64; const float* kn = opq(p.in[14]) + L * 64; const float* sinks = opq(p.in[15]) + L * 8;
    const int tid = TID(), lane = tid & 63, w = tid >> 6, r = lane & 31, hh = lane >> 5;
    constexpr float L2E = 1.4426950408889634f;
    for (;;) {
        if (tid == 0) *qslot = (int)__hip_atomic_fetch_add(qctr, 1u, __ATOMIC_RELAXED, __HIP_MEMORY_SCOPE_AGENT);
        __syncthreads();
        const int u = *qslot;
        if (u >= NBATCH * 16 * 2) break;
        const int kvh = u & 1, nb = (u >> 1) & 15, b = u >> 5;
        const int tok0 = b * SEQ + nb * 128;
        const int gq = w >> 1, h = kvh * 4 + gq, qhalf = w & 1;
        u32x4 qn_[4];
#pragma unroll
        for (int s = 0; s < 4; ++s) qn_[s] = *(const u32x4*)(Qg + (size_t)(tok0 + qhalf * 64 + r) * 512 + h * 64 + 16 * s + 8 * hh);
#pragma unroll
        for (int i = 0; i < 4; ++i) {
            const int pc = tid + 512 * i, key = pc >> 3, dc = pc & 7;
            const bool valid = (nb > 0) || (key >= 128);
            u32x4 kr = {0u, 0u, 0u, 0u}, vr = {0u, 0u, 0u, 0u};
            if (valid) { const u16* src = KVg + (size_t)(tok0 - 128 + key) * 256 + kvh * 64 + dc * 8; kr = *(const u32x4*)src; vr = *(const u32x4*)(src + 128); }
            float kf[8];
            kf[0] = bf_lo(kr.x); kf[1] = bf_hi(kr.x); kf[2] = bf_lo(kr.y); kf[3] = bf_hi(kr.y); kf[4] = bf_lo(kr.z); kf[5] = bf_hi(kr.z); kf[6] = bf_lo(kr.w); kf[7] = bf_hi(kr.w);
            float ss = 0.f;
#pragma unroll
            for (int e = 0; e < 8; ++e) ss += kf[e] * kf[e];
            ss += shx(ss, 1, lane); ss += shx(ss, 2, lane); ss += shx(ss, 4, lane);
            const float rs = rsqrtf(ss * (1.0f / 64.0f) + 1e-6f);
            const f32x4 g0 = *(const f32x4*)(kn + dc * 8), g1 = *(const f32x4*)(kn + dc * 8 + 4);
            u32x4 ko;
            ko.x = pk2(kf[0] * rs * g0.x, kf[1] * rs * g0.y); ko.y = pk2(kf[2] * rs * g0.z, kf[3] * rs * g0.w);
            ko.z = pk2(kf[4] * rs * g1.x, kf[5] * rs * g1.y); ko.w = pk2(kf[6] * rs * g1.z, kf[7] * rs * g1.w);
            *(u32x4*)(Ks + key * 72 + dc * 8) = ko;
            u16* vd = Vt + (dc * 8) * 260 + key;
            vd[0 * 260] = (u16)(vr.x & 0xffff); vd[1 * 260] = (u16)(vr.x >> 16); vd[2 * 260] = (u16)(vr.y & 0xffff); vd[3 * 260] = (u16)(vr.y >> 16);
            vd[4 * 260] = (u16)(vr.z & 0xffff); vd[5 * 260] = (u16)(vr.z >> 16); vd[6 * 260] = (u16)(vr.w & 0xffff); vd[7 * 260] = (u16)(vr.w >> 16);
        }
        __syncthreads();
        const float slope2 = exp2f(-(float)(h + 1)) * L2E, sink2 = sinks[h] * L2E;
#pragma unroll 1
        for (int qt = 0; qt < 2; ++qt) {
            const int i0 = qhalf * 64 + qt * 32;
            const int qtok = tok0 + i0 + r;
            bf16x8 qf[4];
            {
                u32x4 qr[4]; float ss = 0.f;
#pragma unroll
                for (int s = 0; s < 4; ++s) qr[s] = qn_[s];
                if (qt == 0) {
#pragma unroll
                    for (int s = 0; s < 4; ++s) qn_[s] = *(const u32x4*)(Qg + (size_t)(qtok + 32) * 512 + h * 64 + 16 * s + 8 * hh);
                }
#pragma unroll
                for (int s = 0; s < 4; ++s) {
                    const float a0 = bf_lo(qr[s].x), a1 = bf_hi(qr[s].x), a2 = bf_lo(qr[s].y), a3 = bf_hi(qr[s].y), a4 = bf_lo(qr[s].z), a5 = bf_hi(qr[s].z), a6 = bf_lo(qr[s].w), a7 = bf_hi(qr[s].w);
                    ss += a0 * a0 + a1 * a1 + a2 * a2 + a3 * a3 + a4 * a4 + a5 * a5 + a6 * a6 + a7 * a7;
                }
                ss += shx(ss, 32, lane);
                const float rs = rsqrtf(ss * (1.0f / 64.0f) + 1e-6f) * (0.125f * L2E);
#pragma unroll
                for (int s = 0; s < 4; ++s) {
                    const f32x4 g0 = *(const f32x4*)(qn + 16 * s + 8 * hh), g1 = *(const f32x4*)(qn + 16 * s + 8 * hh + 4);
                    u32x4 o;
                    o.x = pk2(bf_lo(qr[s].x) * rs * g0.x, bf_hi(qr[s].x) * rs * g0.y); o.y = pk2(bf_lo(qr[s].y) * rs * g0.z, bf_hi(qr[s].y) * rs * g0.w);
                    o.z = pk2(bf_lo(qr[s].z) * rs * g1.x, bf_hi(qr[s].z) * rs * g1.y); o.w = pk2(bf_lo(qr[s].w) * rs * g1.z, bf_hi(qr[s].w) * rs * g1.w);
                    qf[s] = __builtin_bit_cast(bf16x8, o);
                }
            }
            const int kt0 = i0 >> 5;
            const int qi = i0 + r;
            const int dbase = qi + 128 - kt0 * 32 - 4 * hh;
            const int maxd = nb > 0 ? 127 : (qi < 127 ? qi : 127);
            const float A = -slope2 * (float)dbase;
            f32x16 o[2];
#pragma unroll
            for (int db = 0; db < 2; ++db)
#pragma unroll
                for (int e = 0; e < 16; ++e) o[db][e] = 0.f;
            float m = sink2, l = 0.f;
#pragma unroll
            for (int kr2 = 0; kr2 < 5; ++kr2) {
                const int kt = 4 - kr2;
                if (nb == 0 && kt0 + kt < 4) continue;
                f32x16 sc;
#pragma unroll
                for (int e = 0; e < 16; ++e) sc[e] = 0.f;
#pragma unroll
                for (int s = 0; s < 4; ++s) {
                    const bf16x8 kfr = *(const bf16x8*)(Ks + ((kt0 + kt) * 32 + r) * 72 + 16 * s + 8 * hh);
                    sc = mfma32(kfr, qf[s], sc);
                }
                float tm = -1e30f;
#pragma unroll
                for (int e = 0; e < 16; ++e) {
                    const int ce = 32 * kt + (e & 3) + 8 * (e >> 2);
                    float t = fmaf(slope2, (float)ce, sc[e]);
                    if (kt == 0 || kt == 4) { const int dist = dbase - ce; t = ((unsigned)dist <= (unsigned)maxd) ? t : -1e30f; }
                    sc[e] = t; tm = fmaxf(tm, t);
                }
                tm += A;
                tm = fmaxf(tm, shx(tm, 32, lane));
                if (__ballot(tm > m) != 0ull) {
                    const float mn = fmaxf(m, tm), alpha = __builtin_amdgcn_exp2f(m - mn);
                    m = mn; l *= alpha;
#pragma unroll
                    for (int db = 0; db < 2; ++db)
#pragma unroll
                        for (int e = 0; e < 16; ++e) o[db][e] *= alpha;
                }
                const float c0 = A - m;
                float ls = 0.f;
#pragma unroll
                for (int e = 0; e < 16; ++e) { const float pv = __builtin_amdgcn_exp2f(sc[e] + c0); sc[e] = pv; ls += pv; }
                l += ls;
#pragma unroll
                for (int s2 = 0; s2 < 2; ++s2) {
                    u32x4 pp;
                    pp.x = pk2(sc[8 * s2 + 0], sc[8 * s2 + 1]); pp.y = pk2(sc[8 * s2 + 2], sc[8 * s2 + 3]);
                    pp.z = pk2(sc[8 * s2 + 4], sc[8 * s2 + 5]); pp.w = pk2(sc[8 * s2 + 6], sc[8 * s2 + 7]);
                    const bf16x8 pf = __builtin_bit_cast(bf16x8, pp);
                    const int kb = (kt0 + kt) * 32 + 16 * s2 + 4 * hh;
#pragma unroll
                    for (int db = 0; db < 2; ++db) {
                        const u16* vp = Vt + (db * 32 + r) * 260 + kb;
                        const s16x4 lo = *(const s16x4*)vp, hi = *(const s16x4*)(vp + 8);
                        const bf16x8 vf = __builtin_shufflevector(lo, hi, 0, 1, 2, 3, 4, 5, 6, 7);
                        o[db] = mfma32(vf, pf, o[db]);
                    }
                }
                asm volatile("" ::: "memory");
            }
            l += shx(l, 32, lane);
            l += __builtin_amdgcn_exp2f(sink2 - m);
            const float inv = __builtin_amdgcn_rcpf(l);
#pragma unroll
            for (int db = 0; db < 2; ++db)
#pragma unroll
                for (int q4 = 0; q4 < 4; ++q4) {
                    const int d = db * 32 + 8 * q4 + 4 * hh;
                    u32x2 ov; ov.x = pk2(o[db][4 * q4] * inv, o[db][4 * q4 + 1] * inv); ov.y = pk2(o[db][4 * q4 + 2] * inv, o[db][4 * q4 + 3] * inv);
                    *(u32x2*)(YA + (size_t)qtok * 512 + h * 64 + d) = ov;
                }
        }
        __syncthreads();
        if (L == 0) prep_from_queue(p, lds, PREP0_PER_UNIT, 0, PREP0_FIRST);
    }
    if (L == 0) prep_from_queue(p, lds, 1 << 30, 0, PREP0_FIRST);
}

DI void route_token(const float (&lg)[20], int& bucket, float& w0, float& w1) {
    int gi = 0; float gm = lg[0];
#pragma unroll
    for (int j = 1; j < 4; ++j) if (lg[j] > gm) { gm = lg[j]; gi = j; }
    float den = 0.f;
#pragma unroll
    for (int j = 0; j < 4; ++j) den += __expf(lg[j] - gm);
    const float gp = 1.0f / den;
    float f[4];
#pragma unroll
    for (int j = 0; j < 4; ++j) f[j] = gi == 0 ? lg[4 + j] : (gi == 1 ? lg[8 + j] : (gi == 2 ? lg[12 + j] : lg[16 + j]));
    int i1 = 0; float v1 = f[0];
#pragma unroll
    for (int j = 1; j < 4; ++j) if (f[j] > v1) { v1 = f[j]; i1 = j; }
    int i2 = -1; float v2 = -3.0e38f;
#pragma unroll
    for (int j = 0; j < 4; ++j) if (j != i1 && f[j] > v2) { v2 = f[j]; i2 = j; }
    const float e2 = __expf(v2 - v1);
    const float p1 = gp / (1.0f + e2), p2 = gp * e2 / (1.0f + e2);
    const int a = i1 < i2 ? i1 : i2, b = i1 < i2 ? i2 : i1;
    const int pidx = a == 0 ? b - 1 : (a == 1 ? b + 1 : 5);
    bucket = gi * 6 + pidx;
    w0 = i1 < i2 ? p1 : p2; w1 = i1 < i2 ? p2 : p1;
}

constexpr int RW_ROW = 1024 + 8;
DI void phase_router(const Params& p, const int L, char* lds) {
    u16* Wh = (u16*)lds;
    u16* Wl = Wh + 21 * RW_ROW;
    float* lgs = (float*)(Wl + 21 * RW_ROW);
    int* hist = (int*)(lgs + 8 * 16 * 24);
    const u32x4* WRI = (const u32x4*)(opq(p.ws) + OFF_WR);
    const u16* X = (const u16*)(opq(p.ws) + OFF_R1);
    float* rstd2 = (float*)(opq(p.ws) + OFF_RSTD2);
    int* perm2 = (int*)(opq(p.ws) + OFF_PERM2);
    float* rw = (float*)(opq(p.ws) + OFF_RW);
    unsigned* gcnt = (unsigned*)(opq(p.ws) + OFF_MOEQ) + L * 256 + 16;
    const int tid = TID(), lane = tid & 63, w = tid >> 6, fr = lane & 15, fq = lane >> 4;
    if (BID() >= 256) return;
    for (int i = tid; i < 42 * 128; i += NTHR) { const int row = i >> 7, ch = i & 127; *(u32x4*)(Wh + row * RW_ROW + ch * 8) = WRI[i]; }
    for (int rb = BID(); rb < 256; rb += gridDim.x) {
        if (tid < 24) hist[tid] = 0;
        __syncthreads();
        const int tok = rb * 128 + w * 16 + fr;
        const u16* xr = X + (size_t)tok * DM + 8 * fq;
        const int n1 = fr < 4 ? 16 + fr : 20;
        f32x4 a0 = {0.f, 0.f, 0.f, 0.f}, a1 = {0.f, 0.f, 0.f, 0.f};
        float ssq = 0.f;
        u32x4 xq[2][8];
#pragma unroll
        for (int s = 0; s < 8; ++s) xq[0][s] = *(const u32x4*)(xr + s * 32);
#pragma unroll
        for (int kc = 0; kc < 4; ++kc) {
            u32x4 (&xa)[8] = xq[kc & 1];
            if (kc < 3) {
#pragma unroll
                for (int s = 0; s < 8; ++s) xq[(kc + 1) & 1][s] = *(const u32x4*)(xr + ((kc + 1) * 8 + s) * 32);
            }
#pragma unroll
            for (int s = 0; s < 8; ++s) {
                const int ks = kc * 8 + s;
                const f32x4 va = unp_lo(xa[s]), vb = unp_hi(xa[s]);
                ssq += va.x * va.x + va.y * va.y + va.z * va.z + va.w * va.w + vb.x * vb.x + vb.y * vb.y + vb.z * vb.z + vb.w * vb.w;
                const bf16x8 xh = __builtin_bit_cast(bf16x8, xa[s]);
                const bf16x8 wh0 = *(const bf16x8*)(Wh + fr * RW_ROW + ks * 32 + fq * 8), wl0 = *(const bf16x8*)(Wl + fr * RW_ROW + ks * 32 + fq * 8);
                const bf16x8 wh1 = *(const bf16x8*)(Wh + n1 * RW_ROW + ks * 32 + fq * 8), wl1 = *(const bf16x8*)(Wl + n1 * RW_ROW + ks * 32 + fq * 8);
                a0 = mfma16(wh0, xh, a0); a0 = mfma16(wl0, xh, a0);
                a1 = mfma16(wh1, xh, a1); a1 = mfma16(wl1, xh, a1);
            }
        }
        ssq += shx(ssq, 16, lane); ssq += shx(ssq, 32, lane);
        float* lg = lgs + (w * 16 + fr) * 24;
        *(f32x4*)(lg + 4 * fq) = a0;
        if (fq == 0) *(f32x4*)(lg + 16) = a1;
        __syncthreads();
        int mybk = 0, myrank = 0;
        if (lane < 16) {
            const float rs = rsqrtf(ssq * (1.0f / DM) + 1e-6f);
            float l20[20];
#pragma unroll
            for (int n = 0; n < 20; ++n) l20[n] = lg[n] * rs;
            int bk; float w0, w1;
            route_token(l20, bk, w0, w1);
            rstd2[tok] = rs; rw[tok * 2] = w0; rw[tok * 2 + 1] = w1;
            mybk = bk; myrank = atomicAdd(&hist[bk], 1);
        }
        __syncthreads();
        if (tid < 24) { const int c = hist[tid]; hist[32 + tid] = c > 0 ? (int)__hip_atomic_fetch_add(gcnt + tid, (unsigned)c, __ATOMIC_RELAXED, __HIP_MEMORY_SCOPE_AGENT) : 0; }
        __syncthreads();
        if (lane < 16) perm2[(size_t)mybk * 32768 + hist[32 + mybk] + myrank] = tok;
        __syncthreads();
    }
}

template <int MODE> DI JobInProjT<MODE> mk_inproj(const Params& p, const int L) { JobInProjT<MODE> j; char* w = opq(p.ws); j.A = w + OFF_R1; j.B = w + (size_t)L * WSET + OFF_WIN; j.ssq4 = (const float*)(w + OFF_SSQ4); j.A2 = (u16*)(w + OFF_A2); j.ws = w; return j; }
DI JobS5G1 mk_g1(const Params& p, const int L) { JobS5G1 j; j.A2 = opq(p.ws) + OFF_A2; j.W1 = opq(p.ws) + (size_t)L * WSET + OFF_W1T; j.Sloc = (float*)(opq(p.ws) + OFF_SLOC); return j; }
DI JobS5G2 mk_g2(const Params& p, const int L) { JobS5G2 j; j.A2 = opq(p.ws) + OFF_A2; j.W2 = opq(p.ws) + (size_t)L * WSET + OFF_W2T; j.Zp = (u16*)(opq(p.ws) + OFF_Z); return j; }
DI JobGLU mk_glu(const Params& p, const int L) { JobGLU j; j.Zp = opq(p.ws) + OFF_Z; j.B = opq(p.ws) + (size_t)L * WSET + OFF_WGLU; j.SGS = (const unsigned char*)(opq(p.ws) + OFF_SGS8); j.PA = (const u16*)(opq(p.ws) + pa_off(L)); j.MS = (u16*)(opq(p.ws) + OFF_R2); return j; }
DI JobAttnUp mk_attnup(const Params& p, const int L) { JobAttnUp j; j.A = opq(p.ws) + OFF_YA; j.B = opq(p.ws) + (size_t)L * WSET + OFF_WATT; j.SGA = (const unsigned char*)(opq(p.ws) + OFF_SGA8); j.PA = (u16*)(opq(p.ws) + pa_off(L)); return j; }
DI JobOut mk_out(const Params& p, const int L) { JobOut j; j.A = opq(p.ws) + OFF_R2; j.B = opq(p.ws) + (size_t)L * WSET + OFF_WOUT; j.XB = (u16*)(opq(p.ws) + OFF_R1); return j; }
DI JobMoeUp mk_moeup(const Params& p, const int L, char* lds) { JobMoeUp j; j.tb = (const PG_LAS int*)((PG_LAS char*)lds + MOE_TB_OFF); j.XB2 = opq(p.ws) + OFF_R1; j.WUP = opq(p.ws) + (size_t)L * WSET + OFF_WUP; j.perm = (const int*)(opq(p.ws) + OFF_PERM2); j.rstd2 = (const float*)(opq(p.ws) + OFF_RSTD2); j.rw = (const float*)(opq(p.ws) + OFF_RW); j.ACT = (u16*)(opq(p.ws) + OFF_R3); return j; }
DI JobMoeDown mk_moedown(const Params& p, const int L, char* lds) { JobMoeDown j; j.tb = (const PG_LAS int*)((PG_LAS char*)lds + MOE_TB_OFF); j.ACT = opq(p.ws) + OFF_R3; j.WDN = opq(p.ws) + (size_t)L * WSET + OFF_WDN; j.perm = (const int*)(opq(p.ws) + OFF_PERM2); j.XB = (u16*)(opq(p.ws) + OFF_R1); j.OUT = opq(p.out); j.ssq4 = (float*)(opq(p.ws) + OFF_SSQ4); j.last = L == 1; return j; }


#define XB_TMO      128
#define XB_XCNT(j)  (256  + 64 * (j))
#define XB_XSUB(j)  (1280 + 64 * (j))
#define XB_XGEN(j)  (2304 + 64 * (j))
#define XB_TOP      3328
#define XB_TOPGEN   3392
#define XB_SPIN_CAP (1u << 18)
DI unsigned xb_ld(unsigned* p)              { return __hip_atomic_load(p, __ATOMIC_RELAXED, __HIP_MEMORY_SCOPE_AGENT); }
DI unsigned xb_add(unsigned* p, unsigned v) { return __hip_atomic_fetch_add(p, v, __ATOMIC_RELAXED, __HIP_MEMORY_SCOPE_AGENT); }
DI unsigned xb_xcc_id() { return (unsigned)__builtin_amdgcn_s_getreg((3 << 11) | 20) & 0xFu; }
#define XB_SPIN(cond, bar) do { unsigned _sp = 0; while (cond) { __builtin_amdgcn_s_sleep(1); \
    if ((++_sp & 255u) == 0u) { if (xb_ld(&(bar)[XB_TMO])) break; if (_sp > XB_SPIN_CAP) { atomicAdd(&(bar)[XB_TMO], 1u); break; } } } } while (0)
struct XcdBarrier { unsigned* bar; unsigned x; volatile PG_LAS unsigned* st; };
DI XcdBarrier xcd_barrier_post(unsigned* bar, volatile PG_LAS unsigned* st) {
    XcdBarrier b; b.bar = bar; b.x = xb_xcc_id(); b.st = st;
    if (threadIdx.x == 0) (void)xb_add(&bar[XB_XCNT(b.x)], 1u);
    return b;
}
DI void xcd_barrier_complete(unsigned* bar, unsigned x, unsigned& nloc, unsigned& nx) {
    const unsigned G = gridDim.x * gridDim.y * gridDim.z;
    unsigned sum, cnt, mine, sp = 0u;
    for (;;) {
        sum = 0u; cnt = 0u; mine = 0u;
#pragma unroll
        for (unsigned j = 0; j < 16; ++j) { const unsigned c = xb_ld(&bar[XB_XCNT(j)]); sum += c; cnt += (c > 0u) ? 1u : 0u; mine = (j == x) ? c : mine; }
        if (sum == G) break;
        __builtin_amdgcn_s_sleep(1);
        if ((++sp & 255u) == 0u) { if (xb_ld(&bar[XB_TMO])) break; if (sp > XB_SPIN_CAP) { atomicAdd(&bar[XB_TMO], 1u); break; } }
    }
    nloc = mine > 0u ? mine : 1u; nx = cnt > 0u ? cnt : 1u;
}
DI void xcd_barrier(const XcdBarrier& b) {
    asm volatile("s_waitcnt vmcnt(0)" ::: "memory");
    __syncthreads();
    if (threadIdx.x == 0) {
        unsigned* bar = opq(b.bar);
        __builtin_amdgcn_s_waitcnt(0);
        asm volatile("buffer_inv sc1" ::: "memory");
        unsigned nloc = b.st[0], nx = b.st[1];
        if (nloc == 0u) { xcd_barrier_complete(bar, b.x, nloc, nx); b.st[0] = nloc; b.st[1] = nx; }
        const unsigned old = xb_add(&bar[XB_XSUB(b.x)], 1u);
        const unsigned gen = old / nloc;
        if (old + 1u == (gen + 1u) * nloc) {
            __builtin_amdgcn_fence(__ATOMIC_RELEASE, "agent");
            asm volatile("s_waitcnt vmcnt(0)" ::: "memory");
            const unsigned og = xb_add(&bar[XB_TOP], 1u);
            const unsigned tg = og / nx;
            if (og + 1u == (tg + 1u) * nx) xb_add(&bar[XB_TOPGEN], 1u);
            else XB_SPIN(xb_ld(&bar[XB_TOPGEN]) == tg, bar);
            asm volatile("s_waitcnt vmcnt(0)" ::: "memory");
        } else {
            XB_SPIN(xb_ld(&bar[XB_TOPGEN]) == gen, bar);
            asm volatile("s_waitcnt vmcnt(0)" ::: "memory");
        }
    }
    __syncthreads();
}


DI void phase_moe(const Params& p, const int L, char* lds) {
    unsigned* q = (unsigned*)(opq(p.ws) + OFF_MOEQ) + L * 256;
    unsigned* flag = q + 64;
    int* qslot = (int*)(lds + 163840 - 128);
    {
        PG_LAS int* tb = (PG_LAS int*)((PG_LAS char*)lds + MOE_TB_OFF);
        const int t24 = TID();
        if (t24 < 24) tb[32 + t24] = (int)__hip_atomic_load(q + 16 + t24, __ATOMIC_RELAXED, __HIP_MEMORY_SCOPE_AGENT);
        __syncthreads();
        if (threadIdx.x == 0) { int b = 0; for (int t = 0; t < 24; ++t) { tb[t] = b; b += ((tb[32 + t] + TM - 1) / TM) * TM; } tb[24] = b; }
        __syncthreads();
    }
    const JobMoeUp ju = mk_moeup(p, L, lds);
    const JobMoeDown jd = mk_moedown(p, L, lds);
    const int tiles = ju.num_units() >> 2, per = (tiles + 7) >> 3;
    const int myx = (int)((unsigned)__builtin_amdgcn_s_getreg((3 << 11) | 20) & 7u);
    int probe = 0, prev = -1;
    for (;;) {
        asm volatile("s_waitcnt vmcnt(0)" ::: "memory");
        __syncthreads();
        if (threadIdx.x == 0) {
            if (prev >= 0) (void)__hip_atomic_fetch_add(flag + prev, 1u, __ATOMIC_RELAXED, __HIP_MEMORY_SCOPE_AGENT);
            int r = -1;
            while (probe < 8) {
                const int x = (myx + probe) & 7, t0 = x * per;
                int ntx = tiles - t0; ntx = ntx > per ? per : ntx;
                if (ntx > 0) {
                    const int k = (int)__hip_atomic_fetch_add(q + 8 + x, 1u, __ATOMIC_RELAXED, __HIP_MEMORY_SCOPE_AGENT);
                    if (k < 8 * ntx) { r = k < 4 * ntx ? t0 * 4 + k : ((1 << 20) | (t0 * 4 + k - 4 * ntx)); break; }
                }
                ++probe;
            }
            *qslot = r;
        }
        __syncthreads();
        const int r = __builtin_amdgcn_readfirstlane(*qslot);
        __syncthreads();
        if (r < 0) break;
        if (r < (1 << 20)) {
            pg_gemm_seq(ju, lds, r, 1 << 30, r + 1);
            prev = r >> 2;
        } else {
            const int d = r & 0xfffff;
            prev = -1;
            if (__builtin_amdgcn_readfirstlane((int)threadIdx.x >> 6) == 0) {
                unsigned sp = 0;
                while ((unsigned)__builtin_amdgcn_readfirstlane((int)__hip_atomic_load(flag + (d >> 2), __ATOMIC_RELAXED, __HIP_MEMORY_SCOPE_AGENT)) < 4u) { __builtin_amdgcn_s_sleep(2); if (++sp > (1u << 16)) break; }
                __builtin_amdgcn_fence(__ATOMIC_ACQUIRE, "agent");
                asm volatile("s_waitcnt vmcnt(0)" ::: "memory");
            }
            __syncthreads();
            pg_gemm_seq(jd, lds, d, 1 << 30, d + 1);
        }
    }
}

extern __shared__ __attribute__((aligned(16))) char smem[];
namespace cg = cooperative_groups;
constexpr int MEGA_LDS = 163840;
constexpr size_t WS_NEED = OFF_BAR + CTL_BYTES;
__global__ void __launch_bounds__(NTHR) k_mega(const Params p) {
    cg::grid_group grid = cg::this_grid();
    volatile PG_LAS unsigned* st = (volatile PG_LAS unsigned*)((PG_LAS unsigned char*)smem + 163840 - 64);
    if (threadIdx.x < 4) st[threadIdx.x] = 0u;
    __syncthreads();
    const XcdBarrier xb = xcd_barrier_post((unsigned*)(opq(p.ws) + OFF_BAR), st);
#define GSYNC() xcd_barrier(xb)
    for (int L = 0; L < 2; ++L) {
        if (L == 0) {
            for (int rep = 0; rep < REP_PREP; ++rep) phase_prep(p, 0, smem);
            for (int rep = 0; rep < REP_XB; ++rep) phase_xb(p);
            if (p.ws == nullptr) grid.sync();
            GSYNC();
        }
        for (int rep = 0; rep < REP_INPROJ; ++rep) pg_gemm(mk_inproj<0>(p, L), smem);
        GSYNC();
        pg_gemm(mk_g1(p, L), smem);
        if (BID() < 128) { const UnitG ug = mk_g1(p, L).unit(BID()); scan_local(p, ug.g, ug.m0 >> 6); }
        if (BID() >= 128) pg_gemm(mk_inproj<1>(p, L), smem);
        for (int rep = 0; rep < REP_ATTN; ++rep) phase_attn(p, L, smem);
        GSYNC();
        for (int rep = 0; rep < REP_G2; ++rep) pg_gemm(mk_g2(p, L), smem);
        pg_gemm(mk_attnup(p, L), smem);
        GSYNC();
        for (int rep = 0; rep < REP_GLU; ++rep) pg_gemm(mk_glu(p, L), smem);
        GSYNC();
        for (int rep = 0; rep < (L == 0 ? REP_OUT0 : 1); ++rep) pg_gemm(mk_out(p, L), smem);
        GSYNC();
        for (int rep = 0; rep < REP_ROUTER; ++rep) phase_router(p, L, smem);
        GSYNC();
        phase_moe(p, L, smem);
        if (L == 0) { prep_from_queue(p, smem, 1 << 30, 1, 0); GSYNC(); }
    }
#undef GSYNC
}

extern "C" void kernel_launch(void* const* d_in, const int* in_sizes, int n_in, void* d_out, int out_size, void* d_ws, size_t ws_size, hipStream_t stream) {
    static int grid_blocks = 0;
    if (!grid_blocks) {
        int dev = 0, cus = 0, per_cu = 0;
        (void)hipGetDevice(&dev);
        (void)hipDeviceGetAttribute(&cus, hipDeviceAttributeMultiprocessorCount, dev);
        (void)hipFuncSetAttribute((const void*)k_mega, hipFuncAttributeMaxDynamicSharedMemorySize, MEGA_LDS);
        (void)hipOccupancyMaxActiveBlocksPerMultiprocessor(&per_cu, (const void*)k_mega, NTHR, MEGA_LDS);
        if (per_cu < 1) per_cu = 1;
        if (per_cu > 1) per_cu = 1;
        grid_blocks = cus * per_cu;
    }
    if (n_in != 23 || ws_size < WS_NEED || out_size != NTOK * DM) { fprintf(stderr, "kernel_launch: unexpected shapes (n_in %d ws %zu out %d)\n", n_in, ws_size, out_size); return; }
    Params p{};
    for (int i = 0; i < 23; ++i) p.in[i] = (const float*)d_in[i];
    p.out = (float*)d_out; p.ws = (char*)d_ws;
    (void)hipMemsetAsync((char*)d_ws + OFF_BAR, 0, CTL_BYTES, stream);
    void* args[] = {&p};
    hipError_t e = hipLaunchCooperativeKernel((const void*)k_mega, dim3(grid_blocks), dim3(NTHR), args, MEGA_LDS, stream);
    if (e != hipSuccess) fprintf(stderr, "cooperative launch failed: %s (grid %d)\n", hipGetErrorString(e), grid_blocks);
}
```

```cpp
#include <hip/hip_runtime.h>
#include <hip/hip_cooperative_groups.h>
#include <stdint.h>
#include <stdio.h>

#define DI __device__ __forceinline__
typedef unsigned short u16;
typedef short bf16x8 __attribute__((ext_vector_type(8)));
typedef short s16x4 __attribute__((ext_vector_type(4)));
typedef float f32x4 __attribute__((ext_vector_type(4)));
typedef float f32x2 __attribute__((ext_vector_type(2)));
typedef float f32x16 __attribute__((ext_vector_type(16)));
typedef unsigned u32x4 __attribute__((ext_vector_type(4)));
typedef unsigned u32x2 __attribute__((ext_vector_type(2)));
typedef __bf16 bf2_t __attribute__((ext_vector_type(2)));

constexpr int NTOK = 32768, DM = 1024, SEQ = 2048, NBATCH = 16, INC = 3328;
constexpr int TCH = 32, NCH = SEQ / TCH, S5M = NBATCH * NCH, S5K1 = TCH * 16, S5K2 = S5K1 + 128;
constexpr int TM = 256;
constexpr int MAXTILES = (NTOK + 24 * (TM - 1)) / TM + 1;
constexpr int NTHR = 512;
constexpr int LDS_BYTES = 98304;

#ifndef REP_PREP
#define REP_PREP 1
#endif
#ifndef REP_XB
#define REP_XB 1
#endif
#ifndef REP_ATTN
#define REP_ATTN 1
#endif
#ifndef REP_ROUTER
#define REP_ROUTER 1
#endif
#ifndef REP_INPROJ
#define REP_INPROJ 1
#endif
#ifndef REP_GLU
#define REP_GLU 1
#endif
#ifndef REP_MOEUP
#define REP_MOEUP 1
#endif
#ifndef REP_OUT0
#define REP_OUT0 1
#endif
#ifndef REP_EPI
#define REP_EPI 1
#endif
#ifndef REP_KLOOP
#define REP_KLOOP 1
#endif
#ifndef REP_G2
#define REP_G2 1
#endif
constexpr size_t MiB = 1u << 20;
constexpr size_t OFF_R1 = 0;
constexpr size_t OFF_R2 = 64 * MiB;
constexpr size_t OFF_R3 = 128 * MiB;
constexpr size_t OFF_A2 = 192 * MiB;
constexpr size_t OFF_Q = 232 * MiB;
constexpr size_t OFF_KV = 264 * MiB;
constexpr size_t OFF_SLOC = 280 * MiB;
constexpr size_t OFF_Z = OFF_Q;
constexpr size_t OFF_YA = 296 * MiB;
constexpr size_t WSET = 80 * MiB;
constexpr size_t OFF_WIN = 328 * MiB;
constexpr size_t OFF_WGLU = OFF_WIN + 7 * MiB;
constexpr size_t OFF_WATT = OFF_WGLU + 2 * MiB;
constexpr size_t OFF_WOUT = OFF_WATT + 1 * MiB;
constexpr size_t OFF_WUP = OFF_WOUT + 2 * MiB;
constexpr size_t OFF_WDN = OFF_WUP + 16 * MiB;
DI size_t pa_off(const int L) { return OFF_WIN + (size_t)(1 - L) * WSET; }
constexpr size_t OFF_W1T = OFF_WDN + 24 * MiB;
constexpr size_t OFF_W2T = OFF_W1T + 8 * MiB;
constexpr size_t OFF_SMALL = OFF_WIN + 2 * WSET;
constexpr size_t OFF_WR = OFF_SMALL;
constexpr size_t OFF_LT = OFF_WR + 128 * 1024;
constexpr size_t OFF_RSTD1 = OFF_LT + 64 * 1024;
constexpr size_t OFF_RSTD2 = OFF_RSTD1 + 128 * 1024;
constexpr size_t OFF_BUCKET = OFF_RSTD2 + 128 * 1024;
constexpr size_t OFF_RW = OFF_BUCKET + 128 * 1024;
constexpr size_t OFF_PERM = OFF_RW + 256 * 1024;
constexpr size_t OFF_CNT = OFF_PERM + 256 * 1024;
constexpr size_t OFF_TILEB = OFF_CNT + 32 * 1024;
constexpr size_t OFF_META = OFF_TILEB + 4 * 1024;
constexpr size_t OFF_SSQ4 = OFF_META + 1024;
constexpr size_t OFF_PERM2 = OFF_SSQ4 + 512 * 1024;
constexpr size_t WS_END = OFF_PERM2 + (size_t)24 * 32768 * 4;
constexpr size_t OFF_BAR = WS_END;
#define XCD_BAR_WORDS 3456
constexpr size_t OFF_MOEQ = OFF_BAR + XCD_BAR_WORDS * 4;
constexpr size_t CTL_BYTES = XCD_BAR_WORDS * 4 + 2 * 256 * 4;

struct Params {
    const float* in[23];
    float* out;
    char* ws;
};

DI int TID() { int t = threadIdx.x; asm volatile("" : "+v"(t)); return t; }
DI unsigned OZ() { unsigned z = 0; asm volatile("" : "+s"(z)); return z; }
template <class T> DI T* opq(T* x) { unsigned long long v = (unsigned long long)x; asm volatile("" : "+s"(v)); return (T*)(__attribute__((address_space(1))) char*)v; }
DI float shx(float v, int m, int lane) { return __builtin_bit_cast(float, __builtin_amdgcn_ds_bpermute((lane ^ m) << 2, __builtin_bit_cast(int, v))); }
DI const char* uptr(const char* p) { const unsigned long long v = (unsigned long long)p; const unsigned lo = (unsigned)__builtin_amdgcn_readfirstlane((int)(unsigned)v), hi = (unsigned)__builtin_amdgcn_readfirstlane((int)(unsigned)(v >> 32)); return (const char*)(__attribute__((address_space(1))) const char*)(((unsigned long long)hi << 32) | lo); }
DI void st16_sc1(void* p, u32x4 v) { asm volatile("global_store_dwordx4 %0, %1, off sc1\n\ts_nop 1" :: "v"(p), "v"(v) : "memory"); }
DI int BID() { int b = blockIdx.x; asm volatile("" : "+s"(b)); return b; }
DI unsigned pk2(float a, float b) { f32x2 v = {a, b}; bf2_t r = __builtin_convertvector(v, bf2_t); return __builtin_bit_cast(unsigned, r); }
DI float bf_lo(unsigned u) { return __uint_as_float(u << 16); }
DI float bf_hi(unsigned u) { return __uint_as_float(u & 0xffff0000u); }
DI float sigmoidf_(float x) { return __builtin_amdgcn_rcpf(1.0f + __builtin_amdgcn_exp2f(-1.4426950408889634f * x)); }
DI float gelu_tanh(float x) { const float u = 0.7978845608028654f * (x + 0.044715f * x * x * x); return x * __builtin_amdgcn_rcpf(1.0f + __builtin_amdgcn_exp2f(-2.8853900817779268f * u)); }
DI f32x16 mfma32(bf16x8 a, bf16x8 b, f32x16 c) { return __builtin_amdgcn_mfma_f32_32x32x16_bf16(a, b, c, 0, 0, 0); }
DI f32x4 mfma16(bf16x8 a, bf16x8 b, f32x4 c) { return __builtin_amdgcn_mfma_f32_16x16x32_bf16(a, b, c, 0, 0, 0); }

struct TJob { unsigned long long src, dst, scale; int ld_src, ld_dst, dcol0, rmul, radd, k0, n0; };
DI void tconv_load(const TJob& j, int tid, f32x4 (&v)[2]) {
    const float* src = (const float*)(__attribute__((address_space(1))) const char*)j.src;
#pragma unroll
    for (int i = 0; i < 2; ++i) v[i] = *(const f32x4*)(src + (size_t)(j.k0 + (tid >> 4) + 32 * i) * j.ld_src + j.n0 + (tid & 15) * 4);
}
DI void tconv_to_lds(const TJob& j, int tid, const f32x4 (&v)[2], float* sm) {
    const float* scale = (const float*)(__attribute__((address_space(1))) const char*)j.scale;
#pragma unroll
    for (int i = 0; i < 2; ++i) {
        const int k = (tid >> 4) + 32 * i, n = (tid & 15) * 4;
        const float sc = j.scale ? scale[j.k0 + k] : 1.0f;
        sm[(n + 0) * 65 + k] = v[i].x * sc; sm[(n + 1) * 65 + k] = v[i].y * sc; sm[(n + 2) * 65 + k] = v[i].z * sc; sm[(n + 3) * 65 + k] = v[i].w * sc;
    }
}
DI void tconv_store(const TJob& j, int tid, const float* sm) {
    u16* dst = (u16*)(__attribute__((address_space(1))) char*)j.dst;
    const int n = tid >> 3, c = tid & 7;
    const float* s = sm + n * 65 + c * 8;
    u32x4 o; o.x = pk2(s[0], s[1]); o.y = pk2(s[2], s[3]); o.z = pk2(s[4], s[5]); o.w = pk2(s[6], s[7]);
    const int nn = j.n0 + n, drow = j.rmul == 1 ? nn + j.radd : (nn >> 7) * 256 + j.radd + (nn & 127);
    *(u32x4*)(dst + (size_t)drow * j.ld_dst + j.dcol0 + j.k0 + c * 8) = o;
}

constexpr int T_WIN = (1024 / 64) * (INC / 64);
constexpr int T_GLU = 2 * (512 / 64) * (1024 / 64);
constexpr int T_ATT = (512 / 64) * (1024 / 64);
constexpr int T_OUT = (1024 / 64) * (1024 / 64);
constexpr int T_UP = 16 * 2 * (1024 / 64) * (256 / 64);
constexpr int T_DN = 24 * 2 * (256 / 64) * (1024 / 64);
constexpr int T_ALL = T_WIN + T_GLU + T_ATT + T_OUT + T_UP + T_DN;
static_assert(T_ALL % 4 == 0, "tiles are processed four at a time");

DI void pair_experts(int pidx, int& a, int& b) {
    a = pidx < 3 ? 0 : (pidx < 5 ? 1 : 2);
    b = pidx < 3 ? pidx + 1 : (pidx < 5 ? pidx - 1 : 3);
}

DI TJob prep_tjob(const Params& p, const int L, int t) {
    const unsigned long long ws = (unsigned long long)opq(p.ws) + (unsigned long long)L * WSET;
    TJob j; j.scale = 0; j.dcol0 = 0; j.rmul = 1; j.radd = 0;
    if (t < T_WIN) { const int kb = t / (INC / 64), nb = t % (INC / 64);
        j.src = (unsigned long long)(opq(p.in[2]) + (size_t)L * 1024 * INC); j.ld_src = INC; j.dst = ws + OFF_WIN; j.ld_dst = 1024; j.scale = (unsigned long long)(opq(p.in[1]) + L * 1024); j.k0 = kb * 64; j.n0 = nb * 64; return j; }
    t -= T_WIN;
    if (t < T_GLU) { const int half = t / 128, r = t % 128, kb = r / 16, nb = r % 16;
        j.src = (unsigned long long)((half ? opq(p.in[12]) : opq(p.in[11])) + (size_t)L * 512 * 1024); j.ld_src = 1024; j.dst = ws + OFF_WGLU; j.ld_dst = 512; j.rmul = 2; j.radd = half * 128; j.k0 = kb * 64; j.n0 = nb * 64; return j; }
    t -= T_GLU;
    if (t < T_ATT) { const int kb = t / 16, nb = t % 16;
        j.src = (unsigned long long)(opq(p.in[16]) + (size_t)L * 512 * 1024); j.ld_src = 1024; j.dst = ws + OFF_WATT; j.ld_dst = 512; j.k0 = kb * 64; j.n0 = nb * 64; return j; }
    t -= T_ATT;
    if (t < T_OUT) { const int kb = t / 16, nb = t % 16;
        j.src = (unsigned long long)(opq(p.in[17]) + (size_t)L * 1024 * 1024); j.ld_src = 1024; j.dst = ws + OFF_WOUT; j.ld_dst = 1024; j.k0 = kb * 64; j.n0 = nb * 64; return j; }
    t -= T_OUT;
    if (t < T_UP) { const int e = t / 128, r = t % 128, half = r / 64, r2 = r % 64, kb = r2 / 4, nb = r2 % 4;
        j.src = (unsigned long long)(opq(p.in[21]) + ((size_t)(L * 16 + e) * 1024) * 512 + half * 256); j.ld_src = 512; j.dst = ws + OFF_WUP + (size_t)e * 512 * 1024 * 2; j.ld_dst = 1024; j.rmul = 2; j.radd = half * 128;
        j.scale = (unsigned long long)(opq(p.in[18]) + L * 1024); j.k0 = kb * 64; j.n0 = nb * 64; return j; }
    t -= T_UP;
    { const int pr = t / 128, r = t % 128, slot = r / 64, r2 = r % 64, kb = r2 / 16, nb = r2 % 16;
      const int grp = pr / 6; int a, b; pair_experts(pr % 6, a, b); const int e = grp * 4 + (slot ? b : a);
      j.src = (unsigned long long)(opq(p.in[22]) + ((size_t)(L * 16 + e) * 256) * 1024); j.ld_src = 1024; j.dst = ws + OFF_WDN + (size_t)pr * 1024 * 512 * 2; j.ld_dst = 512; j.dcol0 = slot * 256; j.k0 = kb * 64; j.n0 = nb * 64; }
    return j;
}

DI void prep_s5_item(const Params& p, const int L, int item, float* sm) {
    const int tid = TID(), g = item >> 3, s = item & 7;
    float* LBre = sm;
    float* LBim = LBre + 33 * 64;
    float* BBre = LBim + 33 * 64;
    float* BBim = BBre + 1024;
    float* Cre = BBim + 1024;
    float* Cim = Cre + 128;
    float* Kt = Cim + 128;
    const float* lam_re = opq(p.in[3]) + (size_t)(L * 32 + g) * 64;
    const float* lam_im = opq(p.in[4]) + (size_t)(L * 32 + g) * 64;
    const float dt = expf(opq(p.in[5])[L * 32 + g]);
    const float* b_re = opq(p.in[6]) + (size_t)(L * 32 + g) * 1024;
    const float* b_im = opq(p.in[7]) + (size_t)(L * 32 + g) * 1024;
    const float* c_re = opq(p.in[8]) + (size_t)(L * 32 + g) * 1024;
    const float* c_im = opq(p.in[9]) + (size_t)(L * 32 + g) * 1024;
    const float* dsk = opq(p.in[10]) + L * 512 + g * 16;
    for (int i = tid; i < 33 * 64; i += NTHR) {
        const int lag = i >> 6, pp = i & 63;
        const float mag = expf(lam_re[pp] * dt * (float)lag);
        double a = (double)lam_im[pp] * (double)dt * (double)lag;
        a -= 6.283185307179586476925 * rint(a * 0.15915494309189533577);
        const float af = (float)a;
        LBre[i] = mag * cosf(af); LBim[i] = mag * sinf(af);
    }
    if (tid < 128) { Cre[tid] = c_re[(2 * s) * 64 + tid]; Cim[tid] = c_im[(2 * s) * 64 + tid]; }
    for (int i = tid; i < 1024; i += NTHR) {
        const int pp = i >> 4;
        const float lr = lam_re[pp], li = lam_im[pp];
        const float a = lr * dt; const float bb = li * dt;
        double br = (double)bb; br -= 6.283185307179586476925 * rint(br * 0.15915494309189533577);
        const float bf = (float)br;
        const float sh = sinf(0.5f * bf);
        const float xr = expm1f(a) * cosf(bf) - 2.0f * sh * sh;
        const float xi = expf(a) * sinf(bf);
        const float den = 1.0f / (lr * lr + li * li);
        const float fr = (xr * lr + xi * li) * den, fi = (xi * lr - xr * li) * den;
        const float vr = b_re[i], vi = b_im[i];
        BBre[i] = fr * vr - fi * vi; BBim[i] = fr * vi + fi * vr;
    }
    __syncthreads();
    if (s == 0 && tid < 64) { float* LT = (float*)(opq(p.ws) + OFF_LT) + (size_t)(g * 64 + tid) * 2; LT[0] = LBre[32 * 64 + tid]; LT[1] = LBim[32 * 64 + tid]; }
    for (int i = tid; i < 32 * 32; i += NTHR) {
        const int lag = i >> 5, hl = (i >> 4) & 1, hi = i & 15;
        float acc = 0.f;
        for (int pp = 0; pp < 64; ++pp) {
            const float cr = Cre[hl * 64 + pp], ci = Cim[hl * 64 + pp];
            const float lr = LBre[lag * 64 + pp], li = LBim[lag * 64 + pp];
            const float tr = cr * lr - ci * li, ti = cr * li + ci * lr;
            acc += tr * BBre[pp * 16 + hi] - ti * BBim[pp * 16 + hi];
        }
        Kt[i] = acc;
    }
    __syncthreads();
    u16* W1 = (u16*)(opq(p.ws) + (size_t)L * WSET + OFF_W1T) + (size_t)g * 256 * 512;
    for (int i = tid; i < 16 * 256; i += NTHR) {
        const int n = 16 * s + (i >> 8), k = (i & 255) * 2, pp = n >> 1, ri = n & 1, j = k >> 4, hi = k & 15;
        const float lr = LBre[(31 - j) * 64 + pp], li = LBim[(31 - j) * 64 + pp];
        float v[2];
#pragma unroll
        for (int e = 0; e < 2; ++e) { const float br = BBre[pp * 16 + hi + e], bi = BBim[pp * 16 + hi + e]; v[e] = ri ? (lr * bi + li * br) : (lr * br - li * bi); }
        *(unsigned*)(W1 + (size_t)n * 512 + k) = pk2(v[0], v[1]);
    }
    u16* W2 = (u16*)(opq(p.ws) + (size_t)L * WSET + OFF_W2T) + (size_t)g * 512 * 640;
    for (int idx = tid; idx < 64 * 320; idx += NTHR) {
        const int rr = idx / 320, k = (idx % 320) * 2, ii = rr >> 1, hl = rr & 1, ho = 2 * s + hl, n = ii * 16 + ho;
        float v[2];
        if (k < 512) {
            const int j = k >> 4, hi = k & 15;
#pragma unroll
            for (int e = 0; e < 2; ++e) {
                float x = 0.f;
                if (j <= ii) x = Kt[(ii - j) * 32 + hl * 16 + hi + e];
                if (j == ii && hi + e == ho) x += dsk[ho];
                v[e] = x;
            }
        } else {
            const int pp = (k - 512) >> 1;
            const float cr = Cre[hl * 64 + pp], ci = Cim[hl * 64 + pp];
            const float lr = LBre[(ii + 1) * 64 + pp], li = LBim[(ii + 1) * 64 + pp];
            v[0] = cr * lr - ci * li; v[1] = -(cr * li + ci * lr);
        }
        *(unsigned*)(W2 + (size_t)n * 640 + k) = pk2(v[0], v[1]);
    }
    __syncthreads();
}

DI void prep_router_w(const Params& p, const int L) {
    u16* WRH = (u16*)(opq(p.ws) + OFF_WR);
    u16* WRL = WRH + 21 * 1024;
    const float* nf = opq(p.in[18]) + L * 1024;
    const float* wc = opq(p.in[19]) + (size_t)L * 1024 * 4;
    const float* wf = opq(p.in[20]) + (size_t)L * 1024 * 16;
    for (int i = TID(); i < 21 * 1024; i += NTHR) {
        const int n = i >> 10, k = i & 1023;
        const float v = n < 20 ? nf[k] * (n < 4 ? wc[k * 4 + n] : wf[k * 16 + (n - 4)]) : 0.f;
        const unsigned h = pk2(v, 0.f) & 0xffffu;
        const float vh = __uint_as_float(h << 16);
        WRH[i] = (u16)h;
        WRL[i] = (u16)(pk2(v - vh, 0.f) & 0xffffu);
    }
}

DI void phase_prep(const Params& p, const int L, char* lds) {
    float* sm = (float*)lds;
    const int bid = BID(), G = gridDim.x;
    for (int it = bid; it < 257; it += G) {
        if (it < 256) prep_s5_item(p, L, it, sm);
        else prep_router_w(p, L);
    }
    const int tid = TID();
    for (int gi = bid; gi < T_WIN / 4; gi += G) {
        TJob j0 = prep_tjob(p, L, 4 * gi), j1 = prep_tjob(p, L, 4 * gi + 1), j2 = prep_tjob(p, L, 4 * gi + 2), j3 = prep_tjob(p, L, 4 * gi + 3);
        f32x4 v0[2], v1[2], v2[2], v3[2];
        tconv_load(j0, tid, v0); tconv_load(j1, tid, v1); tconv_load(j2, tid, v2); tconv_load(j3, tid, v3);
        tconv_to_lds(j0, tid, v0, sm); tconv_to_lds(j1, tid, v1, sm + 4224); tconv_to_lds(j2, tid, v2, sm + 8448); tconv_to_lds(j3, tid, v3, sm + 12672);
        __syncthreads();
        tconv_store(j0, tid, sm); tconv_store(j1, tid, sm + 4224); tconv_store(j2, tid, sm + 8448); tconv_store(j3, tid, sm + 12672);
        __syncthreads();
    }
}

constexpr int PREPQ_ITEMS = 257 + T_ALL / 4;
DI void prep_from_queue(const Params& p, char* lds, int budget, const int L, const int first) {
    float* sm = (float*)lds;
    unsigned* qc = (unsigned*)(opq(p.ws) + OFF_BAR) + 12 + L;
    int* qslot = (int*)(lds + 81920);
    const int tid = TID();
    for (int n = 0; n < budget; ++n) {
        if (threadIdx.x == 0) *qslot = (int)__hip_atomic_fetch_add(qc, 1u, __ATOMIC_RELAXED, __HIP_MEMORY_SCOPE_AGENT);
        __syncthreads();
        const int it = __builtin_amdgcn_readfirstlane(*qslot) + first;
        __syncthreads();
        if (it >= PREPQ_ITEMS) break;
        if (it < 256) prep_s5_item(p, L, it, sm);
        else if (it == 256) prep_router_w(p, L);
        else {
            const int gi = it - 257;
            TJob j0 = prep_tjob(p, L, 4 * gi), j1 = prep_tjob(p, L, 4 * gi + 1), j2 = prep_tjob(p, L, 4 * gi + 2), j3 = prep_tjob(p, L, 4 * gi + 3);
            f32x4 v0[2], v1[2], v2[2], v3[2];
            tconv_load(j0, tid, v0); tconv_load(j1, tid, v1); tconv_load(j2, tid, v2); tconv_load(j3, tid, v3);
            tconv_to_lds(j0, tid, v0, sm); tconv_to_lds(j1, tid, v1, sm + 4224); tconv_to_lds(j2, tid, v2, sm + 8448); tconv_to_lds(j3, tid, v3, sm + 12672);
            __syncthreads();
            tconv_store(j0, tid, sm); tconv_store(j1, tid, sm + 4224); tconv_store(j2, tid, sm + 8448); tconv_store(j3, tid, sm + 12672);
            __syncthreads();
        }
    }
}

DI void phase_xb(const Params& p) {
    const float* X = opq(p.in[0]);
    u16* XB = (u16*)(opq(p.ws) + OFF_R1);
    float* ssq4 = (float*)(opq(p.ws) + OFF_SSQ4);
    const int tid_ = TID(), lane = tid_ & 63, w = tid_ >> 6;
    for (int row0 = (BID() * 8 + w) * 4; row0 < NTOK; row0 += gridDim.x * 8 * 4) {
        f32x4 v[4][4];
#pragma unroll
        for (int r = 0; r < 4; ++r)
#pragma unroll
            for (int j = 0; j < 4; ++j) v[r][j] = ((const f32x4*)(X + (size_t)(row0 + r) * DM) + lane)[64 * j];
#pragma unroll
        for (int r = 0; r < 4; ++r) {
            const int row = row0 + r; float s = 0.f;
            u32x2* o8 = (u32x2*)(XB + (size_t)row * DM) + lane;
#pragma unroll
            for (int j = 0; j < 4; ++j) { u32x2 q; q.x = pk2(v[r][j].x, v[r][j].y); q.y = pk2(v[r][j].z, v[r][j].w); o8[64 * j] = q;
                const float a = bf_lo(q.x), b = bf_hi(q.x), c = bf_lo(q.y), d = bf_hi(q.y); s += a * a + b * b + c * c + d * d; }
#pragma unroll
            for (int o = 1; o < 64; o <<= 1) s += shx(s, o, lane);
            if (lane == 0) *(f32x4*)(ssq4 + (size_t)row * 4) = (f32x4){s, 0.f, 0.f, 0.f};
        }
    }
}

#define PG_LAS __attribute__((address_space(3)))
constexpr int PG_HTB = 128 * 64 * 2;
constexpr int PG_STAGE_BYTES = 8 * PG_HTB;
DI int pg_lds_byte(int r, int c) { const int st = (r >> 4) * 2 + (c >> 5), rr = r & 15, cc = c & 31, ob = rr * 64 + cc * 2; return st * 1024 + (ob ^ (((ob >> 9) & 1) << 5)); }
DI void pg_stage_rc(int b, int& R, int& C) { const int st = b / 1024, sb = b % 1024, swz = sb ^ (((sb >> 9) & 1) << 5); R = (st >> 1) * 16 + swz / 64; C = (st & 1) * 32 + (swz % 64) / 2; }

constexpr int ST16 = 264;
constexpr int ST16H = 136;
constexpr int ST32 = 260;
DI int rg_row(int rg, int rbase) { return (rg >> 2) * 128 + (rg & 3) * 16 + rbase; }

DI void pg_glds16(unsigned lds_dst, const char* base, unsigned voff) {
    unsigned keep;
    asm volatile("s_mov_b32 %0, m0\n\ts_mov_b32 m0, %1\n\ts_nop 0\n\tglobal_load_lds_dwordx4 %2, %3\n\ts_mov_b32 m0, %0" : "=&s"(keep) : "s"(lds_dst), "v"(voff), "s"(base) : "memory");
}

constexpr unsigned ROWC_OFF = 139264;
template <class J, class = void> struct has_rowdma { static constexpr bool v = false; };
template <class J> struct has_rowdma<J, decltype((void)J::ROWDMA)> { static constexpr bool v = J::ROWDMA; };

template <class J>
DI void pg_gemm_seq(const J& jb, char* lds_, const int u_begin, const int G, const int nu) {
    PG_LAS unsigned char* lds = (PG_LAS unsigned char*)lds_;
    const int tid = TID(), wid = __builtin_amdgcn_readfirstlane(tid >> 6), lane = tid & 63, wr = wid >> 2, wc = wid & 3, fr = lane & 15, fq = lane >> 4;
    const int bid = u_begin;
    const int K = jb.kdim(), nt = K / 64;
    if (bid >= nu) return;
    int Rr[2], Cc[2]; unsigned voffB[2];
#pragma unroll
    for (int i = 0; i < 2; ++i) { pg_stage_rc(tid * 16 + i * 8192, Rr[i], Cc[i]); const int rho = Rr[i] & 31, Rb = (Rr[i] & ~31) + 8 * ((rho & 15) >> 2) + 4 * (rho >> 4) + (rho & 3); voffB[i] = (unsigned)(Rb * K + Cc[i]) * 2u; }
    const size_t kstepA = jb.a_kstep();
    const size_t hstepA = jb.a_hstep();
    const size_t kstepB = 128;
    const size_t hstepB = (size_t)128 * K * 2;
    const unsigned ldsw = (unsigned)wid * 1024u;
    const unsigned ldsb = (unsigned)(size_t)lds;
    const int aoff = pg_lds_byte(wr * 64 + fr, fq * 8), boff = pg_lds_byte(wc * 32 + fr, fq * 8);
#define PG_SA(b, h) ((b) * 65536 + (h) * PG_HTB)
#define PG_SB(b, h) ((b) * 65536 + 32768 + (h) * PG_HTB)
#define PG_STAGE(bufoff, gbase, voff) do { _Pragma("unroll") for (int _i = 0; _i < 2; ++_i) \
        pg_glds16(ldsb + (unsigned)(bufoff) + ldsw + _i * 8192u, (const char*)(gbase), (voff)[_i]); } while (0)
#define PG_STAGE_A(bufoff, gbase, h) do { if constexpr (J::GATHER) { if (h) PG_STAGE(bufoff, gbase, vo1); else PG_STAGE(bufoff, gbase, vo0); } else { PG_STAGE(bufoff, (gbase) + (h) * hstepA, vo0); } } while (0)
#define PG_LDA(dst, b, h) do { _Pragma("unroll") for (int m = 0; m < 4; ++m) _Pragma("unroll") for (int k = 0; k < 2; ++k) dst[m][k] = *(const PG_LAS bf16x8*)(lds + PG_SA(b, h) + aoff + m * 2048 + k * 1024); } while (0)
#define PG_LDB(dst, b, h) do { _Pragma("unroll") for (int n = 0; n < 2; ++n) _Pragma("unroll") for (int k = 0; k < 2; ++k) dst[n][k] = *(const PG_LAS bf16x8*)(lds + PG_SB(b, h) + boff + n * 2048 + k * 1024); } while (0)
#define PG_MMA(ai, bj, At, Bt) do { __builtin_amdgcn_s_setprio(1); _Pragma("unroll") for (int m = 0; m < 4; ++m) _Pragma("unroll") for (int n = 0; n < 2; ++n) _Pragma("unroll") for (int k = 0; k < 2; ++k) \
        acc[ai][bj][m][n] = __builtin_amdgcn_mfma_f32_16x16x32_bf16(Bt[n][k], At[m][k], acc[ai][bj][m][n], 0, 0, 0); __builtin_amdgcn_s_setprio(0); } while (0)
#define PG_WAIT_V(n) asm volatile("s_waitcnt vmcnt(" #n ")" ::: "memory")
#define PG_WAIT_L(n) asm volatile("s_waitcnt lgkmcnt(" #n ")" ::: "memory")
#define PG_BAR __builtin_amdgcn_s_barrier()
#define PG_SCHED __builtin_amdgcn_sched_barrier(0)
    typename J::Unit cur = jb.unit(bid);
    unsigned vo0[2], vo1[2];
#pragma unroll
    for (int i = 0; i < 2; ++i) { vo0[i] = jb.a_off(cur, Rr[i], Cc[i]); vo1[i] = J::GATHER ? jb.a_off(cur, Rr[i] + 128, Cc[i]) : 0u; }
    const char* cA = uptr(jb.a_base(cur)); const char* cB = uptr(jb.b_base(cur));
    int rpar = 0;
    if constexpr (has_rowdma<J>::v) { if (wid < 4) pg_glds16(ldsb + ROWC_OFF + (unsigned)wid * 1024u, uptr(jb.row_base(cur)), (unsigned)tid * 16u); }
    PG_STAGE(PG_SB(0, 0), cB, voffB); PG_STAGE_A(PG_SA(0, 0), cA, 0); PG_STAGE(PG_SB(0, 1), cB + hstepB, voffB); PG_STAGE_A(PG_SA(0, 1), cA, 1);
    for (int uidx = bid;;) {
        if (wr == 1) PG_BAR;
        PG_WAIT_V(4); PG_BAR;
        PG_STAGE(PG_SB(1, 0), cB + kstepB, voffB); PG_STAGE_A(PG_SA(1, 0), cA + kstepA, 0); PG_STAGE(PG_SB(1, 1), cB + hstepB + kstepB, voffB);
        PG_WAIT_V(6); PG_BAR;
        f32x4 acc[2][2][4][2];
#pragma unroll
        for (int a = 0; a < 2; ++a)
#pragma unroll
            for (int b = 0; b < 2; ++b)
#pragma unroll
                for (int m = 0; m < 4; ++m)
#pragma unroll
                    for (int n = 0; n < 2; ++n) acc[a][b][m][n] = (f32x4){0.f, 0.f, 0.f, 0.f};
        bf16x8 At[4][2], B0[2][2], B1[2][2];
        for (int t = 0; t < nt; t += 2) {
            const bool more = (t != nt - 2);
            const char* a1 = cA + (size_t)(t + 1) * kstepA;
            const char* a2 = cA + (size_t)(t + 2) * kstepA; const char* b2 = cB + (size_t)(t + 2) * kstepB;
            const char* a3 = a2 + kstepA; const char* b3 = b2 + kstepB;
            PG_LDB(B0, 0, 0); PG_SCHED; PG_LDA(At, 0, 0); PG_STAGE_A(PG_SA(1, 1), a1, 1);
            PG_WAIT_L(8); PG_BAR; PG_WAIT_L(0); PG_MMA(0, 0, At, B0); PG_BAR; PG_SCHED;
            PG_LDB(B1, 0, 1); if (more) PG_STAGE(PG_SB(0, 0), b2, voffB);
            PG_BAR; PG_WAIT_L(0); PG_MMA(0, 1, At, B1); PG_BAR;
            PG_LDA(At, 0, 1); if (more) PG_STAGE_A(PG_SA(0, 0), a2, 0);
            PG_BAR; PG_WAIT_L(0); PG_MMA(1, 0, At, B0); PG_BAR; PG_SCHED;
            if (more) { PG_STAGE(PG_SB(0, 1), b2 + hstepB, voffB); PG_WAIT_V(6); } else { PG_WAIT_V(0); }
            PG_BAR; PG_MMA(1, 1, At, B1); PG_BAR;
            PG_LDB(B0, 1, 0); PG_SCHED; PG_LDA(At, 1, 0); if (more) PG_STAGE_A(PG_SA(0, 1), a2, 1);
            PG_WAIT_L(8); PG_BAR; PG_WAIT_L(0); PG_MMA(0, 0, At, B0); PG_BAR; PG_SCHED;
            PG_LDB(B1, 1, 1); if (more) PG_STAGE(PG_SB(1, 0), b3, voffB);
            PG_BAR; PG_WAIT_L(0); PG_MMA(0, 1, At, B1); PG_BAR;
            PG_LDA(At, 1, 1); if (more) PG_STAGE_A(PG_SA(1, 0), a3, 0);
            PG_BAR; PG_WAIT_L(0); PG_MMA(1, 0, At, B0); PG_BAR; PG_SCHED;
            if (more) { PG_STAGE(PG_SB(1, 1), b3 + hstepB, voffB); PG_WAIT_V(6); }
            PG_BAR; PG_MMA(1, 1, At, B1); PG_BAR;
        }
        if (wr == 0) PG_BAR;
        PG_BAR;
        const int nidx = uidx + G;
        const bool has_next = nidx < nu;
        const typename J::Unit done = cur;
        if (has_next) {
            cur = jb.unit(nidx);
            if constexpr (J::GATHER) {
#pragma unroll
                for (int i = 0; i < 2; ++i) { int R2, C2; pg_stage_rc(TID() * 16 + i * 8192, R2, C2); vo0[i] = jb.a_off(cur, R2, C2); vo1[i] = jb.a_off(cur, R2 + 128, C2); }
            }
            cA = uptr(jb.a_base(cur)); cB = uptr(jb.b_base(cur));
            if constexpr (has_rowdma<J>::v) { if (wid < 4) pg_glds16(ldsb + ROWC_OFF + (unsigned)((rpar ^ 1) * 4096) + (unsigned)wid * 1024u, uptr(jb.row_base(cur)), (unsigned)TID() * 16u); }
            PG_STAGE(PG_SB(0, 0), cB, voffB); PG_STAGE_A(PG_SA(0, 0), cA, 0); PG_STAGE(PG_SB(0, 1), cB + hstepB, voffB); PG_STAGE_A(PG_SA(0, 1), cA, 1);
        }
        {
            const int l2 = TID() & 63;
            const int rbase = wr * 64 + (l2 & 15), cb = wc * 32 + 8 * (l2 >> 4);
            typename J::Ctx ctx;
            if constexpr (has_rowdma<J>::v) jb.epi_begin(done, rbase, ctx, (const PG_LAS unsigned char*)(lds + ROWC_OFF + rpar * 4096)); else jb.epi_begin(done, rbase, ctx);
            if constexpr (J::SMODE == 0 && J::NCOL == 128) {
                PG_LAS u16* T = (PG_LAS u16*)(lds + 65536);
#pragma unroll
                for (int rg = 0; rg < 8; ++rg) {
                    u32x4 o0, o1;
                    jb.epi_val(done, ctx, rg, acc[rg >> 2][0][rg & 3][0], acc[rg >> 2][0][rg & 3][1], acc[rg >> 2][1][rg & 3][0], acc[rg >> 2][1][rg & 3][1], o0, o1);
                    *(PG_LAS u32x4*)(T + rg_row(rg, rbase) * ST16H + cb) = o0;
                }
                __syncthreads();
                jb.epi_copy(done, ctx, (const PG_LAS u16*)T, TID());
                __syncthreads();
            } else if constexpr (J::SMODE == 0) {
                PG_LAS u16* T = (PG_LAS u16*)(lds + 65536);
#pragma unroll
                for (int h = 0; h < 2; ++h) {
#pragma unroll
                    for (int m = 0; m < 4; ++m) {
                        u32x4 o0, o1;
                        jb.epi_val(done, ctx, h * 4 + m, acc[h][0][m][0], acc[h][0][m][1], acc[h][1][m][0], acc[h][1][m][1], o0, o1);
                        PG_LAS u16* d = T + (m * 16 + rbase) * ST16 + cb;
                        *(PG_LAS u32x4*)d = o0; *(PG_LAS u32x4*)(d + 128) = o1;
                    }
                    __syncthreads();
                    jb.epi_copy(done, (const PG_LAS u16*)T, h, TID());
                    __syncthreads();
                }
            } else {
                PG_LAS float* T = (PG_LAS float*)(lds + 65536);
                typename J::Pre pa, pb;
                jb.epi_load(done, ctx, 0, TID(), pa);
#pragma unroll
                for (int ps = 0; ps < 4; ++ps) {
                    if (wr == (ps & 1)) {
#pragma unroll
                        for (int m = 0; m < 4; ++m) {
                            PG_LAS float* d = T + (m * 16 + (l2 & 15)) * ST32 + cb;
                            *(PG_LAS f32x4*)d = acc[ps >> 1][0][m][0]; *(PG_LAS f32x4*)(d + 4) = acc[ps >> 1][0][m][1];
                            *(PG_LAS f32x4*)(d + 128) = acc[ps >> 1][1][m][0]; *(PG_LAS f32x4*)(d + 132) = acc[ps >> 1][1][m][1];
                        }
                    }
                    __syncthreads();
                    if (ps < 3) jb.epi_load(done, ctx, ps + 1, TID(), pb);
                    jb.epi_copy(done, ctx, (const PG_LAS float*)T, ps, TID(), pa);
                    __syncthreads();
                    pa = pb;
                }
            }
        }
        if (!has_next) break;
        uidx = nidx; rpar ^= 1;
    }
#undef PG_SA
#undef PG_SB
#undef PG_STAGE
#undef PG_STAGE_A
#undef PG_LDA
#undef PG_LDB
#undef PG_MMA
#undef PG_WAIT_V
#undef PG_WAIT_L
#undef PG_BAR
#undef PG_SCHED
}

template <class J> DI void pg_gemm(const J& jb, char* lds_) { pg_gemm_seq(jb, lds_, BID(), (int)gridDim.x, jb.num_units()); }

DI void tile_order(int L, int nM, int nN, int& pm, int& pn) {
    const int nwg = nM * nN, q = nwg / 8, r = nwg % 8, xcd = L % 8, off = L / 8;
    const int wgid = (xcd < r ? xcd * (q + 1) : r * (q + 1) + (xcd - r) * q) + off;
    const int nig = 8 * nN, gid = wgid / nig, fm = gid * 8, gsz = (nM - fm) < 8 ? (nM - fm) : 8;
    pm = fm + ((wgid % nig) % gsz); pn = (wgid % nig) / gsz;
}

struct UnitMN { int m0, n0; };
struct NoCtx {};
DI u32x4 pack8(f32x4 a, f32x4 b) { u32x4 o; o.x = pk2(a.x, a.y); o.y = pk2(a.z, a.w); o.z = pk2(b.x, b.y); o.w = pk2(b.z, b.w); return o; }
DI f32x4 sig4(f32x4 v) { f32x4 o; o.x = sigmoidf_(v.x); o.y = sigmoidf_(v.y); o.z = sigmoidf_(v.z); o.w = sigmoidf_(v.w); return o; }
DI unsigned q4u8(f32x4 v) {
    const unsigned a = (unsigned)fmaf(v.x, 255.0f, 0.5f), b = (unsigned)fmaf(v.y, 255.0f, 0.5f), c = (unsigned)fmaf(v.z, 255.0f, 0.5f), d = (unsigned)fmaf(v.w, 255.0f, 0.5f);
    return a | (b << 8) | (c << 16) | (d << 24);
}
DI f32x4 unq4u8(unsigned w) { f32x4 o; o.x = (float)(w & 0xffu); o.y = (float)((w >> 8) & 0xffu); o.z = (float)((w >> 16) & 0xffu); o.w = (float)(w >> 24); return o * (1.0f / 255.0f); }
constexpr size_t OFF_SGS8 = OFF_R3, OFF_SGA8 = OFF_R3 + ((size_t)32 << 20);
DI f32x4 unp_lo(u32x4 u) { f32x4 o; o.x = bf_lo(u.x); o.y = bf_hi(u.x); o.z = bf_lo(u.y); o.w = bf_hi(u.y); return o; }
DI f32x4 unp_hi(u32x4 u) { f32x4 o; o.x = bf_lo(u.z); o.y = bf_hi(u.z); o.z = bf_lo(u.w); o.w = bf_hi(u.w); return o; }

template <int MODE> struct JobInProjT {
    typedef UnitMN Unit; static constexpr bool GATHER = false; static constexpr int SMODE = 0, NCOL = 256, EREP = REP_EPI;
    struct Ctx { float rs[8]; };
    const char* A; const char* B; const float* ssq4; u16* A2; char* ws;
    DI int num_units() const { return MODE == 0 ? (NTOK / 256) * 12 : 256; }
    DI Unit unit(int u) const { int pm, pn; if (MODE == 0) tile_order(u, NTOK / 256, 12, pm, pn); else { pm = u - 128; pn = 12; } Unit x; x.m0 = pm * 256; x.n0 = pn * 256; return x; }
    DI const char* a_base(const Unit& un) const { return A + (size_t)un.m0 * 2048; }
    DI const char* b_base(const Unit& un) const { return B + (size_t)un.n0 * 2048; }
    DI unsigned a_off(const Unit&, int R, int C) const { return (unsigned)(R * 1024 + C) * 2u; }
    DI size_t a_hstep() const { return 128 * 2048; }
    DI size_t a_kstep() const { return 128; }
    DI int kdim() const { return 1024; }
    static constexpr bool ROWDMA = true;
    DI const char* row_base(const Unit& un) const { return (const char*)ssq4 + (size_t)un.m0 * 16; }
    DI void epi_begin(const Unit&, int rbase, Ctx& c, const PG_LAS unsigned char* rc) const {
#pragma unroll
        for (int rg = 0; rg < 8; ++rg) { const f32x4 q = *(const PG_LAS f32x4*)(rc + rg_row(rg, rbase) * 16); c.rs[rg] = rsqrtf((q.x + q.y + q.z + q.w) * (1.0f / DM) + 1e-6f); }
    }
    DI void epi_val(const Unit& un, const Ctx& c, int rg, f32x4 v00, f32x4 v01, f32x4 v10, f32x4 v11, u32x4& o0, u32x4& o1) const {
        const float s = c.rs[rg];
        if (un.n0 >= 1280) { o0 = (u32x4){q4u8(sig4(v00 * s)), q4u8(sig4(v01 * s)), 0u, 0u}; o1 = (u32x4){q4u8(sig4(v10 * s)), q4u8(sig4(v11 * s)), 0u, 0u}; }
        else { o0 = pack8(v00 * s, v01 * s); o1 = pack8(v10 * s, v11 * s); }
    }
    DI void epi_copy(const Unit& un, const PG_LAS u16* T, int h, int tid) const {
        if (un.n0 < 512) {
#pragma unroll
            for (int it = 0; it < 4; ++it) {
                const int id = it * NTHR + tid, gl = id >> 7, r = id & 127, row = un.m0 + h * 128 + r;
                const PG_LAS u16* s = T + r * ST16 + gl * 16;
                const u32x4 a = *(const PG_LAS u32x4*)s, b = *(const PG_LAS u32x4*)(s + 8);
                const int g = (un.n0 >> 4) + gl, bb = row >> 11, t = row & 2047, ch = t >> 5, i = t & 31;
                u16* d = A2 + ((size_t)(g * S5M + bb * NCH + ch) * S5K2 + i * 16);
                *(u32x4*)d = a; *(u32x4*)(d + 8) = b;
            }
            return;
        }
        if (un.n0 >= 1280) {
            unsigned char* d8 = (unsigned char*)ws + (un.n0 < 2304 ? OFF_SGS8 + (size_t)(un.n0 - 1280) : OFF_SGA8 + (size_t)(un.n0 - 2304));
#pragma unroll
            for (int it = 0; it < 8; ++it) {
                const int id = it * NTHR + tid, r = id >> 5, c = (id & 31) * 8;
                *(u32x2*)(d8 + (size_t)(un.m0 + h * 128 + r) * 1024 + c) = *(const PG_LAS u32x2*)(T + r * ST16 + c);
            }
            return;
        }
        size_t doff; int ld, c0;
        if (un.n0 < 1024) { doff = OFF_Q; ld = 512; c0 = un.n0 - 512; }
        else { doff = OFF_KV; ld = 256; c0 = 0; }
        u16* dst = (u16*)(ws + doff);
#pragma unroll
        for (int it = 0; it < 8; ++it) {
            const int id = it * NTHR + tid, r = id >> 5, c = (id & 31) * 8;
            *(u32x4*)(dst + (size_t)(un.m0 + h * 128 + r) * ld + c0 + c) = *(const PG_LAS u32x4*)(T + r * ST16 + c);
        }
    }
};

struct UnitG { int g, m0, n0; };
struct JobS5G1 {
    typedef UnitG Unit; static constexpr bool GATHER = false; static constexpr int SMODE = 1, NCOL = 256, EREP = 1;
    typedef NoCtx Ctx;
    const char* A2; const char* W1; float* Sloc;
    DI int num_units() const { return 32 * (S5M / 256); }
    DI Unit unit(int u) const { const int xcd = u & 7, slot = u >> 3; Unit x; x.g = xcd * 4 + (slot >> 2); x.m0 = (slot & 3) * 256; x.n0 = 0; return x; }
    DI const char* a_base(const Unit& un) const { return A2 + (size_t)(un.g * S5M + un.m0) * S5K2 * 2; }
    DI const char* b_base(const Unit& un) const { return W1 + (size_t)un.g * 256 * 512 * 2; }
    DI unsigned a_off(const Unit&, int R, int C) const { return (unsigned)(R * S5K2 + C) * 2u; }
    DI size_t a_hstep() const { return 128 * S5K2 * 2; }
    DI size_t a_kstep() const { return 128; }
    DI int kdim() const { return S5K1; }
    DI void epi_begin(const Unit&, int, Ctx&) const {}
    struct Pre {}; DI void epi_load(const Unit&, const Ctx&, int, int, Pre&) const {}
    DI void epi_copy(const Unit& un, const Ctx&, const PG_LAS float* T, int ps, int tid, const Pre&) const {
        const int r0 = (ps >> 1) * 128 + (ps & 1) * 64;
#pragma unroll
        for (int it = 0; it < 4; ++it) {
            const int id = it * NTHR + tid, r = id >> 5, c = (id & 31) * 4;
            *(f32x4*)(Sloc + (size_t)(un.g * S5M + un.m0 + r0 + r) * 128 + c) = *(const PG_LAS f32x4*)(T + r * ST32 + c);
        }
    }
};

struct JobS5G2 {
    typedef UnitG Unit; static constexpr bool GATHER = false; static constexpr int SMODE = 0, NCOL = 256, EREP = 1;
    typedef NoCtx Ctx;
    const char* A2; const char* W2; u16* Zp;
    DI int num_units() const { return 32 * (S5M / 256) * 2; }
    DI Unit unit(int u) const { const int xcd = u & 7, slot = u >> 3; Unit x; x.g = xcd * 4 + (slot >> 3); const int r = slot & 7; x.m0 = (r >> 1) * 256; x.n0 = (r & 1) * 256; return x; }
    DI const char* a_base(const Unit& un) const { return A2 + (size_t)(un.g * S5M + un.m0) * S5K2 * 2; }
    DI const char* b_base(const Unit& un) const { return W2 + (size_t)(un.g * 512 + un.n0) * S5K2 * 2; }
    DI unsigned a_off(const Unit&, int R, int C) const { return (unsigned)(R * S5K2 + C) * 2u; }
    DI size_t a_hstep() const { return 128 * S5K2 * 2; }
    DI size_t a_kstep() const { return 128; }
    DI int kdim() const { return S5K2; }
    DI void epi_begin(const Unit&, int, Ctx&) const {}
    DI f32x4 gelu4(f32x4 v) const { f32x4 o; o.x = gelu_tanh(v.x); o.y = gelu_tanh(v.y); o.z = gelu_tanh(v.z); o.w = gelu_tanh(v.w); return o; }
    DI void epi_val(const Unit&, const Ctx&, int, f32x4 v00, f32x4 v01, f32x4 v10, f32x4 v11, u32x4& o0, u32x4& o1) const { o0 = pack8(gelu4(v00), gelu4(v01)); o1 = pack8(gelu4(v10), gelu4(v11)); }
    DI void epi_copy(const Unit& un, const PG_LAS u16* T, int h, int tid) const {
#pragma unroll
        for (int it = 0; it < 8; ++it) {
            const int id = it * NTHR + tid, r = id >> 5, c = (id & 31) * 8, rr = un.m0 + h * 128 + r, bb = rr >> 6, ch = rr & 63;
            *(u32x4*)(Zp + ((size_t)un.g * NTOK + bb * SEQ + ch * TCH) * 16 + un.n0 + c) = *(const PG_LAS u32x4*)(T + r * ST16 + c);
        }
    }
};

struct JobGLU {
    typedef UnitMN Unit; static constexpr bool GATHER = false; static constexpr int SMODE = 0, NCOL = 128, EREP = 1;
    struct Ctx { u32x2 sg[8]; u32x4 pa[8]; };
    const char* Zp; const char* B; const unsigned char* SGS; const u16* PA; u16* MS;
    DI int num_units() const { return (NTOK / 256) * 8; }
    DI Unit unit(int u) const { int pm, pn; tile_order(u, NTOK / 256, 8, pm, pn); Unit x; x.m0 = pm * 256; x.n0 = pn * 256; return x; }
    DI const char* a_base(const Unit& un) const { return Zp + (size_t)un.m0 * 32; }
    DI const char* b_base(const Unit& un) const { return B + (size_t)un.n0 * 1024; }
    DI unsigned a_off(const Unit&, int R, int C) const { return (unsigned)(((C >> 4) * NTOK + R) * 32 + (C & 15) * 2); }
    DI size_t a_hstep() const { return 128 * 32; }
    DI size_t a_kstep() const { return (size_t)4 * NTOK * 32; }
    DI int kdim() const { return 512; }
    DI void epi_begin(const Unit& un, int, Ctx& cx) const {
        const int tid = TID();
#pragma unroll
        for (int it = 0; it < 8; ++it) { const int id = it * NTHR + tid, r = id >> 4, c = (id & 15) * 8; const size_t off = (size_t)(un.m0 + r) * 1024 + (un.n0 >> 1) + c; cx.sg[it] = *(const u32x2*)(SGS + off); cx.pa[it] = *(const u32x4*)(PA + off); }
    }
    DI void epi_val(const Unit&, const Ctx&, int, f32x4 v00, f32x4 v01, f32x4 v10, f32x4 v11, u32x4& o0, u32x4& o1) const { o0 = pack8(v00 * sig4(v10), v01 * sig4(v11)); o1 = o0; }
    DI void epi_copy(const Unit& un, const Ctx& cx, const PG_LAS u16* T, int tid) const {
#pragma unroll
        for (int it = 0; it < 8; ++it) {
            const int id = it * NTHR + tid, r = id >> 4, c = (id & 15) * 8;
            const u32x4 v = *(const PG_LAS u32x4*)(T + r * ST16H + c);
            *(u32x4*)(MS + (size_t)(un.m0 + r) * 1024 + (un.n0 >> 1) + c) = pack8(unp_lo(v) * unq4u8(cx.sg[it].x) + unp_lo(cx.pa[it]), unp_hi(v) * unq4u8(cx.sg[it].y) + unp_hi(cx.pa[it]));
        }
    }
};

struct JobAttnUp {
    typedef UnitMN Unit; static constexpr bool GATHER = false; static constexpr int SMODE = 1, NCOL = 256, EREP = 1;
    typedef NoCtx Ctx;
    const char* A; const char* B; const unsigned char* SGA; u16* PA;
    DI int num_units() const { return (NTOK / 256) * 4; }
    DI Unit unit(int u) const { int pm, pn; tile_order(u, NTOK / 256, 4, pm, pn); Unit x; x.m0 = pm * 256; x.n0 = pn * 256; return x; }
    DI const char* a_base(const Unit& un) const { return A + (size_t)un.m0 * 1024; }
    DI const char* b_base(const Unit& un) const { return B + (size_t)un.n0 * 1024; }
    DI unsigned a_off(const Unit&, int R, int C) const { return (unsigned)(R * 512 + C) * 2u; }
    DI size_t a_hstep() const { return 128 * 1024; }
    DI size_t a_kstep() const { return 128; }
    DI int kdim() const { return 512; }
    DI void epi_begin(const Unit&, int, Ctx&) const {}
    struct Pre { u32x2 ga[4]; };
    DI void epi_load(const Unit& un, const Ctx&, int ps, int tid, Pre& p) const {
        const int r0 = (ps >> 1) * 128 + (ps & 1) * 64;
#pragma unroll
        for (int it = 0; it < 4; ++it) { const int id = it * NTHR + tid, r = id >> 5, c = (id & 31) * 8; const size_t off = (size_t)(un.m0 + r0 + r) * 1024 + un.n0 + c; p.ga[it] = *(const u32x2*)(SGA + off); }
    }
    DI void epi_copy(const Unit& un, const Ctx&, const PG_LAS float* T, int ps, int tid, const Pre& p) const {
        const int r0 = (ps >> 1) * 128 + (ps & 1) * 64;
#pragma unroll
        for (int it = 0; it < 4; ++it) {
            const int id = it * NTHR + tid, r = id >> 5, c = (id & 31) * 8;
            const f32x4 a = unq4u8(p.ga[it].x) * *(const PG_LAS f32x4*)(T + r * ST32 + c), b = unq4u8(p.ga[it].y) * *(const PG_LAS f32x4*)(T + r * ST32 + c + 4);
            *(u32x4*)(PA + (size_t)(un.m0 + r0 + r) * 1024 + un.n0 + c) = pack8(a, b);
        }
    }
};

struct JobOut {
    typedef UnitMN Unit; static constexpr bool GATHER = false; static constexpr int SMODE = 1, NCOL = 256, EREP = 1;
    typedef NoCtx Ctx;
    const char* A; const char* B; u16* XB;
    DI int num_units() const { return (NTOK / 256) * 4; }
    DI Unit unit(int u) const { int pm, pn; tile_order(u, NTOK / 256, 4, pm, pn); Unit x; x.m0 = pm * 256; x.n0 = pn * 256; return x; }
    DI const char* a_base(const Unit& un) const { return A + (size_t)un.m0 * 2048; }
    DI const char* b_base(const Unit& un) const { return B + (size_t)un.n0 * 2048; }
    DI unsigned a_off(const Unit&, int R, int C) const { return (unsigned)(R * 1024 + C) * 2u; }
    DI size_t a_hstep() const { return 128 * 2048; }
    DI size_t a_kstep() const { return 128; }
    DI int kdim() const { return 1024; }
    DI void epi_begin(const Unit&, int, Ctx&) const {}
    struct Pre { u32x4 xv[4]; };
    DI void epi_load(const Unit& un, const Ctx&, int ps, int tid, Pre& p) const {
        const int r0 = (ps >> 1) * 128 + (ps & 1) * 64;
#pragma unroll
        for (int it = 0; it < 4; ++it) { const int id = it * NTHR + tid, r = id >> 5, c = (id & 31) * 8; p.xv[it] = *(const u32x4*)(XB + (size_t)(un.m0 + r0 + r) * 1024 + un.n0 + c); }
    }
    DI void epi_copy(const Unit& un, const Ctx&, const PG_LAS float* T, int ps, int tid, const Pre& p) const {
        const int r0 = (ps >> 1) * 128 + (ps & 1) * 64;
#pragma unroll
        for (int it = 0; it < 4; ++it) {
            const int id = it * NTHR + tid, r = id >> 5, c = (id & 31) * 8;
            const f32x4 a = unp_lo(p.xv[it]) + *(const PG_LAS f32x4*)(T + r * ST32 + c), b = unp_hi(p.xv[it]) + *(const PG_LAS f32x4*)(T + r * ST32 + c + 4);
            *(u32x4*)(XB + (size_t)(un.m0 + r0 + r) * 1024 + un.n0 + c) = pack8(a, b);
        }
    }
};

struct UnitMoe { int m0, n0, e0, e1, pr, pb, nv; };
constexpr unsigned MOE_TB_OFF = 151552;
DI int moe_tok(const int* perm2, const UnitMoe& un, int R) { return R < un.nv ? perm2[un.pb + R] : -1; }
DI void moe_unit(const PG_LAS int* tb, int u, UnitMoe& x) {
    const int rt = u >> 2; x.m0 = rt * TM; x.n0 = (u & 3) * 256;
    int bk = 0;
#pragma unroll 1
    for (int q = 1; q < 24; ++q) if (x.m0 >= __builtin_amdgcn_readfirstlane(tb[q])) bk = q;
    x.pr = bk;
    const int l0 = x.m0 - __builtin_amdgcn_readfirstlane(tb[bk]);
    int nv = __builtin_amdgcn_readfirstlane(tb[32 + bk]) - l0; nv = nv < 0 ? 0 : (nv > TM ? TM : nv);
    x.nv = nv; x.pb = bk * 32768 + l0;
}
DI void bucket_decode(int bk, int& e0, int& e1) { const int grp = bk / 6; int a, b; pair_experts(bk % 6, a, b); e0 = grp * 4 + a; e1 = grp * 4 + b; }
struct JobMoeUp {
    typedef UnitMoe Unit; static constexpr bool GATHER = true; static constexpr int SMODE = 0, NCOL = 128, EREP = 1;
    struct Ctx { float rs[8]; float wg[8]; };
    const char* XB2; const char* WUP; const int* perm; const PG_LAS int* tb; const float* rstd2; const float* rw; u16* ACT;
    DI int num_units() const { return (__builtin_amdgcn_readfirstlane(tb[24]) / TM) * 4; }
    DI Unit unit(int u) const { Unit x; moe_unit(tb, u, x); bucket_decode(x.pr, x.e0, x.e1); return x; }
    DI const char* a_base(const Unit&) const { return XB2; }
    DI const char* b_base(const Unit& un) const { const int e = un.n0 < 512 ? un.e0 : un.e1; return WUP + (size_t)(e * 512 + (un.n0 & 511)) * 2048; }
    DI unsigned a_off(const Unit& un, int R, int C) const { int tok = moe_tok(perm, un, R); tok = tok < 0 ? 0 : tok; return (unsigned)(tok * 1024 + C) * 2u; }
    DI size_t a_hstep() const { return 0; }
    DI size_t a_kstep() const { return 128; }
    DI int kdim() const { return 1024; }
    DI void epi_begin(const Unit& un, int rbase, Ctx& c) const {
        const int slot = un.n0 >> 9; int tk[8];
#pragma unroll
        for (int rg = 0; rg < 8; ++rg) tk[rg] = moe_tok(perm, un, rg_row(rg, rbase));
#pragma unroll
        for (int rg = 0; rg < 8; ++rg) { const int t = tk[rg] < 0 ? 0 : tk[rg]; c.rs[rg] = rstd2[t]; c.wg[rg] = rw[t * 2 + slot]; }
    }
    DI f32x4 swiglu4(f32x4 g, f32x4 u, float s, float w) const { g = g * s; u = u * s; return g * sig4(g) * u * w; }
    DI void epi_val(const Unit&, const Ctx& c, int rg, f32x4 v00, f32x4 v01, f32x4 v10, f32x4 v11, u32x4& o0, u32x4& o1) const {
        o0 = pack8(swiglu4(v00, v10, c.rs[rg], c.wg[rg]), swiglu4(v01, v11, c.rs[rg], c.wg[rg])); o1 = o0;
    }
    DI void epi_copy(const Unit& un, const Ctx&, const PG_LAS u16* T, int tid) const {
        const int slot = un.n0 >> 9, uu = (un.n0 >> 8) & 1;
#pragma unroll
        for (int it = 0; it < 8; ++it) {
            const int id = it * NTHR + tid, r = id >> 4, c = (id & 15) * 8;
            st16_sc1(ACT + (size_t)(un.m0 + r) * 512 + slot * 256 + uu * 128 + c, *(const PG_LAS u32x4*)(T + r * ST16H + c));
        }
    }
};

struct JobMoeDown {
    typedef UnitMoe Unit; static constexpr bool GATHER = false; static constexpr int SMODE = 1, NCOL = 256, EREP = 1;
    struct Ctx { int tk[16]; };
    const char* ACT; const char* WDN; const int* perm; const PG_LAS int* tb; u16* XB; float* OUT; float* ssq4; int last;
    DI int num_units() const { return (__builtin_amdgcn_readfirstlane(tb[24]) / TM) * 4; }
    DI Unit unit(int u) const { Unit x; moe_unit(tb, u, x); x.e0 = 0; x.e1 = 0; return x; }
    DI const char* a_base(const Unit& un) const { return ACT + (size_t)un.m0 * 1024; }
    DI const char* b_base(const Unit& un) const { return WDN + (size_t)(un.pr * 1024 + un.n0) * 1024; }
    DI unsigned a_off(const Unit&, int R, int C) const { return (unsigned)(R * 512 + C) * 2u; }
    DI size_t a_hstep() const { return 128 * 1024; }
    DI size_t a_kstep() const { return 128; }
    DI int kdim() const { return 512; }
    DI void epi_begin(const Unit& un, int, Ctx& c) const {
        const int tid = TID();
#pragma unroll
        for (int q = 0; q < 16; ++q) { const int ps = q >> 2, it = q & 3, r0 = (ps >> 1) * 128 + (ps & 1) * 64, id = it * NTHR + tid, r = id >> 5; c.tk[q] = moe_tok(perm, un, r0 + r); }
    }
    struct Pre { u32x4 xv[4]; };
    DI void epi_load(const Unit& un, const Ctx& cx, int ps, int tid, Pre& p) const {
#pragma unroll
        for (int it = 0; it < 4; ++it) { const int id = it * NTHR + tid, c = (id & 31) * 8, t = cx.tk[ps * 4 + it] < 0 ? 0 : cx.tk[ps * 4 + it]; p.xv[it] = *(const u32x4*)(XB + (size_t)t * 1024 + un.n0 + c); }
    }
    DI void epi_copy(const Unit& un, const Ctx& cx, const PG_LAS float* T, int ps, int tid, const Pre& p) const {
        const int lane = tid & 63;
#pragma unroll
        for (int it = 0; it < 4; ++it) {
            const int id = it * NTHR + tid, r = id >> 5, c = (id & 31) * 8, tk = cx.tk[ps * 4 + it];
            const f32x4 a = unp_lo(p.xv[it]) + *(const PG_LAS f32x4*)(T + r * ST32 + c), b = unp_hi(p.xv[it]) + *(const PG_LAS f32x4*)(T + r * ST32 + c + 4);
            if (last) {
                if (tk >= 0) { float* o = OUT + (size_t)tk * 1024 + un.n0 + c; *(f32x4*)o = a; *(f32x4*)(o + 4) = b; }
            } else {
                const u32x4 q = pack8(a, b);
                if (tk >= 0) *(u32x4*)(XB + (size_t)tk * 1024 + un.n0 + c) = q;
                const f32x4 ra = unp_lo(q), rb = unp_hi(q);
                float ss = ra.x * ra.x + ra.y * ra.y + ra.z * ra.z + ra.w * ra.w + rb.x * rb.x + rb.y * rb.y + rb.z * rb.z + rb.w * rb.w;
                ss += shx(ss, 1, lane); ss += shx(ss, 2, lane); ss += shx(ss, 4, lane); ss += shx(ss, 8, lane); ss += shx(ss, 16, lane);
                if ((lane & 31) == 0 && tk >= 0) ssq4[(size_t)tk * 4 + (un.n0 >> 8)] = ss;
            }
        }
    }
};

DI void phase_scan(const Params& p) {
    const float* Sloc = (const float*)(opq(p.ws) + OFF_SLOC);
    const float* LT = (const float*)(opq(p.ws) + OFF_LT);
    u16* A2 = (u16*)(opq(p.ws) + OFF_A2);
    for (int idx = BID() * NTHR + TID(); idx < 32 * NBATCH * 64; idx += gridDim.x * NTHR) {
        const int pp = idx & 63, b = (idx >> 6) & 15, g = idx >> 10;
        const float ar = LT[(g * 64 + pp) * 2], ai = LT[(g * 64 + pp) * 2 + 1];
        float sr = 0.f, si = 0.f;
        const size_t r0 = (size_t)g * S5M + b * NCH;
#pragma unroll 8
        for (int c = 0; c < NCH; ++c) {
            *(unsigned*)(A2 + (r0 + c) * S5K2 + S5K1 + 2 * pp) = pk2(sr, si);
            const f32x2 l = *(const f32x2*)(Sloc + (r0 + c) * 128 + 2 * pp);
            const float nr = ar * sr - ai * si + l.x, ni = ar * si + ai * sr + l.y;
            sr = nr; si = ni;
        }
    }
}

DI void scan_local(const Params& p, int g, int b0) {
    asm volatile("s_waitcnt vmcnt(0)" ::: "memory");
    __syncthreads();
    const float* Sloc = (const float*)(opq(p.ws) + OFF_SLOC);
    const float* LT = (const float*)(opq(p.ws) + OFF_LT);
    u16* A2 = (u16*)(opq(p.ws) + OFF_A2);
    const int tid = TID();
    if (tid < 256) {
        const int pp = tid & 63, b = b0 + (tid >> 6);
        const float ar = LT[(g * 64 + pp) * 2], ai = LT[(g * 64 + pp) * 2 + 1];
        float sr = 0.f, si = 0.f;
        const size_t r0 = (size_t)g * S5M + b * NCH;
        f32x2 l[NCH];
#pragma unroll
        for (int c = 0; c < NCH; ++c) l[c] = __builtin_nontemporal_load((const f32x2*)(Sloc + (r0 + c) * 128 + 2 * pp));
#pragma unroll
        for (int c = 0; c < NCH; ++c) {
            *(unsigned*)(A2 + (r0 + c) * S5K2 + S5K1 + 2 * pp) = pk2(sr, si);
            const float nr = ar * sr - ai * si + l[c].x, ni = ar * si + ai * sr + l[c].y;
            sr = nr; si = ni;
        }
    }
}

constexpr int PREP0_FIRST = 257 + T_WIN / 4, PREP0_PER_UNIT = 3;
DI void phase_attn(const Params& p, const int L, char* lds) {
    u16* Ks = (u16*)lds;
    u16* Vt = Ks + 256 * 72;
    int* qslot = (int*)(lds + 70400);
    const u16* Qg = (const u16*)(opq(p.ws) + OFF_Q);
    const u16* KVg = (const u16*)(opq(p.ws) + OFF_KV);
    u16* YA = (u16*)(opq(p.ws) + OFF_YA);
    unsigned* qctr = (unsigned*)(opq(p.ws) + OFF_BAR) + 8 + L;
    const float* qn = opq(p.in[13]) + L * 64; const float* kn = opq(p.in[14]) + L * 64; const float* sinks = opq(p.in[15]) + L * 8;
    const int tid = TID(), lane = tid & 63, w = tid >> 6, r = lane & 31, hh = lane >> 5;
    constexpr float L2E = 1.4426950408889634f;
    for (;;) {
        if (tid == 0) *qslot = (int)__hip_atomic_fetch_add(qctr, 1u, __ATOMIC_RELAXED, __HIP_MEMORY_SCOPE_AGENT);
        __syncthreads();
        const int u = *qslot;
        if (u >= NBATCH * 16 * 2) break;
        const int kvh = u & 1, nb = (u >> 1) & 15, b = u >> 5;
        const int tok0 = b * SEQ + nb * 128;
        const int gq = w >> 1, h = kvh * 4 + gq, qhalf = w & 1;
        u32x4 qn_[4];
#pragma unroll
        for (int s = 0; s < 4; ++s) qn_[s] = *(const u32x4*)(Qg + (size_t)(tok0 + qhalf * 64 + r) * 512 + h * 64 + 16 * s + 8 * hh);
#pragma unroll
        for (int i = 0; i < 4; ++i) {
            const int pc = tid + 512 * i, key = pc >> 3, dc = pc & 7;
            const bool valid = (nb > 0) || (key >= 128);
            u32x4 kr = {0u, 0u, 0u, 0u}, vr = {0u, 0u, 0u, 0u};
            if (valid) { const u16* src = KVg + (size_t)(tok0 - 128 + key) * 256 + kvh * 64 + dc * 8; kr = *(const u32x4*)src; vr = *(const u32x4*)(src + 128); }
            float kf[8];
            kf[0] = bf_lo(kr.x); kf[1] = bf_hi(kr.x); kf[2] = bf_lo(kr.y); kf[3] = bf_hi(kr.y); kf[4] = bf_lo(kr.z); kf[5] = bf_hi(kr.z); kf[6] = bf_lo(kr.w); kf[7] = bf_hi(kr.w);
            float ss = 0.f;
#pragma unroll
            for (int e = 0; e < 8; ++e) ss += kf[e] * kf[e];
            ss += shx(ss, 1, lane); ss += shx(ss, 2, lane); ss += shx(ss, 4, lane);
            const float rs = rsqrtf(ss * (1.0f / 64.0f) + 1e-6f);
            const f32x4 g0 = *(const f32x4*)(kn + dc * 8), g1 = *(const f32x4*)(kn + dc * 8 + 4);
            u32x4 ko;
            ko.x = pk2(kf[0] * rs * g0.x, kf[1] * rs * g0.y); ko.y = pk2(kf[2] * rs * g0.z, kf[3] * rs * g0.w);
            ko.z = pk2(kf[4] * rs * g1.x, kf[5] * rs * g1.y); ko.w = pk2(kf[6] * rs * g1.z, kf[7] * rs * g1.w);
            *(u32x4*)(Ks + key * 72 + dc * 8) = ko;
            u16* vd = Vt + (dc * 8) * 260 + key;
            vd[0 * 260] = (u16)(vr.x & 0xffff); vd[1 * 260] = (u16)(vr.x >> 16); vd[2 * 260] = (u16)(vr.y & 0xffff); vd[3 * 260] = (u16)(vr.y >> 16);
            vd[4 * 260] = (u16)(vr.z & 0xffff); vd[5 * 260] = (u16)(vr.z >> 16); vd[6 * 260] = (u16)(vr.w & 0xffff); vd[7 * 260] = (u16)(vr.w >> 16);
        }
        __syncthreads();
        const float slope2 = exp2f(-(float)(h + 1)) * L2E, sink2 = sinks[h] * L2E;
#pragma unroll 1
        for (int qt = 0; qt < 2; ++qt) {
            const int i0 = qhalf * 64 + qt * 32;
            const int qtok = tok0 + i0 + r;
            bf16x8 qf[4];
            {
                u32x4 qr[4]; float ss = 0.f;
#pragma unroll
                for (int s = 0; s < 4; ++s) qr[s] = qn_[s];
                if (qt == 0) {
#pragma unroll
                    for (int s = 0; s < 4; ++s) qn_[s] = *(const u32x4*)(Qg + (size_t)(qtok + 32) * 512 + h * 64 + 16 * s + 8 * hh);
                }
#pragma unroll
                for (int s = 0; s < 4; ++s) {
                    const float a0 = bf_lo(qr[s].x), a1 = bf_hi(qr[s].x), a2 = bf_lo(qr[s].y), a3 = bf_hi(qr[s].y), a4 = bf_lo(qr[s].z), a5 = bf_hi(qr[s].z), a6 = bf_lo(qr[s].w), a7 = bf_hi(qr[s].w);
                    ss += a0 * a0 + a1 * a1 + a2 * a2 + a3 * a3 + a4 * a4 + a5 * a5 + a6 * a6 + a7 * a7;
                }
                ss += shx(ss, 32, lane);
                const float rs = rsqrtf(ss * (1.0f / 64.0f) + 1e-6f) * (0.125f * L2E);
#pragma unroll
                for (int s = 0; s < 4; ++s) {
                    const f32x4 g0 = *(const f32x4*)(qn + 16 * s + 8 * hh), g1 = *(const f32x4*)(qn + 16 * s + 8 * hh + 4);
                    u32x4 o;
                    o.x = pk2(bf_lo(qr[s].x) * rs * g0.x, bf_hi(qr[s].x) * rs * g0.y); o.y = pk2(bf_lo(qr[s].y) * rs * g0.z, bf_hi(qr[s].y) * rs * g0.w);
                    o.z = pk2(bf_lo(qr[s].z) * rs * g1.x, bf_hi(qr[s].z) * rs * g1.y); o.w = pk2(bf_lo(qr[s].w) * rs * g1.z, bf_hi(qr[s].w) * rs * g1.w);
                    qf[s] = __builtin_bit_cast(bf16x8, o);
                }
            }
            const int kt0 = i0 >> 5;
            const int qi = i0 + r;
            const int dbase = qi + 128 - kt0 * 32 - 4 * hh;
            const int maxd = nb > 0 ? 127 : (qi < 127 ? qi : 127);
            const float A = -slope2 * (float)dbase;
            f32x16 o[2];
#pragma unroll
            for (int db = 0; db < 2; ++db)
#pragma unroll
                for (int e = 0; e < 16; ++e) o[db][e] = 0.f;
            float m = sink2, l = 0.f;
#pragma unroll
            for (int kr2 = 0; kr2 < 5; ++kr2) {
                const int kt = 4 - kr2;
                if (nb == 0 && kt0 + kt < 4) continue;
                f32x16 sc;
#pragma unroll
                for (int e = 0; e < 16; ++e) sc[e] = 0.f;
#pragma unroll
                for (int s = 0; s < 4; ++s) {
                    const bf16x8 kfr = *(const bf16x8*)(Ks + ((kt0 + kt) * 32 + r) * 72 + 16 * s + 8 * hh);
                    sc = mfma32(kfr, qf[s], sc);
                }
                float tm = -1e30f;
#pragma unroll
                for (int e = 0; e < 16; ++e) {
                    const int ce = 32 * kt + (e & 3) + 8 * (e >> 2);
                    float t = fmaf(slope2, (float)ce, sc[e]);
                    if (kt == 0 || kt == 4) { const int dist = dbase - ce; t = ((unsigned)dist <= (unsigned)maxd) ? t : -1e30f; }
                    sc[e] = t; tm = fmaxf(tm, t);
                }
                tm += A;
                tm = fmaxf(tm, shx(tm, 32, lane));
                if (__ballot(tm > m) != 0ull) {
                    const float mn = fmaxf(m, tm), alpha = __builtin_amdgcn_exp2f(m - mn);
                    m = mn; l *= alpha;
#pragma unroll
                    for (int db = 0; db < 2; ++db)
#pragma unroll
                        for (int e = 0; e < 16; ++e) o[db][e] *= alpha;
                }
                const float c0 = A - m;
                float ls = 0.f;
#pragma unroll
                for (int e = 0; e < 16; ++e) { const float pv = __builtin_amdgcn_exp2f(sc[e] + c0); sc[e] = pv; ls += pv; }
                l += ls;
#pragma unroll
                for (int s2 = 0; s2 < 2; ++s2) {
                    u32x4 pp;
                    pp.x = pk2(sc[8 * s2 + 0], sc[8 * s2 + 1]); pp.y = pk2(sc[8 * s2 + 2], sc[8 * s2 + 3]);
                    pp.z = pk2(sc[8 * s2 + 4], sc[8 * s2 + 5]); pp.w = pk2(sc[8 * s2 + 6], sc[8 * s2 + 7]);
                    const bf16x8 pf = __builtin_bit_cast(bf16x8, pp);
                    const int kb = (kt0 + kt) * 32 + 16 * s2 + 4 * hh;
#pragma unroll
                    for (int db = 0; db < 2; ++db) {
                        const u16* vp = Vt + (db * 32 + r) * 260 + kb;
                        const s16x4 lo = *(const s16x4*)vp, hi = *(const s16x4*)(vp + 8);
                        const bf16x8 vf = __builtin_shufflevector(lo, hi, 0, 1, 2, 3, 4, 5, 6, 7);
                        o[db] = mfma32(vf, pf, o[db]);
                    }
                }
                asm volatile("" ::: "memory");
            }
            l += shx(l, 32, lane);
            l += __builtin_amdgcn_exp2f(sink2 - m);
            const float inv = __builtin_amdgcn_rcpf(l);
#pragma unroll
            for (int db = 0; db < 2; ++db)
#pragma unroll
                for (int q4 = 0; q4 < 4; ++q4) {
                    const int d = db * 32 + 8 * q4 + 4 * hh;
                    u32x2 ov; ov.x = pk2(o[db][4 * q4] * inv, o[db][4 * q4 + 1] * inv); ov.y = pk2(o[db][4 * q4 + 2] * inv, o[db][4 * q4 + 3] * inv);
                    *(u32x2*)(YA + (size_t)qtok * 512 + h * 64 + d) = ov;
                }
        }
        __syncthreads();
        if (L == 0) prep_from_queue(p, lds, PREP0_PER_UNIT, 0, PREP0_FIRST);
    }
    if (L == 0) prep_from_queue(p, lds, 1 << 30, 0, PREP0_FIRST);
}

DI void route_token(const float (&lg)[20], int& bucket, float& w0, float& w1) {
    int gi = 0; float gm = lg[0];
#pragma unroll
    for (int j = 1; j < 4; ++j) if (lg[j] > gm) { gm = lg[j]; gi = j; }
    float den = 0.f;
#pragma unroll
    for (int j = 0; j < 4; ++j) den += __expf(lg[j] - gm);
    const float gp = 1.0f / den;
    float f[4];
#pragma unroll
    for (int j = 0; j < 4; ++j) f[j] = gi == 0 ? lg[4 + j] : (gi == 1 ? lg[8 + j] : (gi == 2 ? lg[12 + j] : lg[16 + j]));
    int i1 = 0; float v1 = f[0];
#pragma unroll
    for (int j = 1; j < 4; ++j) if (f[j] > v1) { v1 = f[j]; i1 = j; }
    int i2 = -1; float v2 = -3.0e38f;
#pragma unroll
    for (int j = 0; j < 4; ++j) if (j != i1 && f[j] > v2) { v2 = f[j]; i2 = j; }
    const float e2 = __expf(v2 - v1);
    const float p1 = gp / (1.0f + e2), p2 = gp * e2 / (1.0f + e2);
    const int a = i1 < i2 ? i1 : i2, b = i1 < i2 ? i2 : i1;
    const int pidx = a == 0 ? b - 1 : (a == 1 ? b + 1 : 5);
    bucket = gi * 6 + pidx;
    w0 = i1 < i2 ? p1 : p2; w1 = i1 < i2 ? p2 : p1;
}

constexpr int RW_ROW = 1024 + 8;
DI void phase_router(const Params& p, const int L, char* lds) {
    u16* Wh = (u16*)lds;
    u16* Wl = Wh + 21 * RW_ROW;
    float* lgs = (float*)(Wl + 21 * RW_ROW);
    int* hist = (int*)(lgs + 8 * 16 * 24);
    const u32x4* WRI = (const u32x4*)(opq(p.ws) + OFF_WR);
    const u16* X = (const u16*)(opq(p.ws) + OFF_R1);
    float* rstd2 = (float*)(opq(p.ws) + OFF_RSTD2);
    int* perm2 = (int*)(opq(p.ws) + OFF_PERM2);
    float* rw = (float*)(opq(p.ws) + OFF_RW);
    unsigned* gcnt = (unsigned*)(opq(p.ws) + OFF_MOEQ) + L * 256 + 16;
    const int tid = TID(), lane = tid & 63, w = tid >> 6, fr = lane & 15, fq = lane >> 4;
    if (BID() >= 256) return;
    for (int i = tid; i < 42 * 128; i += NTHR) { const int row = i >> 7, ch = i & 127; *(u32x4*)(Wh + row * RW_ROW + ch * 8) = WRI[i]; }
    for (int rb = BID(); rb < 256; rb += gridDim.x) {
        if (tid < 24) hist[tid] = 0;
        __syncthreads();
        const int tok = rb * 128 + w * 16 + fr;
        const u16* xr = X + (size_t)tok * DM + 8 * fq;
        const int n1 = fr < 4 ? 16 + fr : 20;
        f32x4 a0 = {0.f, 0.f, 0.f, 0.f}, a1 = {0.f, 0.f, 0.f, 0.f};
        float ssq = 0.f;
        u32x4 xq[2][8];
#pragma unroll
        for (int s = 0; s < 8; ++s) xq[0][s] = *(const u32x4*)(xr + s * 32);
#pragma unroll
        for (int kc = 0; kc < 4; ++kc) {
            u32x4 (&xa)[8] = xq[kc & 1];
            if (kc < 3) {
#pragma unroll
                for (int s = 0; s < 8; ++s) xq[(kc + 1) & 1][s] = *(const u32x4*)(xr + ((kc + 1) * 8 + s) * 32);
            }
#pragma unroll
            for (int s = 0; s < 8; ++s) {
                const int ks = kc * 8 + s;
                const f32x4 va = unp_lo(xa[s]), vb = unp_hi(xa[s]);
                ssq += va.x * va.x + va.y * va.y + va.z * va.z + va.w * va.w + vb.x * vb.x + vb.y * vb.y + vb.z * vb.z + vb.w * vb.w;
                const bf16x8 xh = __builtin_bit_cast(bf16x8, xa[s]);
                const bf16x8 wh0 = *(const bf16x8*)(Wh + fr * RW_ROW + ks * 32 + fq * 8), wl0 = *(const bf16x8*)(Wl + fr * RW_ROW + ks * 32 + fq * 8);
                const bf16x8 wh1 = *(const bf16x8*)(Wh + n1 * RW_ROW + ks * 32 + fq * 8), wl1 = *(const bf16x8*)(Wl + n1 * RW_ROW + ks * 32 + fq * 8);
                a0 = mfma16(wh0, xh, a0); a0 = mfma16(wl0, xh, a0);
                a1 = mfma16(wh1, xh, a1); a1 = mfma16(wl1, xh, a1);
            }
        }
        ssq += shx(ssq, 16, lane); ssq += shx(ssq, 32, lane);
        float* lg = lgs + (w * 16 + fr) * 24;
        *(f32x4*)(lg + 4 * fq) = a0;
        if (fq == 0) *(f32x4*)(lg + 16) = a1;
        __syncthreads();
        int mybk = 0, myrank = 0;
        if (lane < 16) {
            const float rs = rsqrtf(ssq * (1.0f / DM) + 1e-6f);
            float l20[20];
#pragma unroll
            for (int n = 0; n < 20; ++n) l20[n] = lg[n] * rs;
            int bk; float w0, w1;
            route_token(l20, bk, w0, w1);
            rstd2[tok] = rs; rw[tok * 2] = w0; rw[tok * 2 + 1] = w1;
            mybk = bk; myrank = atomicAdd(&hist[bk], 1);
        }
        __syncthreads();
        if (tid < 24) { const int c = hist[tid]; hist[32 + tid] = c > 0 ? (int)__hip_atomic_fetch_add(gcnt + tid, (unsigned)c, __ATOMIC_RELAXED, __HIP_MEMORY_SCOPE_AGENT) : 0; }
        __syncthreads();
        if (lane < 16) perm2[(size_t)mybk * 32768 + hist[32 + mybk] + myrank] = tok;
        __syncthreads();
    }
}

template <int MODE> DI JobInProjT<MODE> mk_inproj(const Params& p, const int L) { JobInProjT<MODE> j; char* w = opq(p.ws); j.A = w + OFF_R1; j.B = w + (size_t)L * WSET + OFF_WIN; j.ssq4 = (const float*)(w + OFF_SSQ4); j.A2 = (u16*)(w + OFF_A2); j.ws = w; return j; }
DI JobS5G1 mk_g1(const Params& p, const int L) { JobS5G1 j; j.A2 = opq(p.ws) + OFF_A2; j.W1 = opq(p.ws) + (size_t)L * WSET + OFF_W1T; j.Sloc = (float*)(opq(p.ws) + OFF_SLOC); return j; }
DI JobS5G2 mk_g2(const Params& p, const int L) { JobS5G2 j; j.A2 = opq(p.ws) + OFF_A2; j.W2 = opq(p.ws) + (size_t)L * WSET + OFF_W2T; j.Zp = (u16*)(opq(p.ws) + OFF_Z); return j; }
DI JobGLU mk_glu(const Params& p, const int L) { JobGLU j; j.Zp = opq(p.ws) + OFF_Z; j.B = opq(p.ws) + (size_t)L * WSET + OFF_WGLU; j.SGS = (const unsigned char*)(opq(p.ws) + OFF_SGS8); j.PA = (const u16*)(opq(p.ws) + pa_off(L)); j.MS = (u16*)(opq(p.ws) + OFF_R2); return j; }
DI JobAttnUp mk_attnup(const Params& p, const int L) { JobAttnUp j; j.A = opq(p.ws) + OFF_YA; j.B = opq(p.ws) + (size_t)L * WSET + OFF_WATT; j.SGA = (const unsigned char*)(opq(p.ws) + OFF_SGA8); j.PA = (u16*)(opq(p.ws) + pa_off(L)); return j; }
DI JobOut mk_out(const Params& p, const int L) { JobOut j; j.A = opq(p.ws) + OFF_R2; j.B = opq(p.ws) + (size_t)L * WSET + OFF_WOUT; j.XB = (u16*)(opq(p.ws) + OFF_R1); return j; }
DI JobMoeUp mk_moeup(const Params& p, const int L, char* lds) { JobMoeUp j; j.tb = (const PG_LAS int*)((PG_LAS char*)lds + MOE_TB_OFF); j.XB2 = opq(p.ws) + OFF_R1; j.WUP = opq(p.ws) + (size_t)L * WSET + OFF_WUP; j.perm = (const int*)(opq(p.ws) + OFF_PERM2); j.rstd2 = (const float*)(opq(p.ws) + OFF_RSTD2); j.rw = (const float*)(opq(p.ws) + OFF_RW); j.ACT = (u16*)(opq(p.ws) + OFF_R3); return j; }
DI JobMoeDown mk_moedown(const Params& p, const int L, char* lds) { JobMoeDown j; j.tb = (const PG_LAS int*)((PG_LAS char*)lds + MOE_TB_OFF); j.ACT = opq(p.ws) + OFF_R3; j.WDN = opq(p.ws) + (size_t)L * WSET + OFF_WDN; j.perm = (const int*)(opq(p.ws) + OFF_PERM2); j.XB = (u16*)(opq(p.ws) + OFF_R1); j.OUT = opq(p.out); j.ssq4 = (float*)(opq(p.ws) + OFF_SSQ4); j.last = L == 1; return j; }


#define XB_TMO      128
#define XB_XCNT(j)  (256  + 64 * (j))
#define XB_XSUB(j)  (1280 + 64 * (j))
#define XB_XGEN(j)  (2304 + 64 * (j))
#define XB_TOP      3328
#define XB_TOPGEN   3392
#define XB_SPIN_CAP (1u << 18)
DI unsigned xb_ld(unsigned* p)              { return __hip_atomic_load(p, __ATOMIC_RELAXED, __HIP_MEMORY_SCOPE_AGENT); }
DI unsigned xb_add(unsigned* p, unsigned v) { return __hip_atomic_fetch_add(p, v, __ATOMIC_RELAXED, __HIP_MEMORY_SCOPE_AGENT); }
DI unsigned xb_xcc_id() { return (unsigned)__builtin_amdgcn_s_getreg((3 << 11) | 20) & 0xFu; }
#define XB_SPIN(cond, bar) do { unsigned _sp = 0; while (cond) { __builtin_amdgcn_s_sleep(1); \
    if ((++_sp & 255u) == 0u) { if (xb_ld(&(bar)[XB_TMO])) break; if (_sp > XB_SPIN_CAP) { atomicAdd(&(bar)[XB_TMO], 1u); break; } } } } while (0)
struct XcdBarrier { unsigned* bar; unsigned x; volatile PG_LAS unsigned* st; };
DI XcdBarrier xcd_barrier_post(unsigned* bar, volatile PG_LAS unsigned* st) {
    XcdBarrier b; b.bar = bar; b.x = xb_xcc_id(); b.st = st;
    if (threadIdx.x == 0) (void)xb_add(&bar[XB_XCNT(b.x)], 1u);
    return b;
}
DI void xcd_barrier_complete(unsigned* bar, unsigned x, unsigned& nloc, unsigned& nx) {
    const unsigned G = gridDim.x * gridDim.y * gridDim.z;
    unsigned sum, cnt, mine, sp = 0u;
    for (;;) {
        sum = 0u; cnt = 0u; mine = 0u;
#pragma unroll
        for (unsigned j = 0; j < 16; ++j) { const unsigned c = xb_ld(&bar[XB_XCNT(j)]); sum += c; cnt += (c > 0u) ? 1u : 0u; mine = (j == x) ? c : mine; }
        if (sum == G) break;
        __builtin_amdgcn_s_sleep(1);
        if ((++sp & 255u) == 0u) { if (xb_ld(&bar[XB_TMO])) break; if (sp > XB_SPIN_CAP) { atomicAdd(&bar[XB_TMO], 1u); break; } }
    }
    nloc = mine > 0u ? mine : 1u; nx = cnt > 0u ? cnt : 1u;
}
DI void xcd_barrier(const XcdBarrier& b) {
    asm volatile("s_waitcnt vmcnt(0)" ::: "memory");
    __syncthreads();
    if (threadIdx.x == 0) {
        unsigned* bar = opq(b.bar);
        __builtin_amdgcn_s_waitcnt(0);
        asm volatile("buffer_inv sc1" ::: "memory");
        unsigned nloc = b.st[0], nx = b.st[1];
        if (nloc == 0u) { xcd_barrier_complete(bar, b.x, nloc, nx); b.st[0] = nloc; b.st[1] = nx; }
        const unsigned old = xb_add(&bar[XB_XSUB(b.x)], 1u);
        const unsigned gen = old / nloc;
        if (old + 1u == (gen + 1u) * nloc) {
            __builtin_amdgcn_fence(__ATOMIC_RELEASE, "agent");
            asm volatile("s_waitcnt vmcnt(0)" ::: "memory");
            const unsigned og = xb_add(&bar[XB_TOP], 1u);
            const unsigned tg = og / nx;
            if (og + 1u == (tg + 1u) * nx) xb_add(&bar[XB_TOPGEN], 1u);
            else XB_SPIN(xb_ld(&bar[XB_TOPGEN]) == tg, bar);
            asm volatile("s_waitcnt vmcnt(0)" ::: "memory");
        } else {
            XB_SPIN(xb_ld(&bar[XB_TOPGEN]) == gen, bar);
            asm volatile("s_waitcnt vmcnt(0)" ::: "memory");
        }
    }
    __syncthreads();
}


DI void phase_moe(const Params& p, const int L, char* lds) {
    unsigned* q = (unsigned*)(opq(p.ws) + OFF_MOEQ) + L * 256;
    unsigned* flag = q + 64;
    int* qslot = (int*)(lds + 163840 - 128);
    {
        PG_LAS int* tb = (PG_LAS int*)((PG_LAS char*)lds + MOE_TB_OFF);
        const int t24 = TID();
        if (t24 < 24) tb[32 + t24] = (int)__hip_atomic_load(q + 16 + t24, __ATOMIC_RELAXED, __HIP_MEMORY_SCOPE_AGENT);
        __syncthreads();
        if (threadIdx.x == 0) { int b = 0; for (int t = 0; t < 24; ++t) { tb[t] = b; b += ((tb[32 + t] + TM - 1) / TM) * TM; } tb[24] = b; }
        __syncthreads();
    }
    const JobMoeUp ju = mk_moeup(p, L, lds);
    const JobMoeDown jd = mk_moedown(p, L, lds);
    const int tiles = ju.num_units() >> 2, per = (tiles + 7) >> 3;
    const int myx = (int)((unsigned)__builtin_amdgcn_s_getreg((3 << 11) | 20) & 7u);
    int probe = 0, prev = -1;
    for (;;) {
        asm volatile("s_waitcnt vmcnt(0)" ::: "memory");
        __syncthreads();
        if (threadIdx.x == 0) {
            if (prev >= 0) (void)__hip_atomic_fetch_add(flag + prev, 1u, __ATOMIC_RELAXED, __HIP_MEMORY_SCOPE_AGENT);
            int r = -1;
            while (probe < 8) {
                const int x = (myx + probe) & 7, t0 = x * per;
                int ntx = tiles - t0; ntx = ntx > per ? per : ntx;
                if (ntx > 0) {
                    const int k = (int)__hip_atomic_fetch_add(q + 8 + x, 1u, __ATOMIC_RELAXED, __HIP_MEMORY_SCOPE_AGENT);
                    if (k < 8 * ntx) { r = k < 4 * ntx ? t0 * 4 + k : ((1 << 20) | (t0 * 4 + k - 4 * ntx)); break; }
                }
                ++probe;
            }
            *qslot = r;
        }
        __syncthreads();
        const int r = __builtin_amdgcn_readfirstlane(*qslot);
        __syncthreads();
        if (r < 0) break;
        if (r < (1 << 20)) {
            pg_gemm_seq(ju, lds, r, 1 << 30, r + 1);
            prev = r >> 2;
        } else {
            const int d = r & 0xfffff;
            prev = -1;
            if (__builtin_amdgcn_readfirstlane((int)threadIdx.x >> 6) == 0) {
                unsigned sp = 0;
                while ((unsigned)__builtin_amdgcn_readfirstlane((int)__hip_atomic_load(flag + (d >> 2), __ATOMIC_RELAXED, __HIP_MEMORY_SCOPE_AGENT)) < 4u) { __builtin_amdgcn_s_sleep(2); if (++sp > (1u << 16)) break; }
                __builtin_amdgcn_fence(__ATOMIC_ACQUIRE, "agent");
                asm volatile("s_waitcnt vmcnt(0)" ::: "memory");
            }
            __syncthreads();
            pg_gemm_seq(jd, lds, d, 1 << 30, d + 1);
        }
    }
}

extern __shared__ __attribute__((aligned(16))) char smem[];
namespace cg = cooperative_groups;
constexpr int MEGA_LDS = 163840;
constexpr size_t WS_NEED = OFF_BAR + CTL_BYTES;
__global__ void __launch_bounds__(NTHR) k_mega(const Params p) {
    cg::grid_group grid = cg::this_grid();
    volatile PG_LAS unsigned* st = (volatile PG_LAS unsigned*)((PG_LAS unsigned char*)smem + 163840 - 64);
    if (threadIdx.x < 4) st[threadIdx.x] = 0u;
    __syncthreads();
    const XcdBarrier xb = xcd_barrier_post((unsigned*)(opq(p.ws) + OFF_BAR), st);
#define GSYNC() xcd_barrier(xb)
    for (int L = 0; L < 2; ++L) {
        if (L == 0) {
            {
                const int ord = __builtin_amdgcn_readfirstlane((BID() >> 3) & 1);
#pragma unroll 1
                for (int s2 = 0; s2 < 2; ++s2) { if (s2 == ord) phase_prep(p, 0, smem); else phase_xb(p); }
            }
            if (p.ws == nullptr) grid.sync();
            GSYNC();
        }
        for (int rep = 0; rep < REP_INPROJ; ++rep) pg_gemm(mk_inproj<0>(p, L), smem);
        GSYNC();
        pg_gemm(mk_g1(p, L), smem);
        if (BID() < 128) { const UnitG ug = mk_g1(p, L).unit(BID()); scan_local(p, ug.g, ug.m0 >> 6); }
        if (BID() >= 128) pg_gemm(mk_inproj<1>(p, L), smem);
        for (int rep = 0; rep < REP_ATTN; ++rep) phase_attn(p, L, smem);
        GSYNC();
        for (int rep = 0; rep < REP_G2; ++rep) pg_gemm(mk_g2(p, L), smem);
        pg_gemm(mk_attnup(p, L), smem);
        GSYNC();
        for (int rep = 0; rep < REP_GLU; ++rep) pg_gemm(mk_glu(p, L), smem);
        GSYNC();
        for (int rep = 0; rep < (L == 0 ? REP_OUT0 : 1); ++rep) pg_gemm(mk_out(p, L), smem);
        GSYNC();
        for (int rep = 0; rep < REP_ROUTER; ++rep) phase_router(p, L, smem);
        GSYNC();
        phase_moe(p, L, smem);
        if (L == 0) { prep_from_queue(p, smem, 1 << 30, 1, 0); GSYNC(); }
    }
#undef GSYNC
}

extern "C" void kernel_launch(void* const* d_in, const int* in_sizes, int n_in, void* d_out, int out_size, void* d_ws, size_t ws_size, hipStream_t stream) {
    static int grid_blocks = 0;
    if (!grid_blocks) {
        int dev = 0, cus = 0, per_cu = 0;
        (void)hipGetDevice(&dev);
        (void)hipDeviceGetAttribute(&cus, hipDeviceAttributeMultiprocessorCount, dev);
        (void)hipFuncSetAttribute((const void*)k_mega, hipFuncAttributeMaxDynamicSharedMemorySize, MEGA_LDS);
        (void)hipOccupancyMaxActiveBlocksPerMultiprocessor(&per_cu, (const void*)k_mega, NTHR, MEGA_LDS);
        if (per_cu < 1) per_cu = 1;
        if (per_cu > 1) per_cu = 1;
        grid_blocks = cus * per_cu;
    }
    if (n_in != 23 || ws_size < WS_NEED || out_size != NTOK * DM) { fprintf(stderr, "kernel_launch: unexpected shapes (n_in %d ws %zu out %d)\n", n_in, ws_size, out_size); return; }
    Params p{};
    for (int i = 0; i < 23; ++i) p.in[i] = (const float*)d_in[i];
    p.out = (float*)d_out; p.ws = (char*)d_ws;
    (void)hipMemsetAsync((char*)d_ws + OFF_BAR, 0, CTL_BYTES, stream);
    void* args[] = {&p};
    hipError_t e = hipLaunchCooperativeKernel((const void*)k_mega, dim3(grid_blocks), dim3(NTHR), args, MEGA_LDS, stream);
    if (e != hipSuccess) fprintf(stderr, "cooperative launch failed: %s (grid %d)\n", hipGetErrorString(e), grid_blocks);
}
```

```cpp
#include <hip/hip_runtime.h>
#include <hip/hip_cooperative_groups.h>
#include <stdint.h>
#include <stdio.h>

#define DI __device__ __forceinline__
typedef unsigned short u16;
typedef short bf16x8 __attribute__((ext_vector_type(8)));
typedef short s16x4 __attribute__((ext_vector_type(4)));
typedef float f32x4 __attribute__((ext_vector_type(4)));
typedef float f32x2 __attribute__((ext_vector_type(2)));
typedef float f32x16 __attribute__((ext_vector_type(16)));
typedef unsigned u32x4 __attribute__((ext_vector_type(4)));
typedef unsigned u32x2 __attribute__((ext_vector_type(2)));
typedef __bf16 bf2_t __attribute__((ext_vector_type(2)));

constexpr int NTOK = 32768, DM = 1024, SEQ = 2048, NBATCH = 16, INC = 3328;
constexpr int TCH = 32, NCH = SEQ / TCH, S5M = NBATCH * NCH, S5K1 = TCH * 16, S5K2 = S5K1 + 128;
constexpr int TM = 256;
constexpr int MAXTILES = (NTOK + 24 * (TM - 1)) / TM + 1;
constexpr int NTHR = 512;
constexpr int LDS_BYTES = 98304;

#ifndef REP_PREP
#define REP_PREP 1
#endif
#ifndef REP_XB
#define REP_XB 1
#endif
#ifndef REP_ATTN
#define REP_ATTN 1
#endif
#ifndef REP_ROUTER
#define REP_ROUTER 1
#endif
#ifndef REP_INPROJ
#define REP_INPROJ 1
#endif
#ifndef REP_GLU
#define REP_GLU 1
#endif
#ifndef REP_MOEUP
#define REP_MOEUP 1
#endif
#ifndef REP_OUT0
#define REP_OUT0 1
#endif
#ifndef REP_EPI
#define REP_EPI 1
#endif
#ifndef REP_KLOOP
#define REP_KLOOP 1
#endif
#ifndef REP_G2
#define REP_G2 1
#endif
constexpr size_t MiB = 1u << 20;
constexpr size_t OFF_R1 = 0;
constexpr size_t OFF_R2 = 64 * MiB;
constexpr size_t OFF_R3 = 128 * MiB;
constexpr size_t OFF_A2 = 192 * MiB;
constexpr size_t OFF_Q = 232 * MiB;
constexpr size_t OFF_KV = 264 * MiB;
constexpr size_t OFF_SLOC = 280 * MiB;
constexpr size_t OFF_Z = OFF_Q;
constexpr size_t OFF_YA = 296 * MiB;
constexpr size_t WSET = 80 * MiB;
constexpr size_t OFF_WIN = 328 * MiB;
constexpr size_t OFF_WGLU = OFF_WIN + 7 * MiB;
constexpr size_t OFF_WATT = OFF_WGLU + 2 * MiB;
constexpr size_t OFF_WOUT = OFF_WATT + 1 * MiB;
constexpr size_t OFF_WUP = OFF_WOUT + 2 * MiB;
constexpr size_t OFF_WDN = OFF_WUP + 16 * MiB;
DI size_t pa_off(const int L) { return OFF_WIN + (size_t)(1 - L) * WSET; }
constexpr size_t OFF_W1T = OFF_WDN + 24 * MiB;
constexpr size_t OFF_W2T = OFF_W1T + 8 * MiB;
constexpr size_t OFF_SMALL = OFF_WIN + 2 * WSET;
constexpr size_t OFF_WR = OFF_SMALL;
constexpr size_t OFF_LT = OFF_WR + 128 * 1024;
constexpr size_t OFF_RSTD1 = OFF_LT + 64 * 1024;
constexpr size_t OFF_RSTD2 = OFF_RSTD1 + 128 * 1024;
constexpr size_t OFF_BUCKET = OFF_RSTD2 + 128 * 1024;
constexpr size_t OFF_RW = OFF_BUCKET + 128 * 1024;
constexpr size_t OFF_PERM = OFF_RW + 256 * 1024;
constexpr size_t OFF_CNT = OFF_PERM + 256 * 1024;
constexpr size_t OFF_TILEB = OFF_CNT + 32 * 1024;
constexpr size_t OFF_META = OFF_TILEB + 4 * 1024;
constexpr size_t OFF_SSQ4 = OFF_META + 1024;
constexpr size_t OFF_PERM2 = OFF_SSQ4 + 512 * 1024;
constexpr size_t WS_END = OFF_PERM2 + (size_t)24 * 32768 * 4;
constexpr size_t OFF_BAR = WS_END;
#define XCD_BAR_WORDS 3456
constexpr size_t OFF_MOEQ = OFF_BAR + XCD_BAR_WORDS * 4;
constexpr size_t CTL_BYTES = XCD_BAR_WORDS * 4 + 2 * 256 * 4;

struct Params {
    const float* in[23];
    float* out;
    char* ws;
};

DI int TID() { int t = threadIdx.x; asm volatile("" : "+v"(t)); return t; }
DI unsigned OZ() { unsigned z = 0; asm volatile("" : "+s"(z)); return z; }
template <class T> DI T* opq(T* x) { unsigned long long v = (unsigned long long)x; asm volatile("" : "+s"(v)); return (T*)(__attribute__((address_space(1))) char*)v; }
DI float shx(float v, int m, int lane) { return __builtin_bit_cast(float, __builtin_amdgcn_ds_bpermute((lane ^ m) << 2, __builtin_bit_cast(int, v))); }
DI const char* uptr(const char* p) { const unsigned long long v = (unsigned long long)p; const unsigned lo = (unsigned)__builtin_amdgcn_readfirstlane((int)(unsigned)v), hi = (unsigned)__builtin_amdgcn_readfirstlane((int)(unsigned)(v >> 32)); return (const char*)(__attribute__((address_space(1))) const char*)(((unsigned long long)hi << 32) | lo); }
DI void st16_sc1(void* p, u32x4 v) { asm volatile("global_store_dwordx4 %0, %1, off sc1\n\ts_nop 1" :: "v"(p), "v"(v) : "memory"); }
DI int BID() { int b = blockIdx.x; asm volatile("" : "+s"(b)); return b; }
DI unsigned pk2(float a, float b) { f32x2 v = {a, b}; bf2_t r = __builtin_convertvector(v, bf2_t); return __builtin_bit_cast(unsigned, r); }
DI float bf_lo(unsigned u) { return __uint_as_float(u << 16); }
DI float bf_hi(unsigned u) { return __uint_as_float(u & 0xffff0000u); }
DI float sigmoidf_(float x) { return __builtin_amdgcn_rcpf(1.0f + __builtin_amdgcn_exp2f(-1.4426950408889634f * x)); }
DI float gelu_tanh(float x) { const float u = 0.7978845608028654f * (x + 0.044715f * x * x * x); return x * __builtin_amdgcn_rcpf(1.0f + __builtin_amdgcn_exp2f(-2.8853900817779268f * u)); }
DI f32x16 mfma32(bf16x8 a, bf16x8 b, f32x16 c) { return __builtin_amdgcn_mfma_f32_32x32x16_bf16(a, b, c, 0, 0, 0); }
DI f32x4 mfma16(bf16x8 a, bf16x8 b, f32x4 c) { return __builtin_amdgcn_mfma_f32_16x16x32_bf16(a, b, c, 0, 0, 0); }

struct TJob { unsigned long long src, dst, scale; int ld_src, ld_dst, dcol0, rmul, radd, k0, n0; };
DI void tconv_load(const TJob& j, int tid, f32x4 (&v)[2]) {
    const float* src = (const float*)(__attribute__((address_space(1))) const char*)j.src;
#pragma unroll
    for (int i = 0; i < 2; ++i) v[i] = *(const f32x4*)(src + (size_t)(j.k0 + (tid >> 4) + 32 * i) * j.ld_src + j.n0 + (tid & 15) * 4);
}
DI void tconv_to_lds(const TJob& j, int tid, const f32x4 (&v)[2], float* sm) {
    const float* scale = (const float*)(__attribute__((address_space(1))) const char*)j.scale;
#pragma unroll
    for (int i = 0; i < 2; ++i) {
        const int k = (tid >> 4) + 32 * i, n = (tid & 15) * 4;
        const float sc = j.scale ? scale[j.k0 + k] : 1.0f;
        sm[(n + 0) * 65 + k] = v[i].x * sc; sm[(n + 1) * 65 + k] = v[i].y * sc; sm[(n + 2) * 65 + k] = v[i].z * sc; sm[(n + 3) * 65 + k] = v[i].w * sc;
    }
}
DI void tconv_store(const TJob& j, int tid, const float* sm) {
    u16* dst = (u16*)(__attribute__((address_space(1))) char*)j.dst;
    const int n = tid >> 3, c = tid & 7;
    const float* s = sm + n * 65 + c * 8;
    u32x4 o; o.x = pk2(s[0], s[1]); o.y = pk2(s[2], s[3]); o.z = pk2(s[4], s[5]); o.w = pk2(s[6], s[7]);
    const int nn = j.n0 + n, drow = j.rmul == 1 ? nn + j.radd : (nn >> 7) * 256 + j.radd + (nn & 127);
    *(u32x4*)(dst + (size_t)drow * j.ld_dst + j.dcol0 + j.k0 + c * 8) = o;
}

constexpr int T_WIN = (1024 / 64) * (INC / 64);
constexpr int T_GLU = 2 * (512 / 64) * (1024 / 64);
constexpr int T_ATT = (512 / 64) * (1024 / 64);
constexpr int T_OUT = (1024 / 64) * (1024 / 64);
constexpr int T_UP = 16 * 2 * (1024 / 64) * (256 / 64);
constexpr int T_DN = 24 * 2 * (256 / 64) * (1024 / 64);
constexpr int T_ALL = T_WIN + T_GLU + T_ATT + T_OUT + T_UP + T_DN;
static_assert(T_ALL % 4 == 0, "tiles are processed four at a time");

DI void pair_experts(int pidx, int& a, int& b) {
    a = pidx < 3 ? 0 : (pidx < 5 ? 1 : 2);
    b = pidx < 3 ? pidx + 1 : (pidx < 5 ? pidx - 1 : 3);
}

DI TJob prep_tjob(const Params& p, const int L, int t) {
    const unsigned long long ws = (unsigned long long)opq(p.ws) + (unsigned long long)L * WSET;
    TJob j; j.scale = 0; j.dcol0 = 0; j.rmul = 1; j.radd = 0;
    if (t < T_WIN) { const int kb = t / (INC / 64), nb = t % (INC / 64);
        j.src = (unsigned long long)(opq(p.in[2]) + (size_t)L * 1024 * INC); j.ld_src = INC; j.dst = ws + OFF_WIN; j.ld_dst = 1024; j.scale = (unsigned long long)(opq(p.in[1]) + L * 1024); j.k0 = kb * 64; j.n0 = nb * 64; return j; }
    t -= T_WIN;
    if (t < T_GLU) { const int half = t / 128, r = t % 128, kb = r / 16, nb = r % 16;
        j.src = (unsigned long long)((half ? opq(p.in[12]) : opq(p.in[11])) + (size_t)L * 512 * 1024); j.ld_src = 1024; j.dst = ws + OFF_WGLU; j.ld_dst = 512; j.rmul = 2; j.radd = half * 128; j.k0 = kb * 64; j.n0 = nb * 64; return j; }
    t -= T_GLU;
    if (t < T_ATT) { const int kb = t / 16, nb = t % 16;
        j.src = (unsigned long long)(opq(p.in[16]) + (size_t)L * 512 * 1024); j.ld_src = 1024; j.dst = ws + OFF_WATT; j.ld_dst = 512; j.k0 = kb * 64; j.n0 = nb * 64; return j; }
    t -= T_ATT;
    if (t < T_OUT) { const int kb = t / 16, nb = t % 16;
        j.src = (unsigned long long)(opq(p.in[17]) + (size_t)L * 1024 * 1024); j.ld_src = 1024; j.dst = ws + OFF_WOUT; j.ld_dst = 1024; j.k0 = kb * 64; j.n0 = nb * 64; return j; }
    t -= T_OUT;
    if (t < T_UP) { const int e = t / 128, r = t % 128, half = r / 64, r2 = r % 64, kb = r2 / 4, nb = r2 % 4;
        j.src = (unsigned long long)(opq(p.in[21]) + ((size_t)(L * 16 + e) * 1024) * 512 + half * 256); j.ld_src = 512; j.dst = ws + OFF_WUP + (size_t)e * 512 * 1024 * 2; j.ld_dst = 1024; j.rmul = 2; j.radd = half * 128;
        j.scale = (unsigned long long)(opq(p.in[18]) + L * 1024); j.k0 = kb * 64; j.n0 = nb * 64; return j; }
    t -= T_UP;
    { const int pr = t / 128, r = t % 128, slot = r / 64, r2 = r % 64, kb = r2 / 16, nb = r2 % 16;
      const int grp = pr / 6; int a, b; pair_experts(pr % 6, a, b); const int e = grp * 4 + (slot ? b : a);
      j.src = (unsigned long long)(opq(p.in[22]) + ((size_t)(L * 16 + e) * 256) * 1024); j.ld_src = 1024; j.dst = ws + OFF_WDN + (size_t)pr * 1024 * 512 * 2; j.ld_dst = 512; j.dcol0 = slot * 256; j.k0 = kb * 64; j.n0 = nb * 64; }
    return j;
}

DI void prep_s5_item(const Params& p, const int L, int item, float* sm) {
    const int tid = TID(), g = item >> 3, s = item & 7;
    float* LBre = sm;
    float* LBim = LBre + 33 * 64;
    float* BBre = LBim + 33 * 64;
    float* BBim = BBre + 1024;
    float* Cre = BBim + 1024;
    float* Cim = Cre + 128;
    float* Kt = Cim + 128;
    const float* lam_re = opq(p.in[3]) + (size_t)(L * 32 + g) * 64;
    const float* lam_im = opq(p.in[4]) + (size_t)(L * 32 + g) * 64;
    const float dt = expf(opq(p.in[5])[L * 32 + g]);
    const float* b_re = opq(p.in[6]) + (size_t)(L * 32 + g) * 1024;
    const float* b_im = opq(p.in[7]) + (size_t)(L * 32 + g) * 1024;
    const float* c_re = opq(p.in[8]) + (size_t)(L * 32 + g) * 1024;
    const float* c_im = opq(p.in[9]) + (size_t)(L * 32 + g) * 1024;
    const float* dsk = opq(p.in[10]) + L * 512 + g * 16;
    for (int i = tid; i < 33 * 64; i += NTHR) {
        const int lag = i >> 6, pp = i & 63;
        const float mag = expf(lam_re[pp] * dt * (float)lag);
        double a = (double)lam_im[pp] * (double)dt * (double)lag;
        a -= 6.283185307179586476925 * rint(a * 0.15915494309189533577);
        const float af = (float)a;
        LBre[i] = mag * cosf(af); LBim[i] = mag * sinf(af);
    }
    if (tid < 128) { Cre[tid] = c_re[(2 * s) * 64 + tid]; Cim[tid] = c_im[(2 * s) * 64 + tid]; }
    for (int i = tid; i < 1024; i += NTHR) {
        const int pp = i >> 4;
        const float lr = lam_re[pp], li = lam_im[pp];
        const float a = lr * dt; const float bb = li * dt;
        double br = (double)bb; br -= 6.283185307179586476925 * rint(br * 0.15915494309189533577);
        const float bf = (float)br;
        const float sh = sinf(0.5f * bf);
        const float xr = expm1f(a) * cosf(bf) - 2.0f * sh * sh;
        const float xi = expf(a) * sinf(bf);
        const float den = 1.0f / (lr * lr + li * li);
        const float fr = (xr * lr + xi * li) * den, fi = (xi * lr - xr * li) * den;
        const float vr = b_re[i], vi = b_im[i];
        BBre[i] = fr * vr - fi * vi; BBim[i] = fr * vi + fi * vr;
    }
    __syncthreads();
    if (s == 0 && tid < 64) { float* LT = (float*)(opq(p.ws) + OFF_LT) + (size_t)(g * 64 + tid) * 2; LT[0] = LBre[32 * 64 + tid]; LT[1] = LBim[32 * 64 + tid]; }
    for (int i = tid; i < 32 * 32; i += NTHR) {
        const int lag = i >> 5, hl = (i >> 4) & 1, hi = i & 15;
        float acc = 0.f;
        for (int pp = 0; pp < 64; ++pp) {
            const float cr = Cre[hl * 64 + pp], ci = Cim[hl * 64 + pp];
            const float lr = LBre[lag * 64 + pp], li = LBim[lag * 64 + pp];
            const float tr = cr * lr - ci * li, ti = cr * li + ci * lr;
            acc += tr * BBre[pp * 16 + hi] - ti * BBim[pp * 16 + hi];
        }
        Kt[i] = acc;
    }
    __syncthreads();
    u16* W1 = (u16*)(opq(p.ws) + (size_t)L * WSET + OFF_W1T) + (size_t)g * 256 * 512;
    for (int i = tid; i < 16 * 256; i += NTHR) {
        const int n = 16 * s + (i >> 8), k = (i & 255) * 2, pp = n >> 1, ri = n & 1, j = k >> 4, hi = k & 15;
        const float lr = LBre[(31 - j) * 64 + pp], li = LBim[(31 - j) * 64 + pp];
        float v[2];
#pragma unroll
        for (int e = 0; e < 2; ++e) { const float br = BBre[pp * 16 + hi + e], bi = BBim[pp * 16 + hi + e]; v[e] = ri ? (lr * bi + li * br) : (lr * br - li * bi); }
        *(unsigned*)(W1 + (size_t)n * 512 + k) = pk2(v[0], v[1]);
    }
    u16* W2 = (u16*)(opq(p.ws) + (size_t)L * WSET + OFF_W2T) + (size_t)g * 512 * 640;
    for (int idx = tid; idx < 64 * 320; idx += NTHR) {
        const int rr = idx / 320, k = (idx % 320) * 2, ii = rr >> 1, hl = rr & 1, ho = 2 * s + hl, n = ii * 16 + ho;
        float v[2];
        if (k < 512) {
            const int j = k >> 4, hi = k & 15;
#pragma unroll
            for (int e = 0; e < 2; ++e) {
                float x = 0.f;
                if (j <= ii) x = Kt[(ii - j) * 32 + hl * 16 + hi + e];
                if (j == ii && hi + e == ho) x += dsk[ho];
                v[e] = x;
            }
        } else {
            const int pp = (k - 512) >> 1;
            const float cr = Cre[hl * 64 + pp], ci = Cim[hl * 64 + pp];
            const float lr = LBre[(ii + 1) * 64 + pp], li = LBim[(ii + 1) * 64 + pp];
            v[0] = cr * lr - ci * li; v[1] = -(cr * li + ci * lr);
        }
        *(unsigned*)(W2 + (size_t)n * 640 + k) = pk2(v[0], v[1]);
    }
    __syncthreads();
}

DI void prep_router_w(const Params& p, const int L) {
    u16* WRH = (u16*)(opq(p.ws) + OFF_WR);
    u16* WRL = WRH + 21 * 1024;
    const float* nf = opq(p.in[18]) + L * 1024;
    const float* wc = opq(p.in[19]) + (size_t)L * 1024 * 4;
    const float* wf = opq(p.in[20]) + (size_t)L * 1024 * 16;
    for (int i = TID(); i < 21 * 1024; i += NTHR) {
        const int n = i >> 10, k = i & 1023;
        const float v = n < 20 ? nf[k] * (n < 4 ? wc[k * 4 + n] : wf[k * 16 + (n - 4)]) : 0.f;
        const unsigned h = pk2(v, 0.f) & 0xffffu;
        const float vh = __uint_as_float(h << 16);
        WRH[i] = (u16)h;
        WRL[i] = (u16)(pk2(v - vh, 0.f) & 0xffffu);
    }
}

DI void phase_prep(const Params& p, const int L, char* lds) {
    float* sm = (float*)lds;
    const int bid = BID(), G = gridDim.x;
    for (int it = bid; it < 257; it += G) {
        if (it < 256) prep_s5_item(p, L, it, sm);
        else prep_router_w(p, L);
    }
    const int tid = TID();
    for (int gi = bid; gi < T_WIN / 4; gi += G) {
        TJob j0 = prep_tjob(p, L, 4 * gi), j1 = prep_tjob(p, L, 4 * gi + 1), j2 = prep_tjob(p, L, 4 * gi + 2), j3 = prep_tjob(p, L, 4 * gi + 3);
        f32x4 v0[2], v1[2], v2[2], v3[2];
        tconv_load(j0, tid, v0); tconv_load(j1, tid, v1); tconv_load(j2, tid, v2); tconv_load(j3, tid, v3);
        tconv_to_lds(j0, tid, v0, sm); tconv_to_lds(j1, tid, v1, sm + 4224); tconv_to_lds(j2, tid, v2, sm + 8448); tconv_to_lds(j3, tid, v3, sm + 12672);
        __syncthreads();
        tconv_store(j0, tid, sm); tconv_store(j1, tid, sm + 4224); tconv_store(j2, tid, sm + 8448); tconv_store(j3, tid, sm + 12672);
        __syncthreads();
    }
}

static_assert(T_ALL % 8 == 0 && T_WIN % 8 == 0, "tiles are processed eight at a time");
constexpr int NPAIR = T_ALL / 8, PAIR0 = T_WIN / 8;
constexpr int PREPQ_ITEMS = 257 + NPAIR, PREPQ_DEFERRED = NPAIR - PAIR0;
DI void prep_pair(const Params& p, const int L, const int pr, float* sm, const int tid) {
    f32x4 v0[2], v1[2], v2[2], v3[2], v4[2], v5[2], v6[2], v7[2];
    const int t0 = 8 * pr;
    tconv_load(prep_tjob(p, L, t0), tid, v0); tconv_load(prep_tjob(p, L, t0 + 1), tid, v1); tconv_load(prep_tjob(p, L, t0 + 2), tid, v2); tconv_load(prep_tjob(p, L, t0 + 3), tid, v3);
    tconv_load(prep_tjob(p, L, t0 + 4), tid, v4); tconv_load(prep_tjob(p, L, t0 + 5), tid, v5); tconv_load(prep_tjob(p, L, t0 + 6), tid, v6); tconv_load(prep_tjob(p, L, t0 + 7), tid, v7);
    tconv_to_lds(prep_tjob(p, L, t0), tid, v0, sm); tconv_to_lds(prep_tjob(p, L, t0 + 1), tid, v1, sm + 4224); tconv_to_lds(prep_tjob(p, L, t0 + 2), tid, v2, sm + 2 * 4224); tconv_to_lds(prep_tjob(p, L, t0 + 3), tid, v3, sm + 3 * 4224);
    tconv_to_lds(prep_tjob(p, L, t0 + 4), tid, v4, sm + 4 * 4224); tconv_to_lds(prep_tjob(p, L, t0 + 5), tid, v5, sm + 5 * 4224); tconv_to_lds(prep_tjob(p, L, t0 + 6), tid, v6, sm + 6 * 4224); tconv_to_lds(prep_tjob(p, L, t0 + 7), tid, v7, sm + 7 * 4224);
    __syncthreads();
#pragma unroll
    for (int k = 0; k < 8; ++k) tconv_store(prep_tjob(p, L, t0 + k), tid, sm + k * 4224);
    __syncthreads();
}
DI void prep_from_queue(const Params& p, char* lds, int budget, const int L, const bool deferred) {
    float* sm = (float*)lds;
    unsigned* qc = (unsigned*)(opq(p.ws) + OFF_BAR) + 12 + L;
    int* qslot = (int*)(lds + 163840 - 256);
    const int tid = TID();
    for (int n = 0; n < budget; ++n) {
        if (threadIdx.x == 0) *qslot = (int)__hip_atomic_fetch_add(qc, 1u, __ATOMIC_RELAXED, __HIP_MEMORY_SCOPE_AGENT);
        __syncthreads();
        const int it = __builtin_amdgcn_readfirstlane(*qslot);
        __syncthreads();
        if (deferred) {
            if (it >= 4 * PREPQ_DEFERRED / 2) break;
            const int gi = 2 * PAIR0 + it;
            TJob j0 = prep_tjob(p, L, 4 * gi), j1 = prep_tjob(p, L, 4 * gi + 1), j2 = prep_tjob(p, L, 4 * gi + 2), j3 = prep_tjob(p, L, 4 * gi + 3);
            f32x4 v0[2], v1[2], v2[2], v3[2];
            tconv_load(j0, tid, v0); tconv_load(j1, tid, v1); tconv_load(j2, tid, v2); tconv_load(j3, tid, v3);
            tconv_to_lds(j0, tid, v0, sm); tconv_to_lds(j1, tid, v1, sm + 4224); tconv_to_lds(j2, tid, v2, sm + 8448); tconv_to_lds(j3, tid, v3, sm + 12672);
            __syncthreads();
            tconv_store(j0, tid, sm); tconv_store(j1, tid, sm + 4224); tconv_store(j2, tid, sm + 8448); tconv_store(j3, tid, sm + 12672);
            __syncthreads();
        } else {
            if (it >= PREPQ_ITEMS) break;
            if (it < 512) { if (it & 1) prep_s5_item(p, L, it >> 1, sm); else prep_pair(p, L, it >> 1, sm, tid); }
            else if (it == 512) prep_router_w(p, L);
            else prep_pair(p, L, 256 + (it - 513), sm, tid);
        }
    }
}

DI void phase_xb(const Params& p) {
    const float* X = opq(p.in[0]);
    u16* XB = (u16*)(opq(p.ws) + OFF_R1);
    float* ssq4 = (float*)(opq(p.ws) + OFF_SSQ4);
    const int tid_ = TID(), lane = tid_ & 63, w = tid_ >> 6;
    for (int row0 = (BID() * 8 + w) * 4; row0 < NTOK; row0 += gridDim.x * 8 * 4) {
        f32x4 v[4][4];
#pragma unroll
        for (int r = 0; r < 4; ++r)
#pragma unroll
            for (int j = 0; j < 4; ++j) v[r][j] = ((const f32x4*)(X + (size_t)(row0 + r) * DM) + lane)[64 * j];
#pragma unroll
        for (int r = 0; r < 4; ++r) {
            const int row = row0 + r; float s = 0.f;
            u32x2* o8 = (u32x2*)(XB + (size_t)row * DM) + lane;
#pragma unroll
            for (int j = 0; j < 4; ++j) { u32x2 q; q.x = pk2(v[r][j].x, v[r][j].y); q.y = pk2(v[r][j].z, v[r][j].w); o8[64 * j] = q;
                const float a = bf_lo(q.x), b = bf_hi(q.x), c = bf_lo(q.y), d = bf_hi(q.y); s += a * a + b * b + c * c + d * d; }
#pragma unroll
            for (int o = 1; o < 64; o <<= 1) s += shx(s, o, lane);
            if (lane == 0) *(f32x4*)(ssq4 + (size_t)row * 4) = (f32x4){s, 0.f, 0.f, 0.f};
        }
    }
}

#define PG_LAS __attribute__((address_space(3)))
constexpr int PG_HTB = 128 * 64 * 2;
constexpr int PG_STAGE_BYTES = 8 * PG_HTB;
DI int pg_lds_byte(int r, int c) { const int st = (r >> 4) * 2 + (c >> 5), rr = r & 15, cc = c & 31, ob = rr * 64 + cc * 2; return st * 1024 + (ob ^ (((ob >> 9) & 1) << 5)); }
DI void pg_stage_rc(int b, int& R, int& C) { const int st = b / 1024, sb = b % 1024, swz = sb ^ (((sb >> 9) & 1) << 5); R = (st >> 1) * 16 + swz / 64; C = (st & 1) * 32 + (swz % 64) / 2; }

constexpr int ST16 = 264;
constexpr int ST16H = 136;
constexpr int ST32 = 260;
DI int rg_row(int rg, int rbase) { return (rg >> 2) * 128 + (rg & 3) * 16 + rbase; }

DI void pg_glds16(unsigned lds_dst, const char* base, unsigned voff) {
    unsigned keep;
    asm volatile("s_mov_b32 %0, m0\n\ts_mov_b32 m0, %1\n\ts_nop 0\n\tglobal_load_lds_dwordx4 %2, %3\n\ts_mov_b32 m0, %0" : "=&s"(keep) : "s"(lds_dst), "v"(voff), "s"(base) : "memory");
}

constexpr unsigned ROWC_OFF = 139264;
template <class J, class = void> struct has_rowdma { static constexpr bool v = false; };
template <class J> struct has_rowdma<J, decltype((void)J::ROWDMA)> { static constexpr bool v = J::ROWDMA; };

template <class J>
DI void pg_gemm_seq(const J& jb, char* lds_, const int u_begin, const int G, const int nu) {
    PG_LAS unsigned char* lds = (PG_LAS unsigned char*)lds_;
    const int tid = TID(), wid = __builtin_amdgcn_readfirstlane(tid >> 6), lane = tid & 63, wr = wid >> 2, wc = wid & 3, fr = lane & 15, fq = lane >> 4;
    const int bid = u_begin;
    const int K = jb.kdim(), nt = K / 64;
    if (bid >= nu) return;
    int Rr[2], Cc[2]; unsigned voffB[2];
#pragma unroll
    for (int i = 0; i < 2; ++i) { pg_stage_rc(tid * 16 + i * 8192, Rr[i], Cc[i]); const int rho = Rr[i] & 31, Rb = (Rr[i] & ~31) + 8 * ((rho & 15) >> 2) + 4 * (rho >> 4) + (rho & 3); voffB[i] = (unsigned)(Rb * K + Cc[i]) * 2u; }
    const size_t kstepA = jb.a_kstep();
    const size_t hstepA = jb.a_hstep();
    const size_t kstepB = 128;
    const size_t hstepB = (size_t)128 * K * 2;
    const unsigned ldsw = (unsigned)wid * 1024u;
    const unsigned ldsb = (unsigned)(size_t)lds;
    const int aoff = pg_lds_byte(wr * 64 + fr, fq * 8), boff = pg_lds_byte(wc * 32 + fr, fq * 8);
#define PG_SA(b, h) ((b) * 65536 + (h) * PG_HTB)
#define PG_SB(b, h) ((b) * 65536 + 32768 + (h) * PG_HTB)
#define PG_STAGE(bufoff, gbase, voff) do { _Pragma("unroll") for (int _i = 0; _i < 2; ++_i) \
        pg_glds16(ldsb + (unsigned)(bufoff) + ldsw + _i * 8192u, (const char*)(gbase), (voff)[_i]); } while (0)
#define PG_STAGE_A(bufoff, gbase, h) do { if constexpr (J::GATHER) { if (h) PG_STAGE(bufoff, gbase, vo1); else PG_STAGE(bufoff, gbase, vo0); } else { PG_STAGE(bufoff, (gbase) + (h) * hstepA, vo0); } } while (0)
#define PG_LDA(dst, b, h) do { _Pragma("unroll") for (int m = 0; m < 4; ++m) _Pragma("unroll") for (int k = 0; k < 2; ++k) dst[m][k] = *(const PG_LAS bf16x8*)(lds + PG_SA(b, h) + aoff + m * 2048 + k * 1024); } while (0)
#define PG_LDB(dst, b, h) do { _Pragma("unroll") for (int n = 0; n < 2; ++n) _Pragma("unroll") for (int k = 0; k < 2; ++k) dst[n][k] = *(const PG_LAS bf16x8*)(lds + PG_SB(b, h) + boff + n * 2048 + k * 1024); } while (0)
#define PG_MMA(ai, bj, At, Bt) do { __builtin_amdgcn_s_setprio(1); _Pragma("unroll") for (int m = 0; m < 4; ++m) _Pragma("unroll") for (int n = 0; n < 2; ++n) _Pragma("unroll") for (int k = 0; k < 2; ++k) \
        acc[ai][bj][m][n] = __builtin_amdgcn_mfma_f32_16x16x32_bf16(Bt[n][k], At[m][k], acc[ai][bj][m][n], 0, 0, 0); __builtin_amdgcn_s_setprio(0); } while (0)
#define PG_WAIT_V(n) asm volatile("s_waitcnt vmcnt(" #n ")" ::: "memory")
#define PG_WAIT_L(n) asm volatile("s_waitcnt lgkmcnt(" #n ")" ::: "memory")
#define PG_BAR __builtin_amdgcn_s_barrier()
#define PG_SCHED __builtin_amdgcn_sched_barrier(0)
    typename J::Unit cur = jb.unit(bid);
    unsigned vo0[2], vo1[2];
#pragma unroll
    for (int i = 0; i < 2; ++i) { vo0[i] = jb.a_off(cur, Rr[i], Cc[i]); vo1[i] = J::GATHER ? jb.a_off(cur, Rr[i] + 128, Cc[i]) : 0u; }
    const char* cA = uptr(jb.a_base(cur)); const char* cB = uptr(jb.b_base(cur));
    int rpar = 0;
    if constexpr (has_rowdma<J>::v) { if (wid < 4) pg_glds16(ldsb + ROWC_OFF + (unsigned)wid * 1024u, uptr(jb.row_base(cur)), (unsigned)tid * 16u); }
    PG_STAGE(PG_SB(0, 0), cB, voffB); PG_STAGE_A(PG_SA(0, 0), cA, 0); PG_STAGE(PG_SB(0, 1), cB + hstepB, voffB); PG_STAGE_A(PG_SA(0, 1), cA, 1);
    for (int uidx = bid;;) {
        if (wr == 1) PG_BAR;
        PG_WAIT_V(4); PG_BAR;
        PG_STAGE(PG_SB(1, 0), cB + kstepB, voffB); PG_STAGE_A(PG_SA(1, 0), cA + kstepA, 0); PG_STAGE(PG_SB(1, 1), cB + hstepB + kstepB, voffB);
        PG_WAIT_V(6); PG_BAR;
        f32x4 acc[2][2][4][2];
#pragma unroll
        for (int a = 0; a < 2; ++a)
#pragma unroll
            for (int b = 0; b < 2; ++b)
#pragma unroll
                for (int m = 0; m < 4; ++m)
#pragma unroll
                    for (int n = 0; n < 2; ++n) acc[a][b][m][n] = (f32x4){0.f, 0.f, 0.f, 0.f};
        bf16x8 At[4][2], B0[2][2], B1[2][2];
        for (int t = 0; t < nt; t += 2) {
            const bool more = (t != nt - 2);
            const char* a1 = cA + (size_t)(t + 1) * kstepA;
            const char* a2 = cA + (size_t)(t + 2) * kstepA; const char* b2 = cB + (size_t)(t + 2) * kstepB;
            const char* a3 = a2 + kstepA; const char* b3 = b2 + kstepB;
            PG_LDB(B0, 0, 0); PG_SCHED; PG_LDA(At, 0, 0); PG_STAGE_A(PG_SA(1, 1), a1, 1);
            PG_WAIT_L(8); PG_BAR; PG_WAIT_L(0); PG_MMA(0, 0, At, B0); PG_BAR; PG_SCHED;
            PG_LDB(B1, 0, 1); if (more) PG_STAGE(PG_SB(0, 0), b2, voffB);
            PG_BAR; PG_WAIT_L(0); PG_MMA(0, 1, At, B1); PG_BAR;
            PG_LDA(At, 0, 1); if (more) PG_STAGE_A(PG_SA(0, 0), a2, 0);
            PG_BAR; PG_WAIT_L(0); PG_MMA(1, 0, At, B0); PG_BAR; PG_SCHED;
            if (more) { PG_STAGE(PG_SB(0, 1), b2 + hstepB, voffB); PG_WAIT_V(6); } else { PG_WAIT_V(0); }
            PG_BAR; PG_MMA(1, 1, At, B1); PG_BAR;
            PG_LDB(B0, 1, 0); PG_SCHED; PG_LDA(At, 1, 0); if (more) PG_STAGE_A(PG_SA(0, 1), a2, 1);
            PG_WAIT_L(8); PG_BAR; PG_WAIT_L(0); PG_MMA(0, 0, At, B0); PG_BAR; PG_SCHED;
            PG_LDB(B1, 1, 1); if (more) PG_STAGE(PG_SB(1, 0), b3, voffB);
            PG_BAR; PG_WAIT_L(0); PG_MMA(0, 1, At, B1); PG_BAR;
            PG_LDA(At, 1, 1); if (more) PG_STAGE_A(PG_SA(1, 0), a3, 0);
            PG_BAR; PG_WAIT_L(0); PG_MMA(1, 0, At, B0); PG_BAR; PG_SCHED;
            if (more) { PG_STAGE(PG_SB(1, 1), b3 + hstepB, voffB); PG_WAIT_V(6); }
            PG_BAR; PG_MMA(1, 1, At, B1); PG_BAR;
        }
        if (wr == 0) PG_BAR;
        PG_BAR;
        const int nidx = uidx + G;
        const bool has_next = nidx < nu;
        const typename J::Unit done = cur;
        if (has_next) {
            cur = jb.unit(nidx);
            if constexpr (J::GATHER) {
#pragma unroll
                for (int i = 0; i < 2; ++i) { int R2, C2; pg_stage_rc(TID() * 16 + i * 8192, R2, C2); vo0[i] = jb.a_off(cur, R2, C2); vo1[i] = jb.a_off(cur, R2 + 128, C2); }
            }
            cA = uptr(jb.a_base(cur)); cB = uptr(jb.b_base(cur));
            if constexpr (has_rowdma<J>::v) { if (wid < 4) pg_glds16(ldsb + ROWC_OFF + (unsigned)((rpar ^ 1) * 4096) + (unsigned)wid * 1024u, uptr(jb.row_base(cur)), (unsigned)TID() * 16u); }
            PG_STAGE(PG_SB(0, 0), cB, voffB); PG_STAGE_A(PG_SA(0, 0), cA, 0); PG_STAGE(PG_SB(0, 1), cB + hstepB, voffB); PG_STAGE_A(PG_SA(0, 1), cA, 1);
        }
        {
            const int l2 = TID() & 63;
            const int rbase = wr * 64 + (l2 & 15), cb = wc * 32 + 8 * (l2 >> 4);
            typename J::Ctx ctx;
            if constexpr (has_rowdma<J>::v) jb.epi_begin(done, rbase, ctx, (const PG_LAS unsigned char*)(lds + ROWC_OFF + rpar * 4096)); else jb.epi_begin(done, rbase, ctx);
            if constexpr (J::SMODE == 0 && J::NCOL == 128) {
                PG_LAS u16* T = (PG_LAS u16*)(lds + 65536);
#pragma unroll
                for (int rg = 0; rg < 8; ++rg) {
                    u32x4 o0, o1;
                    jb.epi_val(done, ctx, rg, acc[rg >> 2][0][rg & 3][0], acc[rg >> 2][0][rg & 3][1], acc[rg >> 2][1][rg & 3][0], acc[rg >> 2][1][rg & 3][1], o0, o1);
                    *(PG_LAS u32x4*)(T + rg_row(rg, rbase) * ST16H + cb) = o0;
                }
                __syncthreads();
                jb.epi_copy(done, ctx, (const PG_LAS u16*)T, TID());
                __syncthreads();
            } else if constexpr (J::SMODE == 0) {
                PG_LAS u16* T = (PG_LAS u16*)(lds + 65536);
#pragma unroll
                for (int h = 0; h < 2; ++h) {
#pragma unroll
                    for (int m = 0; m < 4; ++m) {
                        u32x4 o0, o1;
                        jb.epi_val(done, ctx, h * 4 + m, acc[h][0][m][0], acc[h][0][m][1], acc[h][1][m][0], acc[h][1][m][1], o0, o1);
                        PG_LAS u16* d = T + (m * 16 + rbase) * ST16 + cb;
                        *(PG_LAS u32x4*)d = o0; *(PG_LAS u32x4*)(d + 128) = o1;
                    }
                    __syncthreads();
                    jb.epi_copy(done, (const PG_LAS u16*)T, h, TID());
                    __syncthreads();
                }
            } else {
                PG_LAS float* T = (PG_LAS float*)(lds + 65536);
                typename J::Pre pa, pb;
                jb.epi_load(done, ctx, 0, TID(), pa);
#pragma unroll
                for (int ps = 0; ps < 4; ++ps) {
                    if (wr == (ps & 1)) {
#pragma unroll
                        for (int m = 0; m < 4; ++m) {
                            PG_LAS float* d = T + (m * 16 + (l2 & 15)) * ST32 + cb;
                            *(PG_LAS f32x4*)d = acc[ps >> 1][0][m][0]; *(PG_LAS f32x4*)(d + 4) = acc[ps >> 1][0][m][1];
                            *(PG_LAS f32x4*)(d + 128) = acc[ps >> 1][1][m][0]; *(PG_LAS f32x4*)(d + 132) = acc[ps >> 1][1][m][1];
                        }
                    }
                    __syncthreads();
                    if (ps < 3) jb.epi_load(done, ctx, ps + 1, TID(), pb);
                    jb.epi_copy(done, ctx, (const PG_LAS float*)T, ps, TID(), pa);
                    __syncthreads();
                    pa = pb;
                }
            }
        }
        if (!has_next) break;
        uidx = nidx; rpar ^= 1;
    }
#undef PG_SA
#undef PG_SB
#undef PG_STAGE
#undef PG_STAGE_A
#undef PG_LDA
#undef PG_LDB
#undef PG_MMA
#undef PG_WAIT_V
#undef PG_WAIT_L
#undef PG_BAR
#undef PG_SCHED
}

template <class J> DI void pg_gemm(const J& jb, char* lds_) { pg_gemm_seq(jb, lds_, BID(), (int)gridDim.x, jb.num_units()); }

DI void tile_order(int L, int nM, int nN, int& pm, int& pn) {
    const int nwg = nM * nN, q = nwg / 8, r = nwg % 8, xcd = L % 8, off = L / 8;
    const int wgid = (xcd < r ? xcd * (q + 1) : r * (q + 1) + (xcd - r) * q) + off;
    const int nig = 8 * nN, gid = wgid / nig, fm = gid * 8, gsz = (nM - fm) < 8 ? (nM - fm) : 8;
    pm = fm + ((wgid % nig) % gsz); pn = (wgid % nig) / gsz;
}

struct UnitMN { int m0, n0; };
struct NoCtx {};
DI u32x4 pack8(f32x4 a, f32x4 b) { u32x4 o; o.x = pk2(a.x, a.y); o.y = pk2(a.z, a.w); o.z = pk2(b.x, b.y); o.w = pk2(b.z, b.w); return o; }
DI f32x4 sig4(f32x4 v) { f32x4 o; o.x = sigmoidf_(v.x); o.y = sigmoidf_(v.y); o.z = sigmoidf_(v.z); o.w = sigmoidf_(v.w); return o; }
DI unsigned q4u8(f32x4 v) {
    const unsigned a = (unsigned)fmaf(v.x, 255.0f, 0.5f), b = (unsigned)fmaf(v.y, 255.0f, 0.5f), c = (unsigned)fmaf(v.z, 255.0f, 0.5f), d = (unsigned)fmaf(v.w, 255.0f, 0.5f);
    return a | (b << 8) | (c << 16) | (d << 24);
}
DI f32x4 unq4u8(unsigned w) { f32x4 o; o.x = (float)(w & 0xffu); o.y = (float)((w >> 8) & 0xffu); o.z = (float)((w >> 16) & 0xffu); o.w = (float)(w >> 24); return o * (1.0f / 255.0f); }
constexpr size_t OFF_SGS8 = OFF_R3, OFF_SGA8 = OFF_R3 + ((size_t)32 << 20);
DI f32x4 unp_lo(u32x4 u) { f32x4 o; o.x = bf_lo(u.x); o.y = bf_hi(u.x); o.z = bf_lo(u.y); o.w = bf_hi(u.y); return o; }
DI f32x4 unp_hi(u32x4 u) { f32x4 o; o.x = bf_lo(u.z); o.y = bf_hi(u.z); o.z = bf_lo(u.w); o.w = bf_hi(u.w); return o; }

template <int MODE> struct JobInProjT {
    typedef UnitMN Unit; static constexpr bool GATHER = false; static constexpr int SMODE = 0, NCOL = 256, EREP = REP_EPI;
    struct Ctx { float rs[8]; };
    const char* A; const char* B; const float* ssq4; u16* A2; char* ws;
    DI int num_units() const { return MODE == 0 ? (NTOK / 256) * 12 : 256; }
    DI Unit unit(int u) const { int pm, pn; if (MODE == 0) tile_order(u, NTOK / 256, 12, pm, pn); else { pm = u - 128; pn = 12; } Unit x; x.m0 = pm * 256; x.n0 = pn * 256; return x; }
    DI const char* a_base(const Unit& un) const { return A + (size_t)un.m0 * 2048; }
    DI const char* b_base(const Unit& un) const { return B + (size_t)un.n0 * 2048; }
    DI unsigned a_off(const Unit&, int R, int C) const { return (unsigned)(R * 1024 + C) * 2u; }
    DI size_t a_hstep() const { return 128 * 2048; }
    DI size_t a_kstep() const { return 128; }
    DI int kdim() const { return 1024; }
    static constexpr bool ROWDMA = true;
    DI const char* row_base(const Unit& un) const { return (const char*)ssq4 + (size_t)un.m0 * 16; }
    DI void epi_begin(const Unit&, int rbase, Ctx& c, const PG_LAS unsigned char* rc) const {
#pragma unroll
        for (int rg = 0; rg < 8; ++rg) { const f32x4 q = *(const PG_LAS f32x4*)(rc + rg_row(rg, rbase) * 16); c.rs[rg] = rsqrtf((q.x + q.y + q.z + q.w) * (1.0f / DM) + 1e-6f); }
    }
    DI void epi_val(const Unit& un, const Ctx& c, int rg, f32x4 v00, f32x4 v01, f32x4 v10, f32x4 v11, u32x4& o0, u32x4& o1) const {
        const float s = c.rs[rg];
        if (un.n0 >= 1280) { o0 = (u32x4){q4u8(sig4(v00 * s)), q4u8(sig4(v01 * s)), 0u, 0u}; o1 = (u32x4){q4u8(sig4(v10 * s)), q4u8(sig4(v11 * s)), 0u, 0u}; }
        else { o0 = pack8(v00 * s, v01 * s); o1 = pack8(v10 * s, v11 * s); }
    }
    DI void epi_copy(const Unit& un, const PG_LAS u16* T, int h, int tid) const {
        if (un.n0 < 512) {
#pragma unroll
            for (int it = 0; it < 4; ++it) {
                const int id = it * NTHR + tid, gl = id >> 7, r = id & 127, row = un.m0 + h * 128 + r;
                const PG_LAS u16* s = T + r * ST16 + gl * 16;
                const u32x4 a = *(const PG_LAS u32x4*)s, b = *(const PG_LAS u32x4*)(s + 8);
                const int g = (un.n0 >> 4) + gl, bb = row >> 11, t = row & 2047, ch = t >> 5, i = t & 31;
                u16* d = A2 + ((size_t)(g * S5M + bb * NCH + ch) * S5K2 + i * 16);
                *(u32x4*)d = a; *(u32x4*)(d + 8) = b;
            }
            return;
        }
        if (un.n0 >= 1280) {
            unsigned char* d8 = (unsigned char*)ws + (un.n0 < 2304 ? OFF_SGS8 + (size_t)(un.n0 - 1280) : OFF_SGA8 + (size_t)(un.n0 - 2304));
#pragma unroll
            for (int it = 0; it < 8; ++it) {
                const int id = it * NTHR + tid, r = id >> 5, c = (id & 31) * 8;
                *(u32x2*)(d8 + (size_t)(un.m0 + h * 128 + r) * 1024 + c) = *(const PG_LAS u32x2*)(T + r * ST16 + c);
            }
            return;
        }
        size_t doff; int ld, c0;
        if (un.n0 < 1024) { doff = OFF_Q; ld = 512; c0 = un.n0 - 512; }
        else { doff = OFF_KV; ld = 256; c0 = 0; }
        u16* dst = (u16*)(ws + doff);
#pragma unroll
        for (int it = 0; it < 8; ++it) {
            const int id = it * NTHR + tid, r = id >> 5, c = (id & 31) * 8;
            *(u32x4*)(dst + (size_t)(un.m0 + h * 128 + r) * ld + c0 + c) = *(const PG_LAS u32x4*)(T + r * ST16 + c);
        }
    }
};

struct UnitG { int g, m0, n0; };
struct JobS5G1 {
    typedef UnitG Unit; static constexpr bool GATHER = false; static constexpr int SMODE = 1, NCOL = 256, EREP = 1;
    typedef NoCtx Ctx;
    const char* A2; const char* W1; float* Sloc;
    DI int num_units() const { return 32 * (S5M / 256); }
    DI Unit unit(int u) const { const int xcd = u & 7, slot = u >> 3; Unit x; x.g = xcd * 4 + (slot >> 2); x.m0 = (slot & 3) * 256; x.n0 = 0; return x; }
    DI const char* a_base(const Unit& un) const { return A2 + (size_t)(un.g * S5M + un.m0) * S5K2 * 2; }
    DI const char* b_base(const Unit& un) const { return W1 + (size_t)un.g * 256 * 512 * 2; }
    DI unsigned a_off(const Unit&, int R, int C) const { return (unsigned)(R * S5K2 + C) * 2u; }
    DI size_t a_hstep() const { return 128 * S5K2 * 2; }
    DI size_t a_kstep() const { return 128; }
    DI int kdim() const { return S5K1; }
    DI void epi_begin(const Unit&, int, Ctx&) const {}
    struct Pre {}; DI void epi_load(const Unit&, const Ctx&, int, int, Pre&) const {}
    DI void epi_copy(const Unit& un, const Ctx&, const PG_LAS float* T, int ps, int tid, const Pre&) const {
        const int r0 = (ps >> 1) * 128 + (ps & 1) * 64;
#pragma unroll
        for (int it = 0; it < 4; ++it) {
            const int id = it * NTHR + tid, r = id >> 5, c = (id & 31) * 4;
            *(f32x4*)(Sloc + (size_t)(un.g * S5M + un.m0 + r0 + r) * 128 + c) = *(const PG_LAS f32x4*)(T + r * ST32 + c);
        }
    }
};

struct JobS5G2 {
    typedef UnitG Unit; static constexpr bool GATHER = false; static constexpr int SMODE = 0, NCOL = 256, EREP = 1;
    typedef NoCtx Ctx;
    const char* A2; const char* W2; u16* Zp;
    DI int num_units() const { return 32 * (S5M / 256) * 2; }
    DI Unit unit(int u) const { const int xcd = u & 7, slot = u >> 3; Unit x; x.g = xcd * 4 + (slot >> 3); const int r = slot & 7; x.m0 = (r >> 1) * 256; x.n0 = (r & 1) * 256; return x; }
    DI const char* a_base(const Unit& un) const { return A2 + (size_t)(un.g * S5M + un.m0) * S5K2 * 2; }
    DI const char* b_base(const Unit& un) const { return W2 + (size_t)(un.g * 512 + un.n0) * S5K2 * 2; }
    DI unsigned a_off(const Unit&, int R, int C) const { return (unsigned)(R * S5K2 + C) * 2u; }
    DI size_t a_hstep() const { return 128 * S5K2 * 2; }
    DI size_t a_kstep() const { return 128; }
    DI int kdim() const { return S5K2; }
    DI void epi_begin(const Unit&, int, Ctx&) const {}
    DI f32x4 gelu4(f32x4 v) const { f32x4 o; o.x = gelu_tanh(v.x); o.y = gelu_tanh(v.y); o.z = gelu_tanh(v.z); o.w = gelu_tanh(v.w); return o; }
    DI void epi_val(const Unit&, const Ctx&, int, f32x4 v00, f32x4 v01, f32x4 v10, f32x4 v11, u32x4& o0, u32x4& o1) const { o0 = pack8(gelu4(v00), gelu4(v01)); o1 = pack8(gelu4(v10), gelu4(v11)); }
    DI void epi_copy(const Unit& un, const PG_LAS u16* T, int h, int tid) const {
#pragma unroll
        for (int it = 0; it < 8; ++it) {
            const int id = it * NTHR + tid, r = id >> 5, c = (id & 31) * 8, rr = un.m0 + h * 128 + r, bb = rr >> 6, ch = rr & 63;
            *(u32x4*)(Zp + ((size_t)un.g * NTOK + bb * SEQ + ch * TCH) * 16 + un.n0 + c) = *(const PG_LAS u32x4*)(T + r * ST16 + c);
        }
    }
};

struct JobGLU {
    typedef UnitMN Unit; static constexpr bool GATHER = false; static constexpr int SMODE = 0, NCOL = 128, EREP = 1;
    struct Ctx { u32x2 sg[8]; u32x4 pa[8]; };
    const char* Zp; const char* B; const unsigned char* SGS; const u16* PA; u16* MS;
    DI int num_units() const { return (NTOK / 256) * 8; }
    DI Unit unit(int u) const { int pm, pn; tile_order(u, NTOK / 256, 8, pm, pn); Unit x; x.m0 = pm * 256; x.n0 = pn * 256; return x; }
    DI const char* a_base(const Unit& un) const { return Zp + (size_t)un.m0 * 32; }
    DI const char* b_base(const Unit& un) const { return B + (size_t)un.n0 * 1024; }
    DI unsigned a_off(const Unit&, int R, int C) const { return (unsigned)(((C >> 4) * NTOK + R) * 32 + (C & 15) * 2); }
    DI size_t a_hstep() const { return 128 * 32; }
    DI size_t a_kstep() const { return (size_t)4 * NTOK * 32; }
    DI int kdim() const { return 512; }
    DI void epi_begin(const Unit& un, int, Ctx& cx) const {
        const int tid = TID();
#pragma unroll
        for (int it = 0; it < 8; ++it) { const int id = it * NTHR + tid, r = id >> 4, c = (id & 15) * 8; const size_t off = (size_t)(un.m0 + r) * 1024 + (un.n0 >> 1) + c; cx.sg[it] = *(const u32x2*)(SGS + off); cx.pa[it] = *(const u32x4*)(PA + off); }
    }
    DI void epi_val(const Unit&, const Ctx&, int, f32x4 v00, f32x4 v01, f32x4 v10, f32x4 v11, u32x4& o0, u32x4& o1) const { o0 = pack8(v00 * sig4(v10), v01 * sig4(v11)); o1 = o0; }
    DI void epi_copy(const Unit& un, const Ctx& cx, const PG_LAS u16* T, int tid) const {
#pragma unroll
        for (int it = 0; it < 8; ++it) {
            const int id = it * NTHR + tid, r = id >> 4, c = (id & 15) * 8;
            const u32x4 v = *(const PG_LAS u32x4*)(T + r * ST16H + c);
            *(u32x4*)(MS + (size_t)(un.m0 + r) * 1024 + (un.n0 >> 1) + c) = pack8(unp_lo(v) * unq4u8(cx.sg[it].x) + unp_lo(cx.pa[it]), unp_hi(v) * unq4u8(cx.sg[it].y) + unp_hi(cx.pa[it]));
        }
    }
};

struct JobAttnUp {
    typedef UnitMN Unit; static constexpr bool GATHER = false; static constexpr int SMODE = 1, NCOL = 256, EREP = 1;
    typedef NoCtx Ctx;
    const char* A; const char* B; const unsigned char* SGA; u16* PA;
    DI int num_units() const { return (NTOK / 256) * 4; }
    DI Unit unit(int u) const { int pm, pn; tile_order(u, NTOK / 256, 4, pm, pn); Unit x; x.m0 = pm * 256; x.n0 = pn * 256; return x; }
    DI const char* a_base(const Unit& un) const { return A + (size_t)un.m0 * 1024; }
    DI const char* b_base(const Unit& un) const { return B + (size_t)un.n0 * 1024; }
    DI unsigned a_off(const Unit&, int R, int C) const { return (unsigned)(R * 512 + C) * 2u; }
    DI size_t a_hstep() const { return 128 * 1024; }
    DI size_t a_kstep() const { return 128; }
    DI int kdim() const { return 512; }
    DI void epi_begin(const Unit&, int, Ctx&) const {}
    struct Pre { u32x2 ga[4]; };
    DI void epi_load(const Unit& un, const Ctx&, int ps, int tid, Pre& p) const {
        const int r0 = (ps >> 1) * 128 + (ps & 1) * 64;
#pragma unroll
        for (int it = 0; it < 4; ++it) { const int id = it * NTHR + tid, r = id >> 5, c = (id & 31) * 8; const size_t off = (size_t)(un.m0 + r0 + r) * 1024 + un.n0 + c; p.ga[it] = *(const u32x2*)(SGA + off); }
    }
    DI void epi_copy(const Unit& un, const Ctx&, const PG_LAS float* T, int ps, int tid, const Pre& p) const {
        const int r0 = (ps >> 1) * 128 + (ps & 1) * 64;
#pragma unroll
        for (int it = 0; it < 4; ++it) {
            const int id = it * NTHR + tid, r = id >> 5, c = (id & 31) * 8;
            const f32x4 a = unq4u8(p.ga[it].x) * *(const PG_LAS f32x4*)(T + r * ST32 + c), b = unq4u8(p.ga[it].y) * *(const PG_LAS f32x4*)(T + r * ST32 + c + 4);
            *(u32x4*)(PA + (size_t)(un.m0 + r0 + r) * 1024 + un.n0 + c) = pack8(a, b);
        }
    }
};

struct JobOut {
    typedef UnitMN Unit; static constexpr bool GATHER = false; static constexpr int SMODE = 1, NCOL = 256, EREP = 1;
    typedef NoCtx Ctx;
    const char* A; const char* B; u16* XB;
    DI int num_units() const { return (NTOK / 256) * 4; }
    DI Unit unit(int u) const { int pm, pn; tile_order(u, NTOK / 256, 4, pm, pn); Unit x; x.m0 = pm * 256; x.n0 = pn * 256; return x; }
    DI const char* a_base(const Unit& un) const { return A + (size_t)un.m0 * 2048; }
    DI const char* b_base(const Unit& un) const { return B + (size_t)un.n0 * 2048; }
    DI unsigned a_off(const Unit&, int R, int C) const { return (unsigned)(R * 1024 + C) * 2u; }
    DI size_t a_hstep() const { return 128 * 2048; }
    DI size_t a_kstep() const { return 128; }
    DI int kdim() const { return 1024; }
    DI void epi_begin(const Unit&, int, Ctx&) const {}
    struct Pre { u32x4 xv[4]; };
    DI void epi_load(const Unit& un, const Ctx&, int ps, int tid, Pre& p) const {
        const int r0 = (ps >> 1) * 128 + (ps & 1) * 64;
#pragma unroll
        for (int it = 0; it < 4; ++it) { const int id = it * NTHR + tid, r = id >> 5, c = (id & 31) * 8; p.xv[it] = *(const u32x4*)(XB + (size_t)(un.m0 + r0 + r) * 1024 + un.n0 + c); }
    }
    DI void epi_copy(const Unit& un, const Ctx&, const PG_LAS float* T, int ps, int tid, const Pre& p) const {
        const int r0 = (ps >> 1) * 128 + (ps & 1) * 64;
#pragma unroll
        for (int it = 0; it < 4; ++it) {
            const int id = it * NTHR + tid, r = id >> 5, c = (id & 31) * 8;
            const f32x4 a = unp_lo(p.xv[it]) + *(const PG_LAS f32x4*)(T + r * ST32 + c), b = unp_hi(p.xv[it]) + *(const PG_LAS f32x4*)(T + r * ST32 + c + 4);
            *(u32x4*)(XB + (size_t)(un.m0 + r0 + r) * 1024 + un.n0 + c) = pack8(a, b);
        }
    }
};

struct UnitMoe { int m0, n0, e0, e1, pr, pb, nv; };
constexpr unsigned MOE_TB_OFF = 151552;
DI int moe_tok(const int* perm2, const UnitMoe& un, int R) { return R < un.nv ? perm2[un.pb + R] : -1; }
DI void moe_unit(const PG_LAS int* tb, int u, UnitMoe& x) {
    const int rt = u >> 2; x.m0 = rt * TM; x.n0 = (u & 3) * 256;
    int bk = 0;
#pragma unroll 1
    for (int q = 1; q < 24; ++q) if (x.m0 >= __builtin_amdgcn_readfirstlane(tb[q])) bk = q;
    x.pr = bk;
    const int l0 = x.m0 - __builtin_amdgcn_readfirstlane(tb[bk]);
    int nv = __builtin_amdgcn_readfirstlane(tb[32 + bk]) - l0; nv = nv < 0 ? 0 : (nv > TM ? TM : nv);
    x.nv = nv; x.pb = bk * 32768 + l0;
}
DI void bucket_decode(int bk, int& e0, int& e1) { const int grp = bk / 6; int a, b; pair_experts(bk % 6, a, b); e0 = grp * 4 + a; e1 = grp * 4 + b; }
struct JobMoeUp {
    typedef UnitMoe Unit; static constexpr bool GATHER = true; static constexpr int SMODE = 0, NCOL = 128, EREP = 1;
    struct Ctx { float rs[8]; float wg[8]; };
    const char* XB2; const char* WUP; const int* perm; const PG_LAS int* tb; const float* rstd2; const float* rw; u16* ACT;
    DI int num_units() const { return (__builtin_amdgcn_readfirstlane(tb[24]) / TM) * 4; }
    DI Unit unit(int u) const { Unit x; moe_unit(tb, u, x); bucket_decode(x.pr, x.e0, x.e1); return x; }
    DI const char* a_base(const Unit&) const { return XB2; }
    DI const char* b_base(const Unit& un) const { const int e = un.n0 < 512 ? un.e0 : un.e1; return WUP + (size_t)(e * 512 + (un.n0 & 511)) * 2048; }
    DI unsigned a_off(const Unit& un, int R, int C) const { int tok = moe_tok(perm, un, R); tok = tok < 0 ? 0 : tok; return (unsigned)(tok * 1024 + C) * 2u; }
    DI size_t a_hstep() const { return 0; }
    DI size_t a_kstep() const { return 128; }
    DI int kdim() const { return 1024; }
    DI void epi_begin(const Unit& un, int rbase, Ctx& c) const {
        const int slot = un.n0 >> 9; int tk[8];
#pragma unroll
        for (int rg = 0; rg < 8; ++rg) tk[rg] = moe_tok(perm, un, rg_row(rg, rbase));
#pragma unroll
        for (int rg = 0; rg < 8; ++rg) { const int t = tk[rg] < 0 ? 0 : tk[rg]; c.rs[rg] = rstd2[t]; c.wg[rg] = rw[t * 2 + slot]; }
    }
    DI f32x4 swiglu4(f32x4 g, f32x4 u, float s, float w) const { g = g * s; u = u * s; return g * sig4(g) * u * w; }
    DI void epi_val(const Unit&, const Ctx& c, int rg, f32x4 v00, f32x4 v01, f32x4 v10, f32x4 v11, u32x4& o0, u32x4& o1) const {
        o0 = pack8(swiglu4(v00, v10, c.rs[rg], c.wg[rg]), swiglu4(v01, v11, c.rs[rg], c.wg[rg])); o1 = o0;
    }
    DI void epi_copy(const Unit& un, const Ctx&, const PG_LAS u16* T, int tid) const {
        const int slot = un.n0 >> 9, uu = (un.n0 >> 8) & 1;
#pragma unroll
        for (int it = 0; it < 8; ++it) {
            const int id = it * NTHR + tid, r = id >> 4, c = (id & 15) * 8;
            st16_sc1(ACT + (size_t)(un.m0 + r) * 512 + slot * 256 + uu * 128 + c, *(const PG_LAS u32x4*)(T + r * ST16H + c));
        }
    }
};

struct JobMoeDown {
    typedef UnitMoe Unit; static constexpr bool GATHER = false; static constexpr int SMODE = 1, NCOL = 256, EREP = 1;
    struct Ctx { int tk[16]; };
    const char* ACT; const char* WDN; const int* perm; const PG_LAS int* tb; u16* XB; float* OUT; float* ssq4; int last;
    DI int num_units() const { return (__builtin_amdgcn_readfirstlane(tb[24]) / TM) * 4; }
    DI Unit unit(int u) const { Unit x; moe_unit(tb, u, x); x.e0 = 0; x.e1 = 0; return x; }
    DI const char* a_base(const Unit& un) const { return ACT + (size_t)un.m0 * 1024; }
    DI const char* b_base(const Unit& un) const { return WDN + (size_t)(un.pr * 1024 + un.n0) * 1024; }
    DI unsigned a_off(const Unit&, int R, int C) const { return (unsigned)(R * 512 + C) * 2u; }
    DI size_t a_hstep() const { return 128 * 1024; }
    DI size_t a_kstep() const { return 128; }
    DI int kdim() const { return 512; }
    DI void epi_begin(const Unit& un, int, Ctx& c) const {
        const int tid = TID();
#pragma unroll
        for (int q = 0; q < 16; ++q) { const int ps = q >> 2, it = q & 3, r0 = (ps >> 1) * 128 + (ps & 1) * 64, id = it * NTHR + tid, r = id >> 5; c.tk[q] = moe_tok(perm, un, r0 + r); }
    }
    struct Pre { u32x4 xv[4]; };
    DI void epi_load(const Unit& un, const Ctx& cx, int ps, int tid, Pre& p) const {
#pragma unroll
        for (int it = 0; it < 4; ++it) { const int id = it * NTHR + tid, c = (id & 31) * 8, t = cx.tk[ps * 4 + it] < 0 ? 0 : cx.tk[ps * 4 + it]; p.xv[it] = *(const u32x4*)(XB + (size_t)t * 1024 + un.n0 + c); }
    }
    DI void epi_copy(const Unit& un, const Ctx& cx, const PG_LAS float* T, int ps, int tid, const Pre& p) const {
        const int lane = tid & 63;
#pragma unroll
        for (int it = 0; it < 4; ++it) {
            const int id = it * NTHR + tid, r = id >> 5, c = (id & 31) * 8, tk = cx.tk[ps * 4 + it];
            const f32x4 a = unp_lo(p.xv[it]) + *(const PG_LAS f32x4*)(T + r * ST32 + c), b = unp_hi(p.xv[it]) + *(const PG_LAS f32x4*)(T + r * ST32 + c + 4);
            if (last) {
                if (tk >= 0) { float* o = OUT + (size_t)tk * 1024 + un.n0 + c; *(f32x4*)o = a; *(f32x4*)(o + 4) = b; }
            } else {
                const u32x4 q = pack8(a, b);
                if (tk >= 0) *(u32x4*)(XB + (size_t)tk * 1024 + un.n0 + c) = q;
                const f32x4 ra = unp_lo(q), rb = unp_hi(q);
                float ss = ra.x * ra.x + ra.y * ra.y + ra.z * ra.z + ra.w * ra.w + rb.x * rb.x + rb.y * rb.y + rb.z * rb.z + rb.w * rb.w;
                ss += shx(ss, 1, lane); ss += shx(ss, 2, lane); ss += shx(ss, 4, lane); ss += shx(ss, 8, lane); ss += shx(ss, 16, lane);
                if ((lane & 31) == 0 && tk >= 0) ssq4[(size_t)tk * 4 + (un.n0 >> 8)] = ss;
            }
        }
    }
};

DI void phase_scan(const Params& p) {
    const float* Sloc = (const float*)(opq(p.ws) + OFF_SLOC);
    const float* LT = (const float*)(opq(p.ws) + OFF_LT);
    u16* A2 = (u16*)(opq(p.ws) + OFF_A2);
    for (int idx = BID() * NTHR + TID(); idx < 32 * NBATCH * 64; idx += gridDim.x * NTHR) {
        const int pp = idx & 63, b = (idx >> 6) & 15, g = idx >> 10;
        const float ar = LT[(g * 64 + pp) * 2], ai = LT[(g * 64 + pp) * 2 + 1];
        float sr = 0.f, si = 0.f;
        const size_t r0 = (size_t)g * S5M + b * NCH;
#pragma unroll 8
        for (int c = 0; c < NCH; ++c) {
            *(unsigned*)(A2 + (r0 + c) * S5K2 + S5K1 + 2 * pp) = pk2(sr, si);
            const f32x2 l = *(const f32x2*)(Sloc + (r0 + c) * 128 + 2 * pp);
            const float nr = ar * sr - ai * si + l.x, ni = ar * si + ai * sr + l.y;
            sr = nr; si = ni;
        }
    }
}

DI void scan_local(const Params& p, int g, int b0) {
    asm volatile("s_waitcnt vmcnt(0)" ::: "memory");
    __syncthreads();
    const float* Sloc = (const float*)(opq(p.ws) + OFF_SLOC);
    const float* LT = (const float*)(opq(p.ws) + OFF_LT);
    u16* A2 = (u16*)(opq(p.ws) + OFF_A2);
    const int tid = TID();
    if (tid < 256) {
        const int pp = tid & 63, b = b0 + (tid >> 6);
        const float ar = LT[(g * 64 + pp) * 2], ai = LT[(g * 64 + pp) * 2 + 1];
        float sr = 0.f, si = 0.f;
        const size_t r0 = (size_t)g * S5M + b * NCH;
        f32x2 l[NCH];
#pragma unroll
        for (int c = 0; c < NCH; ++c) l[c] = __builtin_nontemporal_load((const f32x2*)(Sloc + (r0 + c) * 128 + 2 * pp));
#pragma unroll
        for (int c = 0; c < NCH; ++c) {
            *(unsigned*)(A2 + (r0 + c) * S5K2 + S5K1 + 2 * pp) = pk2(sr, si);
            const float nr = ar * sr - ai * si + l[c].x, ni = ar * si + ai * sr + l[c].y;
            sr = nr; si = ni;
        }
    }
}

constexpr int PREP0_PER_UNIT = 3;
DI void phase_attn(const Params& p, const int L, char* lds) {
    u16* Ks = (u16*)lds;
    u16* Vt = Ks + 256 * 72;
    int* qslot = (int*)(lds + 70400);
    const u16* Qg = (const u16*)(opq(p.ws) + OFF_Q);
    const u16* KVg = (const u16*)(opq(p.ws) + OFF_KV);
    u16* YA = (u16*)(opq(p.ws) + OFF_YA);
    unsigned* qctr = (unsigned*)(opq(p.ws) + OFF_BAR) + 8 + L;
    const float* qn = opq(p.in[13]) + L * 64; const float* kn = opq(p.in[14]) + L * 64; const float* sinks = opq(p.in[15]) + L * 8;
    const int tid = TID(), lane = tid & 63, w = tid >> 6, r = lane & 31, hh = lane >> 5;
    constexpr float L2E = 1.4426950408889634f;
    for (;;) {
        if (tid == 0) *qslot = (int)__hip_atomic_fetch_add(qctr, 1u, __ATOMIC_RELAXED, __HIP_MEMORY_SCOPE_AGENT);
        __syncthreads();
        const int u = *qslot;
        if (u >= NBATCH * 16 * 2) break;
        const int kvh = u & 1, nb = (u >> 1) & 15, b = u >> 5;
        const int tok0 = b * SEQ + nb * 128;
        const int gq = w >> 1, h = kvh * 4 + gq, qhalf = w & 1;
        u32x4 qn_[4];
#pragma unroll
        for (int s = 0; s < 4; ++s) qn_[s] = *(const u32x4*)(Qg + (size_t)(tok0 + qhalf * 64 + r) * 512 + h * 64 + 16 * s + 8 * hh);
#pragma unroll
        for (int i = 0; i < 4; ++i) {
            const int pc = tid + 512 * i, key = pc >> 3, dc = pc & 7;
            const bool valid = (nb > 0) || (key >= 128);
            u32x4 kr = {0u, 0u, 0u, 0u}, vr = {0u, 0u, 0u, 0u};
            if (valid) { const u16* src = KVg + (size_t)(tok0 - 128 + key) * 256 + kvh * 64 + dc * 8; kr = *(const u32x4*)src; vr = *(const u32x4*)(src + 128); }
            float kf[8];
            kf[0] = bf_lo(kr.x); kf[1] = bf_hi(kr.x); kf[2] = bf_lo(kr.y); kf[3] = bf_hi(kr.y); kf[4] = bf_lo(kr.z); kf[5] = bf_hi(kr.z); kf[6] = bf_lo(kr.w); kf[7] = bf_hi(kr.w);
            float ss = 0.f;
#pragma unroll
            for (int e = 0; e < 8; ++e) ss += kf[e] * kf[e];
            ss += shx(ss, 1, lane); ss += shx(ss, 2, lane); ss += shx(ss, 4, lane);
            const float rs = rsqrtf(ss * (1.0f / 64.0f) + 1e-6f);
            const f32x4 g0 = *(const f32x4*)(kn + dc * 8), g1 = *(const f32x4*)(kn + dc * 8 + 4);
            u32x4 ko;
            ko.x = pk2(kf[0] * rs * g0.x, kf[1] * rs * g0.y); ko.y = pk2(kf[2] * rs * g0.z, kf[3] * rs * g0.w);
            ko.z = pk2(kf[4] * rs * g1.x, kf[5] * rs * g1.y); ko.w = pk2(kf[6] * rs * g1.z, kf[7] * rs * g1.w);
            *(u32x4*)(Ks + key * 72 + dc * 8) = ko;
            u16* vd = Vt + (dc * 8) * 260 + key;
            vd[0 * 260] = (u16)(vr.x & 0xffff); vd[1 * 260] = (u16)(vr.x >> 16); vd[2 * 260] = (u16)(vr.y & 0xffff); vd[3 * 260] = (u16)(vr.y >> 16);
            vd[4 * 260] = (u16)(vr.z & 0xffff); vd[5 * 260] = (u16)(vr.z >> 16); vd[6 * 260] = (u16)(vr.w & 0xffff); vd[7 * 260] = (u16)(vr.w >> 16);
        }
        __syncthreads();
        const float slope2 = exp2f(-(float)(h + 1)) * L2E, sink2 = sinks[h] * L2E;
#pragma unroll 1
        for (int qt = 0; qt < 2; ++qt) {
            const int i0 = qhalf * 64 + qt * 32;
            const int qtok = tok0 + i0 + r;
            bf16x8 qf[4];
            {
                u32x4 qr[4]; float ss = 0.f;
#pragma unroll
                for (int s = 0; s < 4; ++s) qr[s] = qn_[s];
                if (qt == 0) {
#pragma unroll
                    for (int s = 0; s < 4; ++s) qn_[s] = *(const u32x4*)(Qg + (size_t)(qtok + 32) * 512 + h * 64 + 16 * s + 8 * hh);
                }
#pragma unroll
                for (int s = 0; s < 4; ++s) {
                    const float a0 = bf_lo(qr[s].x), a1 = bf_hi(qr[s].x), a2 = bf_lo(qr[s].y), a3 = bf_hi(qr[s].y), a4 = bf_lo(qr[s].z), a5 = bf_hi(qr[s].z), a6 = bf_lo(qr[s].w), a7 = bf_hi(qr[s].w);
                    ss += a0 * a0 + a1 * a1 + a2 * a2 + a3 * a3 + a4 * a4 + a5 * a5 + a6 * a6 + a7 * a7;
                }
                ss += shx(ss, 32, lane);
                const float rs = rsqrtf(ss * (1.0f / 64.0f) + 1e-6f) * (0.125f * L2E);
#pragma unroll
                for (int s = 0; s < 4; ++s) {
                    const f32x4 g0 = *(const f32x4*)(qn + 16 * s + 8 * hh), g1 = *(const f32x4*)(qn + 16 * s + 8 * hh + 4);
                    u32x4 o;
                    o.x = pk2(bf_lo(qr[s].x) * rs * g0.x, bf_hi(qr[s].x) * rs * g0.y); o.y = pk2(bf_lo(qr[s].y) * rs * g0.z, bf_hi(qr[s].y) * rs * g0.w);
                    o.z = pk2(bf_lo(qr[s].z) * rs * g1.x, bf_hi(qr[s].z) * rs * g1.y); o.w = pk2(bf_lo(qr[s].w) * rs * g1.z, bf_hi(qr[s].w) * rs * g1.w);
                    qf[s] = __builtin_bit_cast(bf16x8, o);
                }
            }
            const int kt0 = i0 >> 5;
            const int qi = i0 + r;
            const int dbase = qi + 128 - kt0 * 32 - 4 * hh;
            const int maxd = nb > 0 ? 127 : (qi < 127 ? qi : 127);
            const float A = -slope2 * (float)dbase;
            f32x16 o[2];
#pragma unroll
            for (int db = 0; db < 2; ++db)
#pragma unroll
                for (int e = 0; e < 16; ++e) o[db][e] = 0.f;
            float m = sink2, l = 0.f;
#pragma unroll
            for (int kr2 = 0; kr2 < 5; ++kr2) {
                const int kt = 4 - kr2;
                if (nb == 0 && kt0 + kt < 4) continue;
                f32x16 sc;
#pragma unroll
                for (int e = 0; e < 16; ++e) sc[e] = 0.f;
#pragma unroll
                for (int s = 0; s < 4; ++s) {
                    const bf16x8 kfr = *(const bf16x8*)(Ks + ((kt0 + kt) * 32 + r) * 72 + 16 * s + 8 * hh);
                    sc = mfma32(kfr, qf[s], sc);
                }
                float tm = -1e30f;
#pragma unroll
                for (int e = 0; e < 16; ++e) {
                    const int ce = 32 * kt + (e & 3) + 8 * (e >> 2);
                    float t = fmaf(slope2, (float)ce, sc[e]);
                    if (kt == 0 || kt == 4) { const int dist = dbase - ce; t = ((unsigned)dist <= (unsigned)maxd) ? t : -1e30f; }
                    sc[e] = t; tm = fmaxf(tm, t);
                }
                tm += A;
                tm = fmaxf(tm, shx(tm, 32, lane));
                if (__ballot(tm > m) != 0ull) {
                    const float mn = fmaxf(m, tm), alpha = __builtin_amdgcn_exp2f(m - mn);
                    m = mn; l *= alpha;
#pragma unroll
                    for (int db = 0; db < 2; ++db)
#pragma unroll
                        for (int e = 0; e < 16; ++e) o[db][e] *= alpha;
                }
                const float c0 = A - m;
                float ls = 0.f;
#pragma unroll
                for (int e = 0; e < 16; ++e) { const float pv = __builtin_amdgcn_exp2f(sc[e] + c0); sc[e] = pv; ls += pv; }
                l += ls;
#pragma unroll
                for (int s2 = 0; s2 < 2; ++s2) {
                    u32x4 pp;
                    pp.x = pk2(sc[8 * s2 + 0], sc[8 * s2 + 1]); pp.y = pk2(sc[8 * s2 + 2], sc[8 * s2 + 3]);
                    pp.z = pk2(sc[8 * s2 + 4], sc[8 * s2 + 5]); pp.w = pk2(sc[8 * s2 + 6], sc[8 * s2 + 7]);
                    const bf16x8 pf = __builtin_bit_cast(bf16x8, pp);
                    const int kb = (kt0 + kt) * 32 + 16 * s2 + 4 * hh;
#pragma unroll
                    for (int db = 0; db < 2; ++db) {
                        const u16* vp = Vt + (db * 32 + r) * 260 + kb;
                        const s16x4 lo = *(const s16x4*)vp, hi = *(const s16x4*)(vp + 8);
                        const bf16x8 vf = __builtin_shufflevector(lo, hi, 0, 1, 2, 3, 4, 5, 6, 7);
                        o[db] = mfma32(vf, pf, o[db]);
                    }
                }
                asm volatile("" ::: "memory");
            }
            l += shx(l, 32, lane);
            l += __builtin_amdgcn_exp2f(sink2 - m);
            const float inv = __builtin_amdgcn_rcpf(l);
#pragma unroll
            for (int db = 0; db < 2; ++db)
#pragma unroll
                for (int q4 = 0; q4 < 4; ++q4) {
                    const int d = db * 32 + 8 * q4 + 4 * hh;
                    u32x2 ov; ov.x = pk2(o[db][4 * q4] * inv, o[db][4 * q4 + 1] * inv); ov.y = pk2(o[db][4 * q4 + 2] * inv, o[db][4 * q4 + 3] * inv);
                    *(u32x2*)(YA + (size_t)qtok * 512 + h * 64 + d) = ov;
                }
        }
        __syncthreads();
        if (L == 0) prep_from_queue(p, lds, PREP0_PER_UNIT, 0, true);
    }
    if (L == 0) prep_from_queue(p, lds, 1 << 30, 0, true);
}

DI void route_token(const float (&lg)[20], int& bucket, float& w0, float& w1) {
    int gi = 0; float gm = lg[0];
#pragma unroll
    for (int j = 1; j < 4; ++j) if (lg[j] > gm) { gm = lg[j]; gi = j; }
    float den = 0.f;
#pragma unroll
    for (int j = 0; j < 4; ++j) den += __expf(lg[j] - gm);
    const float gp = 1.0f / den;
    float f[4];
#pragma unroll
    for (int j = 0; j < 4; ++j) f[j] = gi == 0 ? lg[4 + j] : (gi == 1 ? lg[8 + j] : (gi == 2 ? lg[12 + j] : lg[16 + j]));
    int i1 = 0; float v1 = f[0];
#pragma unroll
    for (int j = 1; j < 4; ++j) if (f[j] > v1) { v1 = f[j]; i1 = j; }
    int i2 = -1; float v2 = -3.0e38f;
#pragma unroll
    for (int j = 0; j < 4; ++j) if (j != i1 && f[j] > v2) { v2 = f[j]; i2 = j; }
    const float e2 = __expf(v2 - v1);
    const float p1 = gp / (1.0f + e2), p2 = gp * e2 / (1.0f + e2);
    const int a = i1 < i2 ? i1 : i2, b = i1 < i2 ? i2 : i1;
    const int pidx = a == 0 ? b - 1 : (a == 1 ? b + 1 : 5);
    bucket = gi * 6 + pidx;
    w0 = i1 < i2 ? p1 : p2; w1 = i1 < i2 ? p2 : p1;
}

constexpr int RW_ROW = 1024 + 8;
DI void phase_router(const Params& p, const int L, char* lds) {
    u16* Wh = (u16*)lds;
    u16* Wl = Wh + 21 * RW_ROW;
    float* lgs = (float*)(Wl + 21 * RW_ROW);
    int* hist = (int*)(lgs + 8 * 16 * 24);
    const u32x4* WRI = (const u32x4*)(opq(p.ws) + OFF_WR);
    const u16* X = (const u16*)(opq(p.ws) + OFF_R1);
    float* rstd2 = (float*)(opq(p.ws) + OFF_RSTD2);
    int* perm2 = (int*)(opq(p.ws) + OFF_PERM2);
    float* rw = (float*)(opq(p.ws) + OFF_RW);
    unsigned* gcnt = (unsigned*)(opq(p.ws) + OFF_MOEQ) + L * 256 + 16;
    const int tid = TID(), lane = tid & 63, w = tid >> 6, fr = lane & 15, fq = lane >> 4;
    if (BID() >= 256) return;
    for (int i = tid; i < 42 * 128; i += NTHR) { const int row = i >> 7, ch = i & 127; *(u32x4*)(Wh + row * RW_ROW + ch * 8) = WRI[i]; }
    for (int rb = BID(); rb < 256; rb += gridDim.x) {
        if (tid < 24) hist[tid] = 0;
        __syncthreads();
        const int tok = rb * 128 + w * 16 + fr;
        const u16* xr = X + (size_t)tok * DM + 8 * fq;
        const int n1 = fr < 4 ? 16 + fr : 20;
        f32x4 a0 = {0.f, 0.f, 0.f, 0.f}, a1 = {0.f, 0.f, 0.f, 0.f};
        float ssq = 0.f;
        u32x4 xq[2][8];
#pragma unroll
        for (int s = 0; s < 8; ++s) xq[0][s] = *(const u32x4*)(xr + s * 32);
#pragma unroll
        for (int kc = 0; kc < 4; ++kc) {
            u32x4 (&xa)[8] = xq[kc & 1];
            if (kc < 3) {
#pragma unroll
                for (int s = 0; s < 8; ++s) xq[(kc + 1) & 1][s] = *(const u32x4*)(xr + ((kc + 1) * 8 + s) * 32);
            }
#pragma unroll
            for (int s = 0; s < 8; ++s) {
                const int ks = kc * 8 + s;
                const f32x4 va = unp_lo(xa[s]), vb = unp_hi(xa[s]);
                ssq += va.x * va.x + va.y * va.y + va.z * va.z + va.w * va.w + vb.x * vb.x + vb.y * vb.y + vb.z * vb.z + vb.w * vb.w;
                const bf16x8 xh = __builtin_bit_cast(bf16x8, xa[s]);
                const bf16x8 wh0 = *(const bf16x8*)(Wh + fr * RW_ROW + ks * 32 + fq * 8), wl0 = *(const bf16x8*)(Wl + fr * RW_ROW + ks * 32 + fq * 8);
                const bf16x8 wh1 = *(const bf16x8*)(Wh + n1 * RW_ROW + ks * 32 + fq * 8), wl1 = *(const bf16x8*)(Wl + n1 * RW_ROW + ks * 32 + fq * 8);
                a0 = mfma16(wh0, xh, a0); a0 = mfma16(wl0, xh, a0);
                a1 = mfma16(wh1, xh, a1); a1 = mfma16(wl1, xh, a1);
            }
        }
        ssq += shx(ssq, 16, lane); ssq += shx(ssq, 32, lane);
        float* lg = lgs + (w * 16 + fr) * 24;
        *(f32x4*)(lg + 4 * fq) = a0;
        if (fq == 0) *(f32x4*)(lg + 16) = a1;
        __syncthreads();
        int mybk = 0, myrank = 0;
        if (lane < 16) {
            const float rs = rsqrtf(ssq * (1.0f / DM) + 1e-6f);
            float l20[20];
#pragma unroll
            for (int n = 0; n < 20; ++n) l20[n] = lg[n] * rs;
            int bk; float w0, w1;
            route_token(l20, bk, w0, w1);
            rstd2[tok] = rs; rw[tok * 2] = w0; rw[tok * 2 + 1] = w1;
            mybk = bk; myrank = atomicAdd(&hist[bk], 1);
        }
        __syncthreads();
        if (tid < 24) { const int c = hist[tid]; hist[32 + tid] = c > 0 ? (int)__hip_atomic_fetch_add(gcnt + tid, (unsigned)c, __ATOMIC_RELAXED, __HIP_MEMORY_SCOPE_AGENT) : 0; }
        __syncthreads();
        if (lane < 16) perm2[(size_t)mybk * 32768 + hist[32 + mybk] + myrank] = tok;
        __syncthreads();
    }
}

template <int MODE> DI JobInProjT<MODE> mk_inproj(const Params& p, const int L) { JobInProjT<MODE> j; char* w = opq(p.ws); j.A = w + OFF_R1; j.B = w + (size_t)L * WSET + OFF_WIN; j.ssq4 = (const float*)(w + OFF_SSQ4); j.A2 = (u16*)(w + OFF_A2); j.ws = w; return j; }
DI JobS5G1 mk_g1(const Params& p, const int L) { JobS5G1 j; j.A2 = opq(p.ws) + OFF_A2; j.W1 = opq(p.ws) + (size_t)L * WSET + OFF_W1T; j.Sloc = (float*)(opq(p.ws) + OFF_SLOC); return j; }
DI JobS5G2 mk_g2(const Params& p, const int L) { JobS5G2 j; j.A2 = opq(p.ws) + OFF_A2; j.W2 = opq(p.ws) + (size_t)L * WSET + OFF_W2T; j.Zp = (u16*)(opq(p.ws) + OFF_Z); return j; }
DI JobGLU mk_glu(const Params& p, const int L) { JobGLU j; j.Zp = opq(p.ws) + OFF_Z; j.B = opq(p.ws) + (size_t)L * WSET + OFF_WGLU; j.SGS = (const unsigned char*)(opq(p.ws) + OFF_SGS8); j.PA = (const u16*)(opq(p.ws) + pa_off(L)); j.MS = (u16*)(opq(p.ws) + OFF_R2); return j; }
DI JobAttnUp mk_attnup(const Params& p, const int L) { JobAttnUp j; j.A = opq(p.ws) + OFF_YA; j.B = opq(p.ws) + (size_t)L * WSET + OFF_WATT; j.SGA = (const unsigned char*)(opq(p.ws) + OFF_SGA8); j.PA = (u16*)(opq(p.ws) + pa_off(L)); return j; }
DI JobOut mk_out(const Params& p, const int L) { JobOut j; j.A = opq(p.ws) + OFF_R2; j.B = opq(p.ws) + (size_t)L * WSET + OFF_WOUT; j.XB = (u16*)(opq(p.ws) + OFF_R1); return j; }
DI JobMoeUp mk_moeup(const Params& p, const int L, char* lds) { JobMoeUp j; j.tb = (const PG_LAS int*)((PG_LAS char*)lds + MOE_TB_OFF); j.XB2 = opq(p.ws) + OFF_R1; j.WUP = opq(p.ws) + (size_t)L * WSET + OFF_WUP; j.perm = (const int*)(opq(p.ws) + OFF_PERM2); j.rstd2 = (const float*)(opq(p.ws) + OFF_RSTD2); j.rw = (const float*)(opq(p.ws) + OFF_RW); j.ACT = (u16*)(opq(p.ws) + OFF_R3); return j; }
DI JobMoeDown mk_moedown(const Params& p, const int L, char* lds) { JobMoeDown j; j.tb = (const PG_LAS int*)((PG_LAS char*)lds + MOE_TB_OFF); j.ACT = opq(p.ws) + OFF_R3; j.WDN = opq(p.ws) + (size_t)L * WSET + OFF_WDN; j.perm = (const int*)(opq(p.ws) + OFF_PERM2); j.XB = (u16*)(opq(p.ws) + OFF_R1); j.OUT = opq(p.out); j.ssq4 = (float*)(opq(p.ws) + OFF_SSQ4); j.last = L == 1; return j; }


#define XB_TMO      128
#define XB_XCNT(j)  (256  + 64 * (j))
#define XB_XSUB(j)  (1280 + 64 * (j))
#define XB_XGEN(j)  (2304 + 64 * (j))
#define XB_TOP      3328
#define XB_TOPGEN   3392
#define XB_SPIN_CAP (1u << 18)
DI unsigned xb_ld(unsigned* p)              { return __hip_atomic_load(p, __ATOMIC_RELAXED, __HIP_MEMORY_SCOPE_AGENT); }
DI unsigned xb_add(unsigned* p, unsigned v) { return __hip_atomic_fetch_add(p, v, __ATOMIC_RELAXED, __HIP_MEMORY_SCOPE_AGENT); }
DI unsigned xb_xcc_id() { return (unsigned)__builtin_amdgcn_s_getreg((3 << 11) | 20) & 0xFu; }
#define XB_SPIN(cond, bar) do { unsigned _sp = 0; while (cond) { __builtin_amdgcn_s_sleep(1); \
    if ((++_sp & 255u) == 0u) { if (xb_ld(&(bar)[XB_TMO])) break; if (_sp > XB_SPIN_CAP) { atomicAdd(&(bar)[XB_TMO], 1u); break; } } } } while (0)
struct XcdBarrier { unsigned* bar; unsigned x; volatile PG_LAS unsigned* st; };
DI XcdBarrier xcd_barrier_post(unsigned* bar, volatile PG_LAS unsigned* st) {
    XcdBarrier b; b.bar = bar; b.x = xb_xcc_id(); b.st = st;
    if (threadIdx.x == 0) (void)xb_add(&bar[XB_XCNT(b.x)], 1u);
    return b;
}
DI void xcd_barrier_complete(unsigned* bar, unsigned x, unsigned& nloc, unsigned& nx) {
    const unsigned G = gridDim.x * gridDim.y * gridDim.z;
    unsigned sum, cnt, mine, sp = 0u;
    for (;;) {
        sum = 0u; cnt = 0u; mine = 0u;
#pragma unroll
        for (unsigned j = 0; j < 16; ++j) { const unsigned c = xb_ld(&bar[XB_XCNT(j)]); sum += c; cnt += (c > 0u) ? 1u : 0u; mine = (j == x) ? c : mine; }
        if (sum == G) break;
        __builtin_amdgcn_s_sleep(1);
        if ((++sp & 255u) == 0u) { if (xb_ld(&bar[XB_TMO])) break; if (sp > XB_SPIN_CAP) { atomicAdd(&bar[XB_TMO], 1u); break; } }
    }
    nloc = mine > 0u ? mine : 1u; nx = cnt > 0u ? cnt : 1u;
}
DI void xcd_barrier(const XcdBarrier& b) {
    asm volatile("s_waitcnt vmcnt(0)" ::: "memory");
    __syncthreads();
    if (threadIdx.x == 0) {
        unsigned* bar = opq(b.bar);
        __builtin_amdgcn_s_waitcnt(0);
        asm volatile("buffer_inv sc1" ::: "memory");
        unsigned nloc = b.st[0], nx = b.st[1];
        if (nloc == 0u) { xcd_barrier_complete(bar, b.x, nloc, nx); b.st[0] = nloc; b.st[1] = nx; }
        const unsigned old = xb_add(&bar[XB_XSUB(b.x)], 1u);
        const unsigned gen = old / nloc;
        if (old + 1u == (gen + 1u) * nloc) {
            __builtin_amdgcn_fence(__ATOMIC_RELEASE, "agent");
            asm volatile("s_waitcnt vmcnt(0)" ::: "memory");
            const unsigned og = xb_add(&bar[XB_TOP], 1u);
            const unsigned tg = og / nx;
            if (og + 1u == (tg + 1u) * nx) xb_add(&bar[XB_TOPGEN], 1u);
            else XB_SPIN(xb_ld(&bar[XB_TOPGEN]) == tg, bar);
            asm volatile("s_waitcnt vmcnt(0)" ::: "memory");
        } else {
            XB_SPIN(xb_ld(&bar[XB_TOPGEN]) == gen, bar);
            asm volatile("s_waitcnt vmcnt(0)" ::: "memory");
        }
    }
    __syncthreads();
}


DI void phase_moe(const Params& p, const int L, char* lds) {
    unsigned* q = (unsigned*)(opq(p.ws) + OFF_MOEQ) + L * 256;
    unsigned* flag = q + 64;
    int* qslot = (int*)(lds + 163840 - 128);
    {
        PG_LAS int* tb = (PG_LAS int*)((PG_LAS char*)lds + MOE_TB_OFF);
        const int t24 = TID();
        if (t24 < 24) tb[32 + t24] = (int)__hip_atomic_load(q + 16 + t24, __ATOMIC_RELAXED, __HIP_MEMORY_SCOPE_AGENT);
        __syncthreads();
        if (threadIdx.x == 0) { int b = 0; for (int t = 0; t < 24; ++t) { tb[t] = b; b += ((tb[32 + t] + TM - 1) / TM) * TM; } tb[24] = b; }
        __syncthreads();
    }
    const JobMoeUp ju = mk_moeup(p, L, lds);
    const JobMoeDown jd = mk_moedown(p, L, lds);
    const int tiles = ju.num_units() >> 2, per = (tiles + 7) >> 3;
    const int myx = (int)((unsigned)__builtin_amdgcn_s_getreg((3 << 11) | 20) & 7u);
    int probe = 0, prev = -1;
    for (;;) {
        asm volatile("s_waitcnt vmcnt(0)" ::: "memory");
        __syncthreads();
        if (threadIdx.x == 0) {
            if (prev >= 0) (void)__hip_atomic_fetch_add(flag + prev, 1u, __ATOMIC_RELAXED, __HIP_MEMORY_SCOPE_AGENT);
            int r = -1;
            while (probe < 8) {
                const int x = (myx + probe) & 7, t0 = x * per;
                int ntx = tiles - t0; ntx = ntx > per ? per : ntx;
                if (ntx > 0) {
                    const int k = (int)__hip_atomic_fetch_add(q + 8 + x, 1u, __ATOMIC_RELAXED, __HIP_MEMORY_SCOPE_AGENT);
                    if (k < 8 * ntx) { r = k < 4 * ntx ? t0 * 4 + k : ((1 << 20) | (t0 * 4 + k - 4 * ntx)); break; }
                }
                ++probe;
            }
            *qslot = r;
        }
        __syncthreads();
        const int r = __builtin_amdgcn_readfirstlane(*qslot);
        __syncthreads();
        if (r < 0) break;
        if (r < (1 << 20)) {
            pg_gemm_seq(ju, lds, r, 1 << 30, r + 1);
            prev = r >> 2;
        } else {
            const int d = r & 0xfffff;
            prev = -1;
            if (__builtin_amdgcn_readfirstlane((int)threadIdx.x >> 6) == 0) {
                unsigned sp = 0;
                while ((unsigned)__builtin_amdgcn_readfirstlane((int)__hip_atomic_load(flag + (d >> 2), __ATOMIC_RELAXED, __HIP_MEMORY_SCOPE_AGENT)) < 4u) { __builtin_amdgcn_s_sleep(2); if (++sp > (1u << 16)) break; }
                __builtin_amdgcn_fence(__ATOMIC_ACQUIRE, "agent");
                asm volatile("s_waitcnt vmcnt(0)" ::: "memory");
            }
            __syncthreads();
            pg_gemm_seq(jd, lds, d, 1 << 30, d + 1);
        }
    }
}

extern __shared__ __attribute__((aligned(16))) char smem[];
namespace cg = cooperative_groups;
constexpr int MEGA_LDS = 163840;
constexpr size_t WS_NEED = OFF_BAR + CTL_BYTES;
__global__ void __launch_bounds__(NTHR) k_mega(const Params p) {
    cg::grid_group grid = cg::this_grid();
    volatile PG_LAS unsigned* st = (volatile PG_LAS unsigned*)((PG_LAS unsigned char*)smem + 163840 - 64);
    if (threadIdx.x < 4) st[threadIdx.x] = 0u;
    __syncthreads();
    const XcdBarrier xb = xcd_barrier_post((unsigned*)(opq(p.ws) + OFF_BAR), st);
#define GSYNC() xcd_barrier(xb)
    for (int L = 0; L < 2; ++L) {
        if (L == 0) {
            {
                const int ord = __builtin_amdgcn_readfirstlane((BID() >> 3) & 1);
#pragma unroll 1
                for (int s2 = 0; s2 < 2; ++s2) { if (s2 == ord) phase_prep(p, 0, smem); else phase_xb(p); }
            }
            if (p.ws == nullptr) grid.sync();
            GSYNC();
        }
        for (int rep = 0; rep < REP_INPROJ; ++rep) pg_gemm(mk_inproj<0>(p, L), smem);
        GSYNC();
        pg_gemm(mk_g1(p, L), smem);
        if (BID() < 128) { const UnitG ug = mk_g1(p, L).unit(BID()); scan_local(p, ug.g, ug.m0 >> 6); }
        if (BID() >= 128) pg_gemm(mk_inproj<1>(p, L), smem);
        for (int rep = 0; rep < REP_ATTN; ++rep) phase_attn(p, L, smem);
        GSYNC();
        for (int rep = 0; rep < REP_G2; ++rep) pg_gemm(mk_g2(p, L), smem);
        pg_gemm(mk_attnup(p, L), smem);
        GSYNC();
        for (int rep = 0; rep < REP_GLU; ++rep) pg_gemm(mk_glu(p, L), smem);
        GSYNC();
        for (int rep = 0; rep < (L == 0 ? REP_OUT0 : 1); ++rep) pg_gemm(mk_out(p, L), smem);
        GSYNC();
        for (int rep = 0; rep < REP_ROUTER; ++rep) phase_router(p, L, smem);
        GSYNC();
        phase_moe(p, L, smem);
        if (L == 0) { prep_from_queue(p, smem, 1 << 30, 1, false); GSYNC(); }
    }
#undef GSYNC
}

extern "C" void kernel_launch(void* const* d_in, const int* in_sizes, int n_in, void* d_out, int out_size, void* d_ws, size_t ws_size, hipStream_t stream) {
    static int grid_blocks = 0;
    if (!grid_blocks) {
        int dev = 0, cus = 0, per_cu = 0;
        (void)hipGetDevice(&dev);
        (void)hipDeviceGetAttribute(&cus, hipDeviceAttributeMultiprocessorCount, dev);
        (void)hipFuncSetAttribute((const void*)k_mega, hipFuncAttributeMaxDynamicSharedMemorySize, MEGA_LDS);
        (void)hipOccupancyMaxActiveBlocksPerMultiprocessor(&per_cu, (const void*)k_mega, NTHR, MEGA_LDS);
        if (per_cu < 1) per_cu = 1;
        if (per_cu > 1) per_cu = 1;
        grid_blocks = cus * per_cu;
    }
    if (n_in != 23 || ws_size < WS_NEED || out_size != NTOK * DM) { fprintf(stderr, "kernel_launch: unexpected shapes (n_in %d ws %zu out %d)\n", n_in, ws_size, out_size); return; }
    Params p{};
    for (int i = 0; i < 23; ++i) p.in[i] = (const float*)d_in[i];
    p.out = (float*)d_out; p.ws = (char*)d_ws;
    (void)hipMemsetAsync((char*)d_ws + OFF_BAR, 0, CTL_BYTES, stream);
    void* args[] = {&p};
    hipError_t e = hipLaunchCooperativeKernel((const void*)k_mega, dim3(grid_blocks), dim3(NTHR), args, MEGA_LDS, stream);
    if (e != hipSuccess) fprintf(stderr, "cooperative launch failed: %s (grid %d)\n", hipGetErrorString(e), grid_blocks);
}
```
